# Optimizing an MI355X kernel written in HIP

```python
import math
import jax
import jax.numpy as jnp
from jax import lax
import numpy as np

D_MODEL = 1024
BATCH = 16
SEQ = 2048
DEPTH = 4

CTX_LEN = 256
GRID_W = 64
ROPE_THETA = 10000.0
Q_BLOCK = 128
NEG_INF = -1e30
F32 = jnp.float32
MIX_WIDTH = D_MODEL

A_HEADS = 4
A_KV_HEADS = 2
A_HEAD_DIM = 128
S5_CH = D_MODEL // 2
S5_GROUP = 16
S5_GROUPS = S5_CH // S5_GROUP
S5_STATE = 64
C_HEADS = 4
C_Q_LORA = 256
C_KV_LORA = 256
C_NOPE = 128
C_ROPE = 64
C_V = 128
D_HEADS = 4
D_KV_HEADS = 2
D_HEAD_DIM = 128
D_WINDOW = 128
N_EXPERTS = 32
TOP_K = 4
D_FF = D_MODEL
SWIGLU_LIMIT = 7.0
SWIGLU_ALPHA = 1.702
MOE_BLOCK = 256

N_EVEN = (DEPTH + 1) // 2
N_ODD = DEPTH // 2
DEEPNORM_ALPHA = (2.0 * DEPTH) ** 0.25
DEEPNORM_BETA = (8.0 * DEPTH) ** -0.25

_A_Q = A_HEADS * A_HEAD_DIM
_A_KV = A_KV_HEADS * A_HEAD_DIM
AB_CUTS = (_A_Q, _A_Q + _A_KV, _A_Q + 2 * _A_KV)
AB_IN = _A_Q + 2 * _A_KV + S5_CH
_C_IN = C_Q_LORA + C_KV_LORA + C_ROPE
CD_CUTS = (C_Q_LORA, C_Q_LORA + C_KV_LORA, _C_IN, _C_IN + D_HEADS * D_HEAD_DIM,
           _C_IN + (D_HEADS + D_KV_HEADS) * D_HEAD_DIM)
CD_IN = _C_IN + (D_HEADS + 2 * D_KV_HEADS) * D_HEAD_DIM

kernel_name = "hybrid_dit_gqa_s5_mla_swa_moe"


def rms_norm(x, g, eps=1e-6):
    xf = x.astype(F32)
    y = xf * lax.rsqrt(jnp.mean(jnp.square(xf), axis=-1, keepdims=True) + eps)
    return (y * g.astype(F32)).astype(x.dtype)


def layer_norm(x, g, b, eps=1e-5):
    xf = x.astype(F32)
    mu = jnp.mean(xf, axis=-1, keepdims=True)
    var = jnp.mean(jnp.square(xf - mu), axis=-1, keepdims=True)
    y = (xf - mu) * lax.rsqrt(var + eps)
    return (y * g.astype(F32) + b.astype(F32)).astype(x.dtype)


def axial_rope_tables(n_rows, rot_dim):
    row, col = jnp.meshgrid(jnp.arange(n_rows, dtype=F32), jnp.arange(GRID_W, dtype=F32), indexing="ij")
    quarter = rot_dim // 4
    inv_freq = ROPE_THETA ** (-jnp.arange(quarter, dtype=F32) / quarter)
    ang_r = row.reshape(-1, 1) * inv_freq
    ang_c = col.reshape(-1, 1) * inv_freq
    return (jnp.cos(ang_r), jnp.sin(ang_r), jnp.cos(ang_c), jnp.sin(ang_c))


def _rot_half(x, cos, sin):
    x1, x2 = jnp.split(x, 2, axis=-1)
    return jnp.concatenate([x1 * cos - x2 * sin, x2 * cos + x1 * sin], axis=-1)


def apply_axial_rope(x, tabs):
    lead = x.ndim - 3
    cr, sr, cc, sc = (t.reshape(t.shape[0], *((1,) * lead), t.shape[1]).astype(x.dtype) for t in tabs)
    half = x.shape[-1] // 2
    return jnp.concatenate([_rot_half(x[..., :half], cr, sr), _rot_half(x[..., half:], cc, sc)], axis=-1)


def attend(q, k, v, scale, bias=None, sink=None):
    s = jnp.einsum("bqgrd,bkgd->bgrqk", q, k).astype(F32) * scale
    if bias is not None:
        s = s + bias
    if sink is not None:
        sk = jnp.broadcast_to(sink.astype(F32)[None, :, :, None, None], s.shape[:-1] + (1,))
        p = jax.nn.softmax(jnp.concatenate([s, sk], axis=-1), axis=-1)[..., :-1]
    else:
        p = jax.nn.softmax(s, axis=-1)
    return jnp.einsum("bgrqk,bkgd->bqgrd", p.astype(v.dtype), v)


def dense_blocked_attend(q, k, v, scale):
    b, t = q.shape[:2]
    nb = t // Q_BLOCK
    qb = jnp.moveaxis(q.reshape(b, nb, Q_BLOCK, *q.shape[2:]), 1, 0)
    ob = lax.map(lambda qi: attend(qi, k, v, scale), qb)
    return jnp.moveaxis(ob, 0, 1).reshape(b, t, *ob.shape[3:])


def windowed_blocked_attend(q, k_lat, v_lat, k_ctx, v_ctx, sink, scale):
    b, t = q.shape[:2]
    nb = t // Q_BLOCK
    band = Q_BLOCK + 2 * D_WINDOW
    padw = ((0, 0), (D_WINDOW, D_WINDOW), (0, 0), (0, 0))
    kp = jnp.pad(k_lat, padw)
    vp = jnp.pad(v_lat, padw)
    rel = jnp.arange(band)[None, :] - D_WINDOW - jnp.arange(Q_BLOCK)[:, None]
    in_win = jnp.abs(rel) <= D_WINDOW
    ctx_bias = jnp.zeros((Q_BLOCK, k_ctx.shape[1]), F32)

    def block(i):
        start = i * Q_BLOCK
        qi = lax.dynamic_slice_in_dim(q, start, Q_BLOCK, axis=1)
        ki = lax.dynamic_slice_in_dim(kp, start, band, axis=1)
        vi = lax.dynamic_slice_in_dim(vp, start, band, axis=1)
        kpos = start - D_WINDOW + jnp.arange(band)
        valid = in_win & ((kpos >= 0) & (kpos < t))[None, :]
        bias = jnp.concatenate([ctx_bias, jnp.where(valid, 0.0, NEG_INF).astype(F32)], axis=-1)
        return attend(qi, jnp.concatenate([k_ctx, ki], axis=1), jnp.concatenate([v_ctx, vi], axis=1),
                      scale, bias, sink)

    ob = lax.map(block, jnp.arange(nb))
    return jnp.moveaxis(ob, 0, 1).reshape(b, t, *ob.shape[3:])


def _lin_combine(e1, e2):
    a1, b1 = e1
    a2, b2 = e2
    return a1 * a2, a2 * b1 + b2


def s5_scan(lam_bar, b_bar, u, h0, reverse):
    bu = jnp.einsum("gpc,btgc->btgp", b_bar, u.astype(jnp.complex64))
    if h0 is not None:
        edge = -1 if reverse else 0
        bu = bu.at[:, edge].add(lam_bar * h0)
    a = jnp.broadcast_to(lam_bar, bu.shape)
    _, h = lax.associative_scan(_lin_combine, (a, bu), reverse=reverse, axis=1)
    return h


def s5_mixer(u_c, u_l, lam_re, lam_im, log_dt, b_re, b_im, c_re, c_im, d_skip):
    to_groups = lambda u: u.astype(F32).reshape(u.shape[0], u.shape[1], S5_GROUPS, S5_GROUP)
    uc, ul = to_groups(u_c), to_groups(u_l)
    outs_c, outs_l = [], []
    for direction in range(2):
        reverse = direction == 1
        lam = lax.complex(lam_re[direction].astype(F32), lam_im[direction].astype(F32))
        dt = jnp.exp(log_dt[direction].astype(F32))[:, None]
        lam_bar = jnp.exp(lam * dt)
        b_bar = ((lam_bar - 1.0) / lam)[..., None] * lax.complex(b_re[direction].astype(F32),
                                                                 b_im[direction].astype(F32))
        c_mat = lax.complex(c_re[direction].astype(F32), c_im[direction].astype(F32))
        h_c = s5_scan(lam_bar, b_bar, uc, None, reverse)
        h0 = h_c[:, 0] if reverse else h_c[:, -1]
        h_l = s5_scan(lam_bar, b_bar, ul, h0, reverse)
        outs_c.append(jnp.einsum("gcp,btgp->btgc", c_mat, h_c).real)
        outs_l.append(jnp.einsum("gcp,btgp->btgc", c_mat, h_l).real)
    d = d_skip.astype(F32).reshape(S5_GROUPS, S5_GROUP)
    y_c = (outs_c[0] + outs_c[1] + d * uc).reshape(u_c.shape).astype(u_c.dtype)
    y_l = (outs_l[0] + outs_l[1] + d * ul).reshape(u_l.shape).astype(u_l.dtype)
    return y_c, y_l


def half_glu(y, w, b):
    z = jax.nn.gelu(y)
    return z * jax.nn.sigmoid(z @ w + b)


def mixer_ab(hc, hl, tabs_head, w_in, q_norm, k_norm, lam_re, lam_im, log_dt, b_re, b_im, c_re, c_im,
             d_skip, w_glu, b_glu):
    rep = A_HEADS // A_KV_HEADS

    def project(h):
        b, t = h.shape[:2]
        q, k, v, u = jnp.split(h @ w_in, AB_CUTS, axis=-1)
        q = rms_norm(q.reshape(b, t, A_HEADS, A_HEAD_DIM), q_norm)
        k = rms_norm(k.reshape(b, t, A_KV_HEADS, A_HEAD_DIM), k_norm)
        return q, k, v.reshape(b, t, A_KV_HEADS, A_HEAD_DIM), u

    qc, kc, vc, uc = project(hc)
    ql, kl, vl, ul = project(hl)
    ql = apply_axial_rope(ql, tabs_head)
    kl = apply_axial_rope(kl, tabs_head)
    group = lambda q: q.reshape(q.shape[0], q.shape[1], A_KV_HEADS, rep, A_HEAD_DIM)
    scale = A_HEAD_DIM ** -0.5
    ac = attend(group(qc), kc, vc, scale)
    al = dense_blocked_attend(group(ql), jnp.concatenate([kc, kl], axis=1),
                              jnp.concatenate([vc, vl], axis=1), scale)
    sc, sl = s5_mixer(uc, ul, lam_re, lam_im, log_dt, b_re, b_im, c_re, c_im, d_skip)
    sc = half_glu(sc, w_glu, b_glu)
    sl = half_glu(sl, w_glu, b_glu)
    flat = lambda a: a.reshape(a.shape[0], a.shape[1], -1)
    return (jnp.concatenate([flat(ac), sc], axis=-1), jnp.concatenate([flat(al), sl], axis=-1))


def mla_qk(q_nope, q_rope, k_nope, k_rope):
    q = jnp.concatenate([q_nope, q_rope], axis=-1)[:, :, :, None, :]
    k_r = jnp.broadcast_to(k_rope[:, :, None, :], k_nope.shape[:3] + (C_ROPE,))
    return q, jnp.concatenate([k_nope, k_r], axis=-1)


def mixer_cd(hc, hl, tabs_head, tabs_mla, w_in, q_lora_norm, kv_lora_norm, w_uq, w_ukv, sink):
    rep = D_HEADS // D_KV_HEADS

    def project(h):
        b, t = h.shape[:2]
        cq, ckv, k_rope, qd, kd, vd = jnp.split(h @ w_in, CD_CUTS, axis=-1)
        q = (rms_norm(cq, q_lora_norm) @ w_uq).reshape(b, t, C_HEADS, C_NOPE + C_ROPE)
        kv = (rms_norm(ckv, kv_lora_norm) @ w_ukv).reshape(b, t, C_HEADS, C_NOPE + C_V)
        q_nope, q_rope = jnp.split(q, [C_NOPE], axis=-1)
        k_nope, v = jnp.split(kv, [C_NOPE], axis=-1)
        return (q_nope, q_rope, k_nope, k_rope, v,
                qd.reshape(b, t, D_HEADS, D_HEAD_DIM),
                kd.reshape(b, t, D_KV_HEADS, D_HEAD_DIM),
                vd.reshape(b, t, D_KV_HEADS, D_HEAD_DIM))

    qn_c, qr_c, kn_c, kr_c, vm_c, qd_c, kd_c, vd_c = project(hc)
    qn_l, qr_l, kn_l, kr_l, vm_l, qd_l, kd_l, vd_l = project(hl)
    qr_l = apply_axial_rope(qr_l, tabs_mla)
    kr_l = apply_axial_rope(kr_l, tabs_mla)
    qd_l = apply_axial_rope(qd_l, tabs_head)
    kd_l = apply_axial_rope(kd_l, tabs_head)
    qm_c, km_c = mla_qk(qn_c, qr_c, kn_c, kr_c)
    qm_l, km_l = mla_qk(qn_l, qr_l, kn_l, kr_l)
    scale_c = (C_NOPE + C_ROPE) ** -0.5
    mc = attend(qm_c, km_c, vm_c, scale_c)
    ml = dense_blocked_attend(qm_l, jnp.concatenate([km_c, km_l], axis=1),
                              jnp.concatenate([vm_c, vm_l], axis=1), scale_c)
    sink_g = sink.reshape(D_KV_HEADS, rep)
    group = lambda q: q.reshape(q.shape[0], q.shape[1], D_KV_HEADS, rep, D_HEAD_DIM)
    scale_d = D_HEAD_DIM ** -0.5
    wc = attend(group(qd_c), kd_c, vd_c, scale_d, sink=sink_g)
    wl = windowed_blocked_attend(group(qd_l), kd_l, vd_l, kd_c, vd_c, sink_g, scale_d)
    flat = lambda a: a.reshape(a.shape[0], a.shape[1], -1)
    return (jnp.concatenate([flat(mc), flat(wc)], axis=-1), jnp.concatenate([flat(ml), flat(wl)], axis=-1))


def clamped_swiglu(z):
    glu, lin = jnp.split(z, 2, axis=-1)
    glu = jnp.minimum(glu, SWIGLU_LIMIT)
    lin = jnp.clip(lin, -SWIGLU_LIMIT, SWIGLU_LIMIT)
    return glu * jax.nn.sigmoid(SWIGLU_ALPHA * glu) * (lin + 1.0)


def moe(h, w_r, b_r, w_in, b_in, w_out, b_out):
    n_tok, d = h.shape
    logits = (h @ w_r + b_r).astype(F32)
    top_logit, top_idx = lax.top_k(logits, TOP_K)
    gates = jax.nn.softmax(top_logit, axis=-1)
    flat_e = top_idx.reshape(-1)
    n_slots = n_tok * TOP_K
    order = jnp.argsort(flat_e)
    sorted_e = flat_e[order]
    counts = jnp.bincount(flat_e, length=N_EXPERTS)
    padded = (counts + MOE_BLOCK - 1) // MOE_BLOCK * MOE_BLOCK
    pad_end = jnp.cumsum(padded)
    pad_start = pad_end - padded
    start = jnp.cumsum(counts) - counts
    dest = pad_start[sorted_e] + jnp.arange(n_slots) - start[sorted_e]
    n_blocks = -(-n_slots // MOE_BLOCK) + N_EXPERTS
    n_pad = n_blocks * MOE_BLOCK
    slot_tok = jnp.full((n_pad,), n_tok, jnp.int32).at[dest].set((order // TOP_K).astype(jnp.int32))
    slot_gate = jnp.zeros((n_pad,), F32).at[dest].set(gates.reshape(-1)[order])
    block_e = jnp.minimum(jnp.searchsorted(pad_end, jnp.arange(n_blocks) * MOE_BLOCK, side="right"),
                          N_EXPERTS - 1)
    h_ext = jnp.concatenate([h, jnp.zeros((1, d), h.dtype)], axis=0)
    xs = h_ext[slot_tok].reshape(n_blocks, MOE_BLOCK, d)

    def expert_block(args):
        xb, e = args
        z = clamped_swiglu(xb @ w_in[e] + b_in[e])
        return z @ w_out[e] + b_out[e]

    ys = lax.map(expert_block, (xs, block_e)).reshape(n_pad, d)
    ys = ys * slot_gate[:, None].astype(ys.dtype)
    return jnp.zeros((n_tok + 1, d), ys.dtype).at[slot_tok].add(ys)[:n_tok]


def setup_inputs(seed: int = 0) -> dict:
    key = jax.random.key(seed)
    keys = list(jax.random.split(key, 40))
    nrm = lambda shape, scale: jax.random.normal(keys.pop(), shape, F32) * scale
    d = D_MODEL
    inp = {}
    inp["x"] = nrm((BATCH, SEQ, d), 1.0)
    inp["c"] = nrm((BATCH, d), 1.0)
    inp["ctx"] = nrm((BATCH, CTX_LEN, d), 1.0)
    inp["c_ctx"] = nrm((d,), 1.0)
    inp["w_mod"] = nrm((DEPTH, d, 6 * d), 0.5 * d ** -0.5)
    inp["b_mod"] = nrm((DEPTH, 6 * d), 0.02)
    inp["ln_g"] = 1.0 + nrm((DEPTH, 2, d), 0.02)
    inp["ln_b"] = nrm((DEPTH, 2, d), 0.02)
    inp["w_mix_out"] = nrm((DEPTH, MIX_WIDTH, d), DEEPNORM_BETA * MIX_WIDTH ** -0.5)
    inp["w_router"] = nrm((DEPTH, d, N_EXPERTS), d ** -0.5)
    inp["b_router"] = nrm((DEPTH, N_EXPERTS), 0.01)
    inp["w_exp_in"] = nrm((DEPTH, N_EXPERTS, d, 2 * D_FF), d ** -0.5)
    inp["b_exp_in"] = nrm((DEPTH, N_EXPERTS, 2 * D_FF), 0.02)
    inp["w_exp_out"] = nrm((DEPTH, N_EXPERTS, D_FF, d), DEEPNORM_BETA * D_FF ** -0.5)
    inp["b_exp_out"] = nrm((DEPTH, N_EXPERTS, d), 0.02)
    inp["w_in_ab"] = nrm((N_EVEN, d, AB_IN), d ** -0.5)
    inp["a_q_norm"] = 1.0 + nrm((N_EVEN, A_HEAD_DIM), 0.02)
    inp["a_k_norm"] = 1.0 + nrm((N_EVEN, A_HEAD_DIM), 0.02)
    ssm_shape = (N_EVEN, 2, S5_GROUPS, S5_STATE)
    inp["s5_lam_re"] = -0.5 * jnp.exp(nrm(ssm_shape, 0.02))
    inp["s5_lam_im"] = jnp.pi * jnp.arange(S5_STATE, dtype=F32) + nrm(ssm_shape, 0.01)
    inp["s5_log_dt"] = jax.random.uniform(keys.pop(), (N_EVEN, 2, S5_GROUPS), F32,
                                          minval=math.log(1e-3), maxval=math.log(1e-1))
    inp["s5_b_re"] = nrm((N_EVEN, 2, S5_GROUPS, S5_STATE, S5_GROUP), (2 * S5_GROUP) ** -0.5)
    inp["s5_b_im"] = nrm((N_EVEN, 2, S5_GROUPS, S5_STATE, S5_GROUP), (2 * S5_GROUP) ** -0.5)
    inp["s5_c_re"] = nrm((N_EVEN, 2, S5_GROUPS, S5_GROUP, S5_STATE), S5_STATE ** -0.5)
    inp["s5_c_im"] = nrm((N_EVEN, 2, S5_GROUPS, S5_GROUP, S5_STATE), S5_STATE ** -0.5)
    inp["s5_d"] = nrm((N_EVEN, S5_CH), 0.5)
    inp["w_glu"] = nrm((N_EVEN, S5_CH, S5_CH), S5_CH ** -0.5)
    inp["b_glu"] = nrm((N_EVEN, S5_CH), 0.02)
    inp["w_in_cd"] = nrm((N_ODD, d, CD_IN), d ** -0.5)
    inp["c_q_norm"] = 1.0 + nrm((N_ODD, C_Q_LORA), 0.02)
    inp["c_kv_norm"] = 1.0 + nrm((N_ODD, C_KV_LORA), 0.02)
    inp["w_uq"] = nrm((N_ODD, C_Q_LORA, C_HEADS * (C_NOPE + C_ROPE)), C_Q_LORA ** -0.5)
    inp["w_ukv"] = nrm((N_ODD, C_KV_LORA, C_HEADS * (C_NOPE + C_V)), C_KV_LORA ** -0.5)
    inp["d_sink"] = nrm((N_ODD, D_HEADS), 1.0)
    return inp


def reference(x, c, ctx, c_ctx, w_mod, b_mod, ln_g, ln_b, w_mix_out, w_router, b_router,
              w_exp_in, b_exp_in, w_exp_out, b_exp_out, w_in_ab, a_q_norm, a_k_norm,
              s5_lam_re, s5_lam_im, s5_log_dt, s5_b_re, s5_b_im, s5_c_re, s5_c_im, s5_d,
              w_glu, b_glu, w_in_cd, c_q_norm, c_kv_norm, w_uq, w_ukv, d_sink):
    n_lat = x.shape[1]
    n_rows = n_lat // GRID_W
    tabs_head = axial_rope_tables(n_rows, A_HEAD_DIM)
    tabs_mla = axial_rope_tables(n_rows, C_ROPE)
    xl, xc = x, ctx
    silu_c = jax.nn.silu(c)
    silu_ctx = jax.nn.silu(c_ctx)
    for layer in range(DEPTH):
        last = layer == DEPTH - 1
        i = layer // 2
        m_l = jnp.split((silu_c @ w_mod[layer] + b_mod[layer])[:, None, :], 6, axis=-1)
        m_c = jnp.split(silu_ctx @ w_mod[layer] + b_mod[layer], 6, axis=-1)
        hl = xl * (1.0 + m_l[1]) + m_l[0]
        hc = xc * (1.0 + m_c[1]) + m_c[0]
        if layer % 2 == 0:
            oc, ol = mixer_ab(hc, hl, tabs_head, w_in_ab[i], a_q_norm[i], a_k_norm[i],
                              s5_lam_re[i], s5_lam_im[i], s5_log_dt[i], s5_b_re[i], s5_b_im[i],
                              s5_c_re[i], s5_c_im[i], s5_d[i], w_glu[i], b_glu[i])
        else:
            oc, ol = mixer_cd(hc, hl, tabs_head, tabs_mla, w_in_cd[i], c_q_norm[i], c_kv_norm[i],
                              w_uq[i], w_ukv[i], d_sink[i])
        xl = layer_norm(DEEPNORM_ALPHA * xl + m_l[2] * (ol @ w_mix_out[layer]), ln_g[layer, 0], ln_b[layer, 0])
        hl = xl * (1.0 + m_l[4]) + m_l[3]
        moe_args = (w_router[layer], b_router[layer], w_exp_in[layer], b_exp_in[layer],
                    w_exp_out[layer], b_exp_out[layer])
        if last:
            yl = moe(hl.reshape(-1, D_MODEL), *moe_args).reshape(xl.shape)
        else:
            xc = layer_norm(DEEPNORM_ALPHA * xc + m_c[2] * (oc @ w_mix_out[layer]), ln_g[layer, 0], ln_b[layer, 0])
            hc = xc * (1.0 + m_c[4]) + m_c[3]
            n_ctx_tok = hc.shape[0] * hc.shape[1]
            y = moe(jnp.concatenate([hc.reshape(-1, D_MODEL), hl.reshape(-1, D_MODEL)], axis=0), *moe_args)
            yc = y[:n_ctx_tok].reshape(xc.shape)
            yl = y[n_ctx_tok:].reshape(xl.shape)
            xc = layer_norm(DEEPNORM_ALPHA * xc + m_c[5] * yc, ln_g[layer, 1], ln_b[layer, 1])
        xl = layer_norm(DEEPNORM_ALPHA * xl + m_l[5] * yl, ln_g[layer, 1], ln_b[layer, 1])
    return xl
```

```cpp
#include <hip/hip_runtime.h>
#include <stdint.h>
#include <stdio.h>

#define LAS __attribute__((address_space(3)))
#define GAS __attribute__((address_space(1)))
typedef unsigned short bf16_t;
typedef short bf16x8 __attribute__((ext_vector_type(8)));
typedef float f32x4 __attribute__((ext_vector_type(4)));
typedef float f32x2 __attribute__((ext_vector_type(2)));
typedef unsigned u32x4 __attribute__((ext_vector_type(4)));
typedef unsigned u32x2 __attribute__((ext_vector_type(2)));

constexpr int DM = 1024, NB = 16, SEQ = 2048, CTXL = 256, TPB = SEQ + CTXL  ;
constexpr int M = NB * TPB;
constexpr int NPANEL = M / 256;
constexpr int DEPTH = 4, NEXP = 32, TOPK = 4, DFF = 1024;
constexpr int CAP = M;
constexpr int NPAD = M * TOPK + NEXP * 256;
constexpr float ALPHA = 1.681792830507429f;
constexpr float LN_EPS = 1e-5f;
constexpr int NWAVES = 8, NTHR = 512;

constexpr size_t MiB = 1ull << 20;
constexpr size_t WS_CTL = 0, CTL_BYTES = 1 * MiB;
constexpr size_t WS_MOD = 1 * MiB;
constexpr size_t WS_X = 4 * MiB;
constexpr size_t WS_H = WS_X + 144 * MiB;
constexpr size_t WS_Y = WS_H + 72 * MiB;
constexpr size_t WS_OL = WS_Y + 72 * MiB;
constexpr size_t WS_PROJ = WS_OL + 72 * MiB;
constexpr size_t WS_Z = WS_PROJ + 126 * MiB;
constexpr size_t WS_Y2 = WS_Z + 304 * MiB;
constexpr size_t WS_SLOTTOK = WS_Y2 + 304 * MiB;
constexpr size_t WS_SLOTGATE = WS_SLOTTOK + 5 * MiB;
constexpr size_t WS_TOKPOS = WS_SLOTGATE + 5 * MiB;
constexpr size_t WS_WEXPIN = WS_TOKPOS + 1 * MiB;
constexpr size_t WS_WEXPOUT = WS_WEXPIN + 512 * MiB;
constexpr size_t WS_WMIX = WS_WEXPOUT + 256 * MiB;
constexpr size_t WS_WINAB = WS_WMIX + 8 * MiB;
constexpr size_t WS_WINCD = WS_WINAB + 6 * MiB;
constexpr size_t WS_WGLU = WS_WINCD + 7 * MiB;
constexpr size_t WS_WUQ = WS_WGLU + 1 * MiB;
constexpr size_t WS_WUKV = WS_WUQ + 1 * MiB;
constexpr size_t WS_ROPE = WS_WUKV + 1 * MiB;
constexpr size_t WS_QM = WS_ROPE + 1 * MiB;
constexpr size_t WS_KVM = WS_QM + 54 * MiB;
constexpr size_t WS_UT = WS_KVM + 72 * MiB;
constexpr size_t WS_XS = WS_UT + 36 * MiB;
constexpr size_t WS_HIN = WS_XS + 72 * MiB;
constexpr size_t WS_ZG = WS_HIN + 36 * MiB;
constexpr size_t WS_TF = WS_ZG + 36 * MiB;
constexpr size_t WS_SF = WS_TF + 2 * MiB;
constexpr size_t WS_WF = WS_SF + 8 * MiB;
constexpr size_t WS_LAM16 = WS_WF + 8 * MiB;
constexpr size_t WS_END = WS_LAM16 + 1 * MiB;

constexpr int CW_BAR = 4096;
constexpr int CW_CURSOR = 8192;

constexpr int LDS_STAGE = 0, LDS_MISC = 133120, LDS_BYTES = 147456;

__device__ __forceinline__ unsigned f2bf(float f) { unsigned u = __builtin_bit_cast(unsigned, f); return (u + 0x7fffu + ((u >> 16) & 1u)) >> 16; }
__device__ __forceinline__ unsigned pk2(float lo, float hi) { return f2bf(lo) | (f2bf(hi) << 16); }
__device__ __forceinline__ float bf2f(unsigned short b) { return __builtin_bit_cast(float, ((unsigned)b) << 16); }
__device__ __forceinline__ float bflo(unsigned w) { return __builtin_bit_cast(float, w << 16); }
__device__ __forceinline__ float bfhi(unsigned w) { return __builtin_bit_cast(float, w & 0xffff0000u); }
__device__ __forceinline__ float wave_sum(float v) {
#pragma unroll
    for (int o = 1; o < 64; o <<= 1) v += __shfl_xor(v, o);
    return v;
}
__device__ __forceinline__ float wave_max(float v) {
#pragma unroll
    for (int o = 1; o < 64; o <<= 1) v = fmaxf(v, __shfl_xor(v, o));
    return v;
}
__device__ __forceinline__ int uni(int v) { return __builtin_amdgcn_readfirstlane(v); }
__device__ __forceinline__ const char* unip(const char* p) { const unsigned long long v = (unsigned long long)p; const unsigned lo = (unsigned)__builtin_amdgcn_readfirstlane((int)(unsigned)v), hi = (unsigned)__builtin_amdgcn_readfirstlane((int)(unsigned)(v >> 32)); return (const char*)(((unsigned long long)hi << 32) | lo); }
#define PHASE_IDS() int tid = threadIdx.x; asm volatile("" : "+v"(tid)); const int lane = tid & 63; const int wave = __builtin_amdgcn_readfirstlane(tid >> 6); const int gw = vcu * NWAVES + wave; (void)lane; (void)gw
#define LDS_WAIT() asm volatile("s_waitcnt lgkmcnt(0)" ::: "memory")
#define VM_WAIT() asm volatile("s_waitcnt vmcnt(0)" ::: "memory")

#define XB_TMO      128
#define XB_XCNT(j)  (256  + 64 * (j))
#define XB_XSUB(j)  (1280 + 64 * (j))
#define XB_XGEN(j)  (2304 + 64 * (j))
#define XB_TOP      3328
#define XB_TOPGEN   3392
#define XCD_BAR_WORDS 3456
#define XB_SPIN_CAP (1u << 22)

__device__ __forceinline__ unsigned xb_ld(unsigned* p)              { return __hip_atomic_load(p, __ATOMIC_RELAXED, __HIP_MEMORY_SCOPE_AGENT); }
__device__ __forceinline__ unsigned xb_add(unsigned* p, unsigned v) { return __hip_atomic_fetch_add(p, v, __ATOMIC_RELAXED, __HIP_MEMORY_SCOPE_AGENT); }
__device__ __forceinline__ unsigned xb_xcc_id() { return (unsigned)__builtin_amdgcn_s_getreg((3 << 11) | 20) & 0xFu; }
#define XB_SPIN(cond, bar) do { unsigned _sp = 0; while (cond) { __builtin_amdgcn_s_sleep(1); \
    if ((++_sp & 255u) == 0u) { if (xb_ld(&(bar)[XB_TMO])) break; if (_sp > XB_SPIN_CAP) { atomicAdd(&(bar)[XB_TMO], 1u); break; } } } } while (0)

struct XcdBarrier { unsigned* bar; unsigned x; volatile LAS unsigned* st; };

__device__ __forceinline__ XcdBarrier xcd_barrier_post(unsigned* bar, volatile LAS unsigned* st) {
    XcdBarrier b; b.bar = bar; b.x = xb_xcc_id(); b.st = st;
    if (threadIdx.x == 0) (void)xb_add(&bar[XB_XCNT(b.x)], 1u);
    return b;
}
__device__ __forceinline__ void xcd_barrier_complete(unsigned* bar, unsigned x, unsigned& nloc, unsigned& nx) {
    const unsigned G = gridDim.x * gridDim.y * gridDim.z;
    unsigned sum, cnt, mine, sp = 0u;
    for (;;) {
        sum = 0u; cnt = 0u; mine = 0u;
#pragma unroll
        for (unsigned j = 0; j < 16; ++j) { const unsigned c = xb_ld(&bar[XB_XCNT(j)]); sum += c; cnt += (c > 0u) ? 1u : 0u; mine = (j == x) ? c : mine; }
        if (sum == G) break;
        __builtin_amdgcn_s_sleep(1);
        if ((++sp & 255u) == 0u) { if (xb_ld(&bar[XB_TMO])) break; if (sp > XB_SPIN_CAP) { atomicAdd(&bar[XB_TMO], 1u); break; } }
    }
    nloc = mine > 0u ? mine : 1u; nx = cnt > 0u ? cnt : 1u;
}
__device__ __forceinline__ void xcd_barrier(const XcdBarrier& b) {
    asm volatile("s_waitcnt vmcnt(0)" ::: "memory");
    __syncthreads();
    if (threadIdx.x == 0) {
        unsigned* bar = b.bar;
        __builtin_amdgcn_s_waitcnt(0);
        unsigned bx_; asm volatile("s_getreg_b32 %0, hwreg(HW_REG_XCC_ID, 0, 4)" : "=s"(bx_));
        unsigned nloc = b.st[0], nx = b.st[1];
        if (nloc == 0u) { xcd_barrier_complete(bar, bx_, nloc, nx); b.st[0] = nloc; b.st[1] = nx; }
        const unsigned old = xb_add(&bar[XB_XSUB(bx_)], 1u);
        const unsigned gen = old / nloc;
        if (old + 1u == (gen + 1u) * nloc) {
            __builtin_amdgcn_fence(__ATOMIC_RELEASE, "agent");
            asm volatile("s_waitcnt vmcnt(0)" ::: "memory");
            const unsigned og = xb_add(&bar[XB_TOP], 1u);
            const unsigned tg = og / nx;
            if (og + 1u == (tg + 1u) * nx) xb_add(&bar[XB_TOPGEN], 1u);
            else XB_SPIN(xb_ld(&bar[XB_TOPGEN]) == tg, bar);
            __builtin_amdgcn_fence(__ATOMIC_ACQUIRE, "agent");
            xb_add(&bar[XB_XGEN(bx_)], 1u);
            asm volatile("s_waitcnt vmcnt(0)" ::: "memory");
        } else {
            XB_SPIN(xb_ld(&bar[XB_XGEN(bx_)]) == gen, bar);
            __builtin_amdgcn_fence(__ATOMIC_ACQUIRE, "agent");
            asm volatile("s_waitcnt vmcnt(0)" ::: "memory");
        }
    }
    __syncthreads();
}

namespace pg8 {
constexpr int BM = 256, BK = 64, HALF = 128, HTB = HALF * BK * 2, STAGE_BYTES = 8 * HTB;
__device__ __forceinline__ int lds_byte(int r, int c) { const int st = (r >> 4) * 2 + (c >> 5), rr = r & 15, cc = c & 31, ob = rr * 64 + cc * 2; return st * 1024 + (ob ^ (((ob >> 9) & 1) << 5)); }
__device__ __forceinline__ void stage_rc(int b, int& R, int& C) { const int st = b / 1024, sb = b % 1024, swz = sb ^ (((sb >> 9) & 1) << 5); R = (st >> 1) * 16 + swz / 64; C = (st & 1) * 32 + (swz % 64) / 2; }
__device__ __forceinline__ int perm32(int rho) { const int n = rho >> 4, i = rho & 15; return 8 * (i >> 2) + 4 * n + (i & 3); }

struct Unit { int pm, pn, g, e, nvalid, pad; const char* A; const char* B; const int* rows; const float* gates; };

__device__ __forceinline__ unsigned cvt_pk_bf16(float lo, float hi) { unsigned r; asm volatile("v_cvt_pk_bf16_f32 %0, %1, %2" : "=v"(r) : "v"(lo), "v"(hi)); return r; }

template <class Epi, class Sched, bool GATHER>
__device__ __forceinline__ void gemm_phase(LAS unsigned char* lds, const int K, const int lda, const char* Agather, const Sched& S, const Epi& E) {
    int tid = threadIdx.x; asm volatile("" : "+v"(tid));
    const int wid = __builtin_amdgcn_readfirstlane(tid >> 6), lane = tid & 63, wr = wid >> 2, wc = wid & 3, fr = lane & 15, fq = lane >> 4;
    const int nt = K / BK;
    unsigned voffA[2], voffB[2]; int rowA[2]; unsigned colA2[2];
#pragma unroll
    for (int i = 0; i < 2; ++i) { int R, C; stage_rc(tid * 16 + i * 8192, R, C); const int Rb = (R & ~31) + perm32(R & 31);
        voffA[i] = (unsigned)(R * lda + C) * 2u; voffB[i] = (unsigned)(Rb * K + C) * 2u; rowA[i] = R; colA2[i] = (unsigned)C * 2u; }
    const size_t kstep = (size_t)(BK * 2);
    const size_t hstepA = (size_t)HALF * lda * 2, hstepB = (size_t)HALF * K * 2;
    const unsigned ldsw = (unsigned)wid * 1024u;
    const int aoff = lds_byte(wr * 64 + fr, fq * 8), boff = lds_byte(wc * 32 + fr, fq * 8);
#define PG8_SA(b, h) (((b) * 2 + (h)) * HTB)
#define PG8_SB(b, h) ((4 + (b) * 2 + (h)) * HTB)
#define PG8_GLDS(gp, lp) __builtin_amdgcn_global_load_lds((const unsigned*)(gp), (LAS unsigned*)(lp), 16, 0, 0)
#define PG8_STAGE_B(bufoff, gbase) do { _Pragma("unroll") for (int _i = 0; _i < 2; ++_i) PG8_GLDS((const char*)(gbase) + voffB[_i], lds + (bufoff) + ldsw + _i * 8192); } while (0)
#define PG8_STAGE_A(bufoff, h, nx, kb) do { if constexpr (GATHER) { const char* _p = Agather + (kb); _Pragma("unroll") for (int _i = 0; _i < 2; ++_i) PG8_GLDS(_p + ((nx) ? nvo[h][_i] : cvo[h][_i]), lds + (bufoff) + ldsw + _i * 8192); } \
        else { const char* _p = ((nx) ? nA : cA) + (size_t)(h) * hstepA + (kb); _Pragma("unroll") for (int _i = 0; _i < 2; ++_i) PG8_GLDS(_p + voffA[_i], lds + (bufoff) + ldsw + _i * 8192); } } while (0)
#define PG8_LDA(dst, b, h) do { _Pragma("unroll") for (int m = 0; m < 4; ++m) _Pragma("unroll") for (int k = 0; k < 2; ++k) dst[m][k] = *(const LAS bf16x8*)(lds + PG8_SA(b, h) + aoff + m * 2048 + k * 1024); } while (0)
#define PG8_LDB(dst, b, h) do { _Pragma("unroll") for (int n = 0; n < 2; ++n) _Pragma("unroll") for (int k = 0; k < 2; ++k) dst[n][k] = *(const LAS bf16x8*)(lds + PG8_SB(b, h) + boff + n * 2048 + k * 1024); } while (0)
#define PG8_MMA(ai, bj, At, Bt) do { __builtin_amdgcn_s_setprio(1); _Pragma("unroll") for (int m = 0; m < 4; ++m) _Pragma("unroll") for (int n = 0; n < 2; ++n) _Pragma("unroll") for (int k = 0; k < 2; ++k) \
        acc[ai][bj][m][n] = __builtin_amdgcn_mfma_f32_16x16x32_bf16(Bt[n][k], At[m][k], acc[ai][bj][m][n], 0, 0, 0); __builtin_amdgcn_s_setprio(0); } while (0)
#define PG8_WAIT_V(n) asm volatile("s_waitcnt vmcnt(" #n ")" ::: "memory")
#define PG8_WAIT_L(n) asm volatile("s_waitcnt lgkmcnt(" #n ")" ::: "memory")
#define PG8_BAR __builtin_amdgcn_s_barrier()
#define PG8_SCHED __builtin_amdgcn_sched_barrier(0)
#define PG8_LOADVO(dst, u) do { if constexpr (GATHER) { _Pragma("unroll") for (int _h = 0; _h < 2; ++_h) _Pragma("unroll") for (int _i = 0; _i < 2; ++_i) { const int _r = _h * 128 + rowA[_i]; \
        const int _t = (_r < (u).nvalid) ? (u).rows[_r] : 0; dst[_h][_i] = (unsigned)_t * (unsigned)(lda * 2) + colA2[_i]; } } } while (0)
    Unit cur, nxt; int ui = 0;
    if (!S.next(0, cur)) return;
    f32x4 acc[2][2][4][2];
#pragma unroll
    for (int a = 0; a < 2; ++a)
#pragma unroll
        for (int b = 0; b < 2; ++b)
#pragma unroll
            for (int m = 0; m < 4; ++m)
#pragma unroll
                for (int n = 0; n < 2; ++n) acc[a][b][m][n] = (f32x4){0.f, 0.f, 0.f, 0.f};
    bf16x8 At[4][2], B0[2][2], B1[2][2];
    unsigned cvo[2][2] = {{0u, 0u}, {0u, 0u}}, nvo[2][2] = {{0u, 0u}, {0u, 0u}};
    const char* cA = cur.A; const char* cB = cur.B; const char* nA = cA; const char* nB = cB;
    PG8_LOADVO(cvo, cur);
    PG8_STAGE_B(PG8_SB(0, 0), cB); PG8_STAGE_A(PG8_SA(0, 0), 0, false, 0); PG8_STAGE_B(PG8_SB(0, 1), cB + hstepB); PG8_STAGE_A(PG8_SA(0, 1), 1, false, 0);
    if (wr == 1) PG8_BAR;
    PG8_WAIT_V(4); PG8_BAR;
    PG8_STAGE_B(PG8_SB(1, 0), cB + kstep); PG8_STAGE_A(PG8_SA(1, 0), 0, false, kstep); PG8_STAGE_B(PG8_SB(1, 1), cB + hstepB + kstep);
    PG8_WAIT_V(6); PG8_BAR;
    for (;;) {
        const bool has_next = S.next(ui + 1, nxt);
        if (has_next) { nA = nxt.A; nB = nxt.B; PG8_LOADVO(nvo, nxt); }
        else { nA = cA; nB = cB;
#pragma unroll
            for (int h = 0; h < 2; ++h)
#pragma unroll
                for (int i = 0; i < 2; ++i) nvo[h][i] = cvo[h][i]; }
        for (int t = 0; t < nt; t += 2) {
            const bool last = (t == nt - 2);
            const size_t k1 = (size_t)(t + 1) * kstep;
            const size_t k2 = last ? 0 : (size_t)(t + 2) * kstep, k3 = k2 + kstep;
            const char* b2 = last ? nB : cB + (size_t)(t + 2) * kstep; const char* b3 = b2 + kstep;
            PG8_LDB(B0, 0, 0); PG8_SCHED; PG8_LDA(At, 0, 0); PG8_STAGE_A(PG8_SA(1, 1), 1, false, k1);
            PG8_WAIT_L(8); PG8_BAR; PG8_WAIT_L(0); PG8_MMA(0, 0, At, B0); PG8_BAR; PG8_SCHED;
            PG8_LDB(B1, 0, 1); PG8_STAGE_B(PG8_SB(0, 0), b2);
            PG8_BAR; PG8_WAIT_L(0); PG8_MMA(0, 1, At, B1); PG8_BAR;
            PG8_LDA(At, 0, 1); PG8_STAGE_A(PG8_SA(0, 0), 0, last, k2);
            PG8_BAR; PG8_WAIT_L(0); PG8_MMA(1, 0, At, B0); PG8_BAR; PG8_SCHED;
            PG8_STAGE_B(PG8_SB(0, 1), b2 + hstepB);
            PG8_WAIT_V(6); PG8_BAR; PG8_MMA(1, 1, At, B1); PG8_BAR;
            PG8_LDB(B0, 1, 0); PG8_SCHED; PG8_LDA(At, 1, 0); PG8_STAGE_A(PG8_SA(0, 1), 1, last, k2);
            PG8_WAIT_L(8); PG8_BAR; PG8_WAIT_L(0); PG8_MMA(0, 0, At, B0); PG8_BAR; PG8_SCHED;
            PG8_LDB(B1, 1, 1); PG8_STAGE_B(PG8_SB(1, 0), b3);
            PG8_BAR; PG8_WAIT_L(0); PG8_MMA(0, 1, At, B1); PG8_BAR;
            PG8_LDA(At, 1, 1); PG8_STAGE_A(PG8_SA(1, 0), 0, last, k3);
            PG8_BAR; PG8_WAIT_L(0); PG8_MMA(1, 0, At, B0); PG8_BAR; PG8_SCHED;
            PG8_STAGE_B(PG8_SB(1, 1), b3 + hstepB);
            PG8_WAIT_V(6); PG8_BAR; PG8_MMA(1, 1, At, B1); PG8_BAR;
        }
        E(acc, cur, wr, wc, fr, fq);
        if (!has_next) break;
#pragma unroll
        for (int a = 0; a < 2; ++a)
#pragma unroll
            for (int b = 0; b < 2; ++b)
#pragma unroll
                for (int m = 0; m < 4; ++m)
#pragma unroll
                    for (int n = 0; n < 2; ++n) acc[a][b][m][n] = (f32x4){0.f, 0.f, 0.f, 0.f};
        cur = nxt; cA = nA; cB = nB; ++ui;
#pragma unroll
        for (int h = 0; h < 2; ++h)
#pragma unroll
            for (int i = 0; i < 2; ++i) cvo[h][i] = nvo[h][i];
    }
    PG8_WAIT_V(0);
    if (wr == 0) PG8_BAR;
    PG8_BAR;
#undef PG8_SA
#undef PG8_SB
#undef PG8_GLDS
#undef PG8_STAGE_A
#undef PG8_STAGE_B
#undef PG8_LDA
#undef PG8_LDB
#undef PG8_MMA
#undef PG8_WAIT_V
#undef PG8_WAIT_L
#undef PG8_BAR
#undef PG8_SCHED
#undef PG8_LOADVO
}

struct SchedDense {
    int nM, nN, G, c, g; const char* A; const char* B; size_t a_tstep, b_tstep;
    __device__ __forceinline__ bool next(int i, Unit& u) const {
        const int nwg = nM * nN; const long L = (long)i * G + c; if (L >= nwg) return false;
        int wgid = (int)L; { const int q = nwg / 8, r = nwg % 8, xcd = wgid % 8, off = wgid / 8; wgid = (xcd < r ? xcd * (q + 1) : r * (q + 1) + (xcd - r) * q) + off; }
        const int nig = 8 * nN, gid = wgid / nig, fm = gid * 8, gsz = (nM - fm) < 8 ? (nM - fm) : 8;
        u.pm = fm + ((wgid % nig) % gsz); u.pn = (wgid % nig) / gsz; u.g = g; u.e = 0; u.nvalid = 256; u.pad = 0;
        u.A = A + (size_t)u.pm * a_tstep; u.B = B + (size_t)u.pn * b_tstep; u.rows = nullptr; u.gates = nullptr; return true;
    }
};
struct SchedDual {
    int nM, nN0, nN1, G, c; const char* A0; const char* A1; const char* B0; const char* B1; size_t a_tstep, b_tstep;
    __device__ __forceinline__ bool next(int i, Unit& u) const {
        const int n0 = nM * nN0, n1 = nM * nN1; int L = i * G + c; if (L >= n0 + n1) return false;
        const int g = (L >= n0) ? 1 : 0; if (g) L -= n0; const int nN = g ? nN1 : nN0;
        u.pm = L / nN; u.pn = L % nN; u.g = g; u.e = 0; u.nvalid = 256; u.pad = 0;
        u.A = (g ? A1 : A0) + (size_t)u.pm * a_tstep; u.B = (g ? B1 : B0) + (size_t)u.pn * b_tstep; u.rows = nullptr; u.gates = nullptr; return true;
    }
};
struct SchedMoE {
    const LAS int* bb; const LAS int* cnt; int NT, G, c; const char* Acompact; size_t a_tstep; const char* W; size_t w_estep, w_tstep; const int* slot_tok; const float* slot_gate;
    __device__ __forceinline__ bool next(int i, Unit& u) const {
        const int L = i * G + c; const int blk = L / NT, pn = L % NT;
        if (blk >= uni(bb[32])) return false;
        int e = 0;
#pragma unroll
        for (int j = 1; j < 32; ++j) e += (blk >= uni(bb[j])) ? 1 : 0;
        e = uni(e);
        const int rank0 = (blk - uni(bb[e])) * 256; int nv = uni(cnt[e]) - rank0; nv = nv > 256 ? 256 : nv;
        u.pm = blk; u.pn = pn; u.g = 0; u.e = e; u.nvalid = nv; u.pad = 0;
        u.A = unip(Acompact + (size_t)blk * a_tstep); u.B = unip(W + (size_t)e * w_estep + (size_t)pn * w_tstep);
        u.rows = (const int*)unip((const char*)(slot_tok + (size_t)e * CAP + rank0)); u.gates = (const float*)unip((const char*)(slot_gate + (size_t)e * CAP + rank0)); return true;
    }
};

struct EpiBf16 {
    bf16_t* O; int ldc;
    __device__ __forceinline__ void operator()(const f32x4 (&acc)[2][2][4][2], const Unit& u, int wr, int wc, int fr, int fq) const {
        const int row0 = u.pm * BM + wr * 64 + fr, col0 = u.pn * BM + wc * 32 + 8 * fq;
#pragma unroll
        for (int ai = 0; ai < 2; ++ai)
#pragma unroll
            for (int m = 0; m < 4; ++m) { bf16_t* rowp = O + (size_t)(row0 + ai * HALF + m * 16) * ldc + col0;
#pragma unroll
                for (int bj = 0; bj < 2; ++bj) { const f32x4 v0 = acc[ai][bj][m][0], v1 = acc[ai][bj][m][1];
                    u32x4 w; w.x = cvt_pk_bf16(v0[0], v0[1]); w.y = cvt_pk_bf16(v0[2], v0[3]); w.z = cvt_pk_bf16(v1[0], v1[1]); w.w = cvt_pk_bf16(v1[2], v1[3]);
                    *(u32x4*)(rowp + bj * HALF) = w; } }
    }
};
struct EpiGlu {
    const bf16_t* ZG; const float* bias; bf16_t* OL;
    __device__ __forceinline__ void operator()(const f32x4 (&acc)[2][2][4][2], const Unit& u, int wr, int wc, int fr, int fq) const {
        const int row0 = u.pm * BM + wr * 64 + fr, col0 = u.pn * BM + wc * 32 + 8 * fq;
        f32x4 bv[2][2];
#pragma unroll
        for (int bj = 0; bj < 2; ++bj)
#pragma unroll
            for (int n = 0; n < 2; ++n) bv[bj][n] = *(const f32x4*)(bias + col0 + bj * HALF + 4 * n);
#pragma unroll
        for (int ai = 0; ai < 2; ++ai)
#pragma unroll
            for (int m = 0; m < 4; ++m) { const int row = row0 + ai * HALF + m * 16;
#pragma unroll
                for (int bj = 0; bj < 2; ++bj) { const u32x4 zw = *(const u32x4*)(ZG + (size_t)row * 512 + col0 + bj * HALF);
                    const float z[8] = {bflo(zw.x), bfhi(zw.x), bflo(zw.y), bfhi(zw.y), bflo(zw.z), bfhi(zw.z), bflo(zw.w), bfhi(zw.w)}; float o[8];
#pragma unroll
                    for (int n = 0; n < 2; ++n)
#pragma unroll
                        for (int j = 0; j < 4; ++j) { const float a = acc[ai][bj][m][n][j] + bv[bj][n][j]; o[n * 4 + j] = z[n * 4 + j] * __builtin_amdgcn_rcpf(1.0f + __expf(-a)); }
                    u32x4 w; w.x = cvt_pk_bf16(o[0], o[1]); w.y = cvt_pk_bf16(o[2], o[3]); w.z = cvt_pk_bf16(o[4], o[5]); w.w = cvt_pk_bf16(o[6], o[7]);
                    *(u32x4*)(OL + (size_t)row * 1024 + 512 + col0 + bj * HALF) = w; } }
    }
};
struct EpiBf16Dual {
    bf16_t* O0; int ldc0; bf16_t* O1; int ldc1;
    __device__ __forceinline__ void operator()(const f32x4 (&acc)[2][2][4][2], const Unit& u, int wr, int wc, int fr, int fq) const {
        EpiBf16 e; e.O = u.g ? O1 : O0; e.ldc = u.g ? ldc1 : ldc0; e(acc, u, wr, wc, fr, fq);
    }
};
struct EpiSwiglu {
    bf16_t* Z; const float* bias;
    __device__ __forceinline__ void operator()(const f32x4 (&acc)[2][2][4][2], const Unit& u, int wr, int wc, int fr, int fq) const {
        const int row0 = u.pm * BM + wr * 64 + fr, c0 = u.pn * 128 + wc * 32 + 8 * fq;
        const float* be = bias + (size_t)u.e * 2048 + c0;
        const f32x4 bg0 = *(const f32x4*)(be), bg1 = *(const f32x4*)(be + 4), bl0 = *(const f32x4*)(be + 1024), bl1 = *(const f32x4*)(be + 1028);
#pragma unroll
        for (int ai = 0; ai < 2; ++ai)
#pragma unroll
            for (int m = 0; m < 4; ++m) {
                float o[8];
#pragma unroll
                for (int n = 0; n < 2; ++n) { const f32x4 g4 = acc[ai][0][m][n] + (n ? bg1 : bg0), l4 = acc[ai][1][m][n] + (n ? bl1 : bl0);
#pragma unroll
                    for (int j = 0; j < 4; ++j) { const float g = fminf(g4[j], 7.0f), l = fminf(fmaxf(l4[j], -7.0f), 7.0f);
                        o[n * 4 + j] = g * __builtin_amdgcn_rcpf(1.0f + __expf(-1.702f * g)) * (l + 1.0f); } }
                u32x4 w; w.x = cvt_pk_bf16(o[0], o[1]); w.y = cvt_pk_bf16(o[2], o[3]); w.z = cvt_pk_bf16(o[4], o[5]); w.w = cvt_pk_bf16(o[6], o[7]);
                *(u32x4*)(Z + (size_t)(row0 + ai * HALF + m * 16) * 1024 + c0) = w; }
    }
};
struct EpiMoeOut {
    bf16_t* Y2; const float* bias;
    __device__ __forceinline__ void operator()(const f32x4 (&acc)[2][2][4][2], const Unit& u, int wr, int wc, int fr, int fq) const {
        const int r0 = wr * 64 + fr, col0 = u.pn * BM + wc * 32 + 8 * fq;
        const float* be = bias + (size_t)u.e * 1024 + col0;
        f32x4 bv[2][2];
#pragma unroll
        for (int bj = 0; bj < 2; ++bj)
#pragma unroll
            for (int n = 0; n < 2; ++n) bv[bj][n] = *(const f32x4*)(be + bj * HALF + 4 * n);
#pragma unroll
        for (int ai = 0; ai < 2; ++ai)
#pragma unroll
            for (int m = 0; m < 4; ++m) { const int r = r0 + ai * HALF + m * 16; const float gt = (r < u.nvalid) ? u.gates[r] : 0.f;
                bf16_t* rowp = Y2 + (size_t)(u.pm * BM + r) * 1024 + col0;
#pragma unroll
                for (int bj = 0; bj < 2; ++bj) { const f32x4 v0 = (acc[ai][bj][m][0] + bv[bj][0]) * gt, v1 = (acc[ai][bj][m][1] + bv[bj][1]) * gt;
                    u32x4 w; w.x = cvt_pk_bf16(v0[0], v0[1]); w.y = cvt_pk_bf16(v0[2], v0[3]); w.z = cvt_pk_bf16(v1[0], v1[1]); w.w = cvt_pk_bf16(v1[2], v1[3]);
                    *(u32x4*)(rowp + bj * HALF) = w; } }
    }
};
}


namespace att {
constexpr int NW = 8, QBLK = 32, KVBLK = 64, DV = 128;
typedef short s16x4 __attribute__((ext_vector_type(4)));
typedef float f32x16 __attribute__((ext_vector_type(16)));
#define SBAR() __builtin_amdgcn_sched_barrier(0)
__device__ __forceinline__ int crow(int r, int hi) { return (r & 3) + 8 * (r >> 2) + 4 * hi; }
__device__ __forceinline__ unsigned cvtpk(float lo, float hi) { unsigned r; asm volatile("v_cvt_pk_bf16_f32 %0, %1, %2" : "=v"(r) : "v"(lo), "v"(hi)); return r; }
template <int DK> __device__ __forceinline__ int kswz(int row, int colB) { return row * (DK * 2) + (colB ^ ((row & 7) << 4)); }
constexpr float THR = 8.f;

template <int DK, bool WINDOW>
__device__ __forceinline__ void partialSM(f32x16& p0, f32x16& p1, float& m_reg, float& mn, float& alpha, const bool masked, const int mbase) {
  constexpr float SCALE = (DK == 128) ? 0.088388347648318440f : 0.072168783648703220f;
  constexpr float C = SCALE * 1.4426950408889634f;
  if (WINDOW && masked) {
#pragma unroll
    for (int r = 0; r < 16; ++r) { const int d0 = mbase + (r & 3) + 8 * (r >> 2); const int d1 = d0 + 32;
      p0[r] = (d0 < -128 || d0 > 128) ? -1e30f : p0[r]; p1[r] = (d1 < -128 || d1 > 128) ? -1e30f : p1[r]; }
  }
  float pmax = p0[0];
#pragma unroll
  for (int r = 1; r < 16; ++r) pmax = fmaxf(pmax, p0[r]);
#pragma unroll
  for (int r = 0; r < 16; ++r) pmax = fmaxf(pmax, p1[r]);
  { auto rr = __builtin_amdgcn_permlane32_swap(__float_as_uint(pmax), __float_as_uint(pmax), false, false);
    pmax = fmaxf(__uint_as_float(rr[0]), __uint_as_float(rr[1])); }
  if (__builtin_expect(__all(pmax - m_reg <= THR / SCALE), 1)) { mn = m_reg; alpha = 1.f; }
  else { mn = fmaxf(m_reg, pmax); alpha = __builtin_amdgcn_exp2f((m_reg - mn) * C); m_reg = mn; }
  const float mnC = -mn * C;
#pragma unroll
  for (int r = 0; r < 16; ++r) p0[r] = fmaf(p0[r], C, mnC);
#pragma unroll
  for (int r = 0; r < 16; ++r) p1[r] = fmaf(p1[r], C, mnC);
#pragma unroll
  for (int r = 0; r < 16; ++r) p0[r] = __builtin_amdgcn_exp2f(p0[r]);
}
__device__ __forceinline__ void finishSM(f32x16& p0, f32x16& p1, float alpha, float& l_reg, bf16x8& pa0, bf16x8& pa1, bf16x8& pa2, bf16x8& pa3) {
#pragma unroll
  for (int r = 0; r < 16; ++r) p1[r] = __builtin_amdgcn_exp2f(p1[r]);
  float ps = 0;
#pragma unroll
  for (int r = 0; r < 16; ++r) ps += p0[r];
#pragma unroll
  for (int r = 0; r < 16; ++r) ps += p1[r];
  { auto rr = __builtin_amdgcn_permlane32_swap(__float_as_uint(ps), __float_as_uint(ps), false, false);
    ps = __uint_as_float(rr[0]) + __uint_as_float(rr[1]); }
  l_reg = l_reg * alpha + ps;
#define PK4(P, BASE, OUT) do { unsigned a0 = cvtpk(P[BASE + 0], P[BASE + 1]), a1 = cvtpk(P[BASE + 2], P[BASE + 3]);   \
    unsigned b0 = cvtpk(P[BASE + 4], P[BASE + 5]), b1 = cvtpk(P[BASE + 6], P[BASE + 7]);                              \
    auto r0 = __builtin_amdgcn_permlane32_swap(a0, b0, false, false); auto r1 = __builtin_amdgcn_permlane32_swap(a1, b1, false, false); \
    u32x4 w = {r0[0], r1[0], r0[1], r1[1]}; OUT = *reinterpret_cast<bf16x8*>(&w); } while (0)
  PK4(p0, 0, pa0); PK4(p0, 8, pa1); PK4(p1, 0, pa2); PK4(p1, 8, pa3);
#undef PK4
}
template <int DK>
__device__ __forceinline__ void qkt(f32x16& p0, f32x16& p1, const LAS char* Ks, const bf16x8* qr, int r32, int hi) {
  p0 = f32x16{}; p1 = f32x16{};
#pragma unroll
  for (int d0 = 0; d0 < DK / 16; ++d0) { const int cb = (d0 * 16 + hi * 8) * 2;
    const bf16x8 b0 = *reinterpret_cast<const LAS bf16x8*>(Ks + kswz<DK>(r32, cb));
    const bf16x8 b1 = *reinterpret_cast<const LAS bf16x8*>(Ks + kswz<DK>(32 + r32, cb));
    p0 = __builtin_amdgcn_mfma_f32_32x32x16_bf16(b0, qr[d0], p0, 0, 0, 0);
    p1 = __builtin_amdgcn_mfma_f32_32x32x16_bf16(b1, qr[d0], p1, 0, 0, 0); }
}
__device__ __forceinline__ int v_st(int k, int c) { const int kk = (k & ~0xC) | ((k & 4) << 1) | ((k & 8) >> 1); return ((kk >> 3) * 4 + (c >> 5)) * 512 + ((kk & 7) * 32 + (c & 31)) * 2; }
__device__ __forceinline__ int v_rd_base(int lane) { return ((lane & 3) << 3) | (((lane >> 2) & 3) << 6) | (((lane >> 4) & 1) << 5) | (((lane >> 5) & 1) << 8); }
constexpr int v_rd_off(int d0, int ks, int half) { return d0 * 512 + ks * 4096 + half * 2048; }
template <int OFF> __device__ __forceinline__ s16x4 tr_read(int vb) {
  s16x4 r; asm volatile("ds_read_b64_tr_b16 %0, %1 offset:%2" : "=&v"(r) : "v"(vb), "i"(OFF) : "memory"); return r;
}
template <int D0> __device__ __forceinline__ void pv_one(f32x16& od, int vb, bf16x8 pa0, bf16x8 pa1, bf16x8 pa2, bf16x8 pa3) {
  const s16x4 l0 = tr_read<v_rd_off(D0, 0, 0)>(vb), h0 = tr_read<v_rd_off(D0, 0, 1)>(vb), l1 = tr_read<v_rd_off(D0, 1, 0)>(vb), h1 = tr_read<v_rd_off(D0, 1, 1)>(vb);
  const s16x4 l2 = tr_read<v_rd_off(D0, 2, 0)>(vb), h2 = tr_read<v_rd_off(D0, 2, 1)>(vb), l3 = tr_read<v_rd_off(D0, 3, 0)>(vb), h3 = tr_read<v_rd_off(D0, 3, 1)>(vb);
  asm volatile("s_waitcnt lgkmcnt(0)" ::: "memory"); SBAR();
#define PK(L, H) (bf16x8){L[0], L[1], L[2], L[3], H[0], H[1], H[2], H[3]}
  od = __builtin_amdgcn_mfma_f32_32x32x16_bf16(pa0, PK(l0, h0), od, 0, 0, 0);
  od = __builtin_amdgcn_mfma_f32_32x32x16_bf16(pa1, PK(l1, h1), od, 0, 0, 0);
  od = __builtin_amdgcn_mfma_f32_32x32x16_bf16(pa2, PK(l2, h2), od, 0, 0, 0);
  od = __builtin_amdgcn_mfma_f32_32x32x16_bf16(pa3, PK(l3, h3), od, 0, 0, 0);
#undef PK
}
__device__ __forceinline__ void pv_d0(f32x16* o, int vb, bf16x8 pa0, bf16x8 pa1, bf16x8 pa2, bf16x8 pa3) {
  pv_one<0>(o[0], vb, pa0, pa1, pa2, pa3); pv_one<1>(o[1], vb, pa0, pa1, pa2, pa3); pv_one<2>(o[2], vb, pa0, pa1, pa2, pa3); pv_one<3>(o[3], vb, pa0, pa1, pa2, pa3);
}

struct Unit {
  const bf16_t* Q; int ldq;
  const bf16_t* K; int ldk;
  const bf16_t* KR; int ldkr;
  const bf16_t* V; int ldv;
  bf16_t* O; int ldo;
  int NT;
  int kofs;
  int q0;
  float sink; int has_sink;
  const float* rope; int rope_row, rope_col_base;
};

template <int DK, bool WINDOW, int SD, bool SIMPLE>
__device__ __forceinline__ void attn_unit(const Unit& U, LAS char* lds) {
  constexpr int SHM_V = KVBLK * DV * 2, SHM_K = KVBLK * DK * 2;
  constexpr float SCALE = (DK == 128) ? 0.088388347648318440f : 0.072168783648703220f;
  constexpr float C = SCALE * 1.4426950408889634f;
  constexpr int NKC = (DK == 128) ? 2 : 3;
  int tid = threadIdx.x; asm volatile("" : "+v"(tid));
  const int wid = tid >> 6, lane = tid & 63, r32 = lane & 31, hi = lane >> 5;
  LAS char* V_lds = lds; LAS char* K_lds = lds + 2 * SHM_V;
  LAS float* wsf = (LAS float*)(lds + 2 * SHM_V + 2 * SHM_K) + wid * 64; LAS float* li_l = wsf; LAS float* al_l = wsf + 32;
  float m_reg = -1e30f, l_reg = 0; f32x16 o[4] = {}; bf16x8 qr[DK / 16];
  const bf16_t* Qw = U.Q + (long)(wid * QBLK + r32) * U.ldq + hi * 8;
#pragma unroll
  for (int d0 = 0; d0 < DK / 16; ++d0) qr[d0] = *reinterpret_cast<const bf16x8*>(Qw + d0 * 16);
  if (DK == 192 && U.rope != nullptr) {
    const int pos = U.q0 + wid * QBLK + r32; const int ri = pos >> 6, ci = pos & 63;
#pragma unroll
    for (int hf = 0; hf < 2; ++hf) { const float* tp = U.rope + ((hf ? ci : ri) * 16 + hi * 8) * 2;
      bf16x8 x1 = qr[8 + 2 * hf], x2 = qr[9 + 2 * hf];
#pragma unroll
      for (int i = 0; i < 8; ++i) { const float c = tp[2 * i], sn = tp[2 * i + 1]; const float a = bf2f((unsigned short)x1[i]), b = bf2f((unsigned short)x2[i]);
        x1[i] = (short)f2bf(a * c - b * sn); x2[i] = (short)f2bf(b * c + a * sn); }
      qr[8 + 2 * hf] = x1; qr[9 + 2 * hf] = x2; }
  }
  const int sr = tid >> 4, sc = (tid & 15) * 8, vst0 = v_st(sr, sc), vst1 = v_st(32 + sr, sc);
  int krw[NKC], kcs[NKC], kdst[NKC];
#pragma unroll
  for (int i = 0; i < NKC; ++i) { const int id = tid + 512 * i; if (DK == 128) { krw[i] = (i == 0) ? sr : 32 + sr; kcs[i] = sc; } else { krw[i] = id / 24; kcs[i] = (id % 24) * 8; }
    kdst[i] = kswz<DK>(krw[i], kcs[i] * 2); }
  const int vb0 = (int)(uintptr_t)V_lds + v_rd_base(lane);
  struct { bf16x8 vs0, vs1, ks[NKC]; } sr_[SD];
  constexpr int SO = SD - 1;
  const int kofs = U.kofs;
#define KROW(j) (64 * (j) + (((j) >= 4) ? kofs : 0))
#define SLOAD(i, jt) do { const int _k0 = KROW(jt); sr_[i].vs0 = *reinterpret_cast<const bf16x8*>(&U.V[(long)(_k0 + sr) * U.ldv + sc]); sr_[i].vs1 = *reinterpret_cast<const bf16x8*>(&U.V[(long)(_k0 + 32 + sr) * U.ldv + sc]); \
    _Pragma("unroll") for (int _c = 0; _c < NKC; ++_c) { if (DK == 128 || kcs[_c] < 128) sr_[i].ks[_c] = *reinterpret_cast<const bf16x8*>(&U.K[(long)(_k0 + krw[_c]) * U.ldk + kcs[_c]]); \
      else sr_[i].ks[_c] = *reinterpret_cast<const bf16x8*>(&U.KR[(long)(_k0 + krw[_c]) * U.ldkr + (kcs[_c] - 128)]); } } while (0)
#define SWRITE(b, i) do { *(LAS bf16x8*)(V_lds + (b) * SHM_V + vst0) = sr_[i].vs0; *(LAS bf16x8*)(V_lds + (b) * SHM_V + vst1) = sr_[i].vs1; \
    _Pragma("unroll") for (int _c = 0; _c < NKC; ++_c) *(LAS bf16x8*)(K_lds + (b) * SHM_K + kdst[_c]) = sr_[i].ks[_c]; } while (0)
#define SWAIT() asm volatile("s_waitcnt vmcnt(%0)" :: "n"(SD == 2 ? 2 + NKC : 0) : "memory")
#define RESC(a) do { if (__any((a) < 1.f)) { if (hi == 0) al_l[r32] = (a); asm volatile("s_waitcnt lgkmcnt(0)" ::: "memory"); \
    _Pragma("unroll") for (int d = 0; d < 4; ++d) _Pragma("unroll") for (int r = 0; r < 16; ++r) o[d][r] *= al_l[crow(r, hi)]; } } while (0)
  const int qpos = U.q0 + wid * QBLK + r32;
#define MBASE(jt) (kofs + 64 * (jt) - 256 - qpos + 4 * hi)
  bf16x8 pa0, pa1, pa2, pa3; const int NT = U.NT;
  if constexpr (SIMPLE) {
    f32x16 p0, p1; float mn, al;
    SLOAD(0, 0); asm volatile("s_waitcnt vmcnt(0)" ::: "memory"); SWRITE(0, 0); __syncthreads();
    for (int j = 0; j < NT; ++j) {
      const int bsel = j & 1;
      if (j + 1 < NT) SLOAD(0, j + 1);
      SBAR(); qkt<DK>(p0, p1, K_lds + bsel * SHM_K, qr, r32, hi);
      partialSM<DK, WINDOW>(p0, p1, m_reg, mn, al, j >= 4, MBASE(j));
      RESC(al);
      finishSM(p0, p1, al, l_reg, pa0, pa1, pa2, pa3); SBAR();
      pv_d0(o, vb0 + bsel * SHM_V, pa0, pa1, pa2, pa3);
      if (j + 1 < NT) { asm volatile("s_waitcnt vmcnt(0)" ::: "memory"); SWRITE(bsel ^ 1, 0); }
      __syncthreads();
    }
  } else {
  f32x16 pA0, pA1, pB0, pB1; float mnA, mnB, alA, alB;
  SLOAD(0, 0); asm volatile("s_waitcnt vmcnt(0)" ::: "memory"); SWRITE(0, 0); __syncthreads();
  qkt<DK>(pA0, pA1, K_lds, qr, r32, hi); partialSM<DK, WINDOW>(pA0, pA1, m_reg, mnA, alA, false, 0);
  SLOAD(SO, 1); if (SD == 2 && 2 < NT) SLOAD(0, 2);
  SWAIT(); SWRITE(1, SO); __syncthreads();
  for (int j = 1; j + 1 < NT; j += 2) {
    SBAR(); qkt<DK>(pB0, pB1, K_lds + SHM_K, qr, r32, hi);
    finishSM(pA0, pA1, alA, l_reg, pa0, pa1, pa2, pa3); SBAR();
    SLOAD(SO, j + SD); SBAR();
    pv_d0(o, vb0, pa0, pa1, pa2, pa3); partialSM<DK, WINDOW>(pB0, pB1, m_reg, mnB, alB, j >= 4, MBASE(j));
    __syncthreads(); SWAIT(); SWRITE(0, 0);
    RESC(alB); __syncthreads();
    SBAR(); qkt<DK>(pA0, pA1, K_lds, qr, r32, hi);
    finishSM(pB0, pB1, alB, l_reg, pa0, pa1, pa2, pa3); SBAR();
    if (SD == 1 || j + 3 < NT) SLOAD(0, j + 1 + SD); SBAR();
    pv_d0(o, vb0 + SHM_V, pa0, pa1, pa2, pa3); partialSM<DK, WINDOW>(pA0, pA1, m_reg, mnA, alA, j + 1 >= 4, MBASE(j + 1));
    __syncthreads(); SWAIT(); SWRITE(1, SO);
    RESC(alA); __syncthreads();
  }
  SBAR(); qkt<DK>(pB0, pB1, K_lds + SHM_K, qr, r32, hi);
  finishSM(pA0, pA1, alA, l_reg, pa0, pa1, pa2, pa3); SBAR();
  pv_d0(o, vb0, pa0, pa1, pa2, pa3); partialSM<DK, WINDOW>(pB0, pB1, m_reg, mnB, alB, NT - 1 >= 4, MBASE(NT - 1));
  __syncthreads(); RESC(alB);
  finishSM(pB0, pB1, alB, l_reg, pa0, pa1, pa2, pa3); SBAR();
  pv_d0(o, vb0 + SHM_V, pa0, pa1, pa2, pa3);
  }
  if (WINDOW && U.has_sink) l_reg += __builtin_amdgcn_exp2f(U.sink * 1.4426950408889634f - m_reg * C);
  if (hi == 0) li_l[r32] = l_reg; asm volatile("s_waitcnt lgkmcnt(0)" ::: "memory");
  float rli[16];
#pragma unroll
  for (int r = 0; r < 16; ++r) rli[r] = __builtin_amdgcn_rcpf(li_l[crow(r, hi)]);
  bf16_t* Ow = U.O + (long)(wid * QBLK) * U.ldo;
#pragma unroll
  for (int r = 0; r < 16; ++r) { const int orow = crow(r, hi);
#pragma unroll
    for (int d0 = 0; d0 < 4; ++d0) Ow[(long)orow * U.ldo + d0 * 32 + r32] = (bf16_t)f2bf(o[d0][r] * rli[r]); }
  __syncthreads();
#undef KROW
#undef SLOAD
#undef SWRITE
#undef SWAIT
#undef RESC
#undef MBASE
}
}

struct Args { const float* in[34]; float* out; unsigned char* ws; };

__device__ __forceinline__ void transpose_item(const float* W, int ldw, int K, bf16_t* WT, int k0, int n0, int drow0, LAS float* scr, int lane) {
#pragma unroll 8
    for (int i = 0; i < 32; ++i) { const int kk = 2 * i + (lane >> 5); scr[kk * 33 + (lane & 31)] = W[(size_t)(k0 + kk) * ldw + n0 + (lane & 31)]; }
    LDS_WAIT(); asm volatile("" ::: "memory");
    const int c = lane & 7;
#pragma unroll
    for (int j = 0; j < 4; ++j) { const int n = (lane >> 3) + 8 * j; const LAS float* s = scr + (8 * c) * 33 + n;
        u32x4 o; o.x = pk2(s[0 * 33], s[1 * 33]); o.y = pk2(s[2 * 33], s[3 * 33]); o.z = pk2(s[4 * 33], s[5 * 33]); o.w = pk2(s[6 * 33], s[7 * 33]);
        *(u32x4*)(WT + (size_t)(drow0 + n) * K + k0 + 8 * c) = o; }
    LDS_WAIT(); asm volatile("" ::: "memory");
}

__device__ __forceinline__ bool conv_group(int& r, const float* W, int nmat, int K, int N, bf16_t* WT, int ldrows, LAS float* scr, int lane) {
    const int per = (K / 64) * (N / 32); if (r >= nmat * per) { r -= nmat * per; return false; }
    const int mi = r / per, q = r % per, kb = q / (N / 32), nb = q % (N / 32);
    transpose_item(W + (size_t)mi * K * N, N, K, WT + (size_t)mi * ldrows * K, kb * 64, nb * 32, nb * 32, scr, lane); return true;
}

typedef const Args __attribute__((address_space(4))) CArgs;
#define PHASE_ARGS() CArgs* A_ = (CArgs*)__builtin_amdgcn_kernarg_segment_ptr(); asm volatile("" : "+s"(A_)); unsigned char* const ws = A_->ws; (void)ws
#define IN(k) (A_->in[k])
#define WSP(T, off) ((T*)(ws + (off)))
__global__ void __launch_bounds__(NTHR, 2) fwd_kernel(Args args) {
    extern __shared__ __attribute__((aligned(16))) unsigned char lds_raw[];
    LAS unsigned char* lds = (LAS unsigned char*)lds_raw;
    const int G = gridDim.x; const int bx = blockIdx.x; const int vcu = (G % 8 == 0) ? (bx % 8) * (G / 8) + bx / 8 : bx;
    volatile LAS unsigned* MISC = (volatile LAS unsigned*)(lds + LDS_MISC);
    for (int u = threadIdx.x; u < (LDS_BYTES - LDS_MISC) / 4; u += NTHR) MISC[u] = 0u;
    __syncthreads();
    XcdBarrier bar = xcd_barrier_post((unsigned*)(args.ws + WS_CTL) + CW_BAR, MISC + 0);
#define GRID_BAR() xcd_barrier(bar)
    const int NGW = G * NWAVES;

    {
        PHASE_IDS(); PHASE_ARGS();
        const float* in_c = IN(1); const float* in_cctx = IN(3); const float* w_mod = IN(4); const float* b_mod = IN(5);
        const float* w_mix_out = IN(8); const float* w_exp_in = IN(11); const float* w_exp_out = IN(13);
        const float* w_in_ab = IN(15); const float* w_glu = IN(26); const float* w_in_cd = IN(28); const float* w_uq = IN(31); const float* w_ukv = IN(32);
        float* MOD = WSP(float, WS_MOD); bf16_t* WexpIn = WSP(bf16_t, WS_WEXPIN); bf16_t* WexpOut = WSP(bf16_t, WS_WEXPOUT); bf16_t* Wmix = WSP(bf16_t, WS_WMIX);
        bf16_t* WinAB = WSP(bf16_t, WS_WINAB); bf16_t* WinCD = WSP(bf16_t, WS_WINCD); bf16_t* Wglu = WSP(bf16_t, WS_WGLU); bf16_t* Wuq = WSP(bf16_t, WS_WUQ); bf16_t* Wukv = WSP(bf16_t, WS_WUKV);
        float* T32 = WSP(float, WS_ROPE); float* T16 = T32 + 64 * 32 * 2;
        LAS float* scr = (LAS float*)(lds + LDS_STAGE + wave * 16384);
        constexpr int I_IN = 16 * 64, I_OUT = 16 * 32, I_MIX = 16 * 32;
        constexpr int NIT = 128 * (I_IN + I_OUT) + 4 * I_MIX + 2 * (16 * 48 + 16 * 50 + 8 * 16 + 4 * 24 + 4 * 32);
        for (int it = gw; it < NIT; it += NGW) {
            int r = it;
            if (r < 128 * I_IN) { const int le = r / I_IN, q = r % I_IN, kb = q / 64, nb = q % 64, n0 = nb * 32;
                const int drow0 = (n0 < 1024) ? ((n0 >> 7) * 256 + (n0 & 127)) : (((n0 - 1024) >> 7) * 256 + 128 + ((n0 - 1024) & 127));
                transpose_item(w_exp_in + (size_t)le * 1024 * 2048, 2048, 1024, WexpIn + (size_t)le * 2048 * 1024, kb * 64, n0, drow0, scr, lane); continue; }
            r -= 128 * I_IN;
            if (r < 128 * I_OUT) { const int le = r / I_OUT, q = r % I_OUT, kb = q / 32, nb = q % 32;
                transpose_item(w_exp_out + (size_t)le * 1024 * 1024, 1024, 1024, WexpOut + (size_t)le * 1024 * 1024, kb * 64, nb * 32, nb * 32, scr, lane); continue; }
            r -= 128 * I_OUT;
            if (conv_group(r, w_mix_out, 4, 1024, 1024, Wmix, 1024, scr, lane)) continue;
            if (conv_group(r, w_in_ab, 2, 1024, 1536, WinAB, 1536, scr, lane)) continue;
            if (conv_group(r, w_in_cd, 2, 1024, 1600, WinCD, 1792, scr, lane)) continue;
            if (conv_group(r, w_glu, 2, 512, 512, Wglu, 512, scr, lane)) continue;
            if (conv_group(r, w_uq, 2, 256, 768, Wuq, 768, scr, lane)) continue;
            (void)conv_group(r, w_ukv, 2, 256, 1024, Wukv, 1024, scr, lane);
        }
        for (int i = vcu * NTHR + tid; i < 2 * 192 * 1024 / 8; i += G * NTHR) { const int mi = i / (192 * 128), q = i % (192 * 128); *(u32x4*)(WinCD + ((size_t)mi * 1792 + 1600) * 1024 + (size_t)q * 8) = (u32x4){0u, 0u, 0u, 0u}; }
        for (int i = vcu * NTHR + tid; i < 64 * 32 + 64 * 16; i += G * NTHR) {
            if (i < 64 * 32) { const int idx = i >> 5, j = i & 31; const float ang = (float)idx * expf(-(float)j * (1.0f / 32.0f) * 9.210340371976184f); float sn, cs; sincosf(ang, &sn, &cs); T32[i * 2] = cs; T32[i * 2 + 1] = sn; }
            else { const int q = i - 64 * 32, idx = q >> 4, j = q & 15; const float ang = (float)idx * expf(-(float)j * (1.0f / 16.0f) * 9.210340371976184f); float sn, cs; sincosf(ang, &sn, &cs); T16[q * 2] = cs; T16[q * 2 + 1] = sn; }
        }

        {
            const float* lam_re = IN(18); const float* lam_im = IN(19); const float* log_dt = IN(20); const float* b_re = IN(21); const float* b_im = IN(22); const float* c_re = IN(23); const float* c_im = IN(24);
            bf16_t* TFb = WSP(bf16_t, WS_TF); bf16_t* SFb = WSP(bf16_t, WS_SF); bf16_t* WFb = WSP(bf16_t, WS_WF); float* LAM16 = WSP(float, WS_LAM16);
            __syncthreads();
            LAS f32x2* Pw = (LAS f32x2*)(lds + LDS_STAGE);
            LAS f32x2* Bb = Pw + 17 * 64;
            LAS f32x2* Cc = Bb + 64 * 16;
            for (int unit = vcu; unit < 128; unit += G) {
                const int dir = (unit >> 5) & 1;
                for (int idx = tid; idx < 17 * 64; idx += NTHR) { const int tau = idx >> 6, n = idx & 63; const float lr = lam_re[unit * 64 + n], lim = lam_im[unit * 64 + n], dt = expf(log_dt[unit]);
                    const float mag = expf((float)tau * dt * lr); float sn, cs; sincosf((float)tau * dt * lim, &sn, &cs); Pw[idx] = (f32x2){mag * cs, mag * sn}; }
                for (int idx = tid; idx < 64 * 16; idx += NTHR) { const int n = idx >> 4; const float lr = lam_re[unit * 64 + n], lim = lam_im[unit * 64 + n], dt = expf(log_dt[unit]);
                    const float mag = expf(dt * lr); float sn, cs; sincosf(dt * lim, &sn, &cs); const float nr = mag * cs - 1.0f, ni = mag * sn; const float den = 1.0f / (lr * lr + lim * lim);
                    const float cbr = (nr * lr + ni * lim) * den, cbi = (ni * lr - nr * lim) * den;
                    const float br = b_re[(size_t)unit * 1024 + idx], bi = b_im[(size_t)unit * 1024 + idx]; Bb[idx] = (f32x2){cbr * br - cbi * bi, cbr * bi + cbi * br};
                    Cc[idx] = (f32x2){c_re[(size_t)unit * 1024 + idx], c_im[(size_t)unit * 1024 + idx]}; }
                __syncthreads();
                for (int idx = tid; idx < 16 * 512; idx += NTHR) { const int f = idx >> 9, l = (idx >> 3) & 63, i = idx & 7; const int cout = l & 15, kq = l >> 4, sl = kq >> 1, cin = (kq & 1) * 8 + i;
                    const int tau = dir == 0 ? f - sl : f - 1 + sl; float v = 0.f;
                    if (tau >= 0 && tau <= 15) { for (int n = 0; n < 64; ++n) { const f32x2 c = Cc[cout * 64 + n], pw = Pw[tau * 64 + n], bb = Bb[n * 16 + cin];
                        const float tr = c.x * pw.x - c.y * pw.y, ti = c.x * pw.y + c.y * pw.x; v += tr * bb.x - ti * bb.y; } }
                    TFb[(size_t)unit * 8192 + idx] = (bf16_t)f2bf(v); }
                for (int idx = tid; idx < 64 * 512; idx += NTHR) { const int fr = idx >> 9, l = (idx >> 3) & 63, i = idx & 7;
                    { const int mt = fr >> 3, j = fr & 7; const int kp = mt * 16 + (l & 15), n = kp >> 1, ri = kp & 1; const int kidx = j * 32 + (l >> 4) * 8 + i, sidx = kidx >> 4, cin = kidx & 15;
                      const int e = dir == 0 ? 15 - sidx : sidx; const f32x2 pw = Pw[e * 64 + n], bb = Bb[n * 16 + cin]; const float zr = pw.x * bb.x - pw.y * bb.y, zi = pw.x * bb.y + pw.y * bb.x;
                      SFb[(size_t)unit * 32768 + idx] = (bf16_t)f2bf(ri ? zi : zr); }
                    { const int t = fr >> 2, ks = fr & 3; const int cout = l & 15, kp = ks * 32 + (l >> 4) * 8 + i, n = kp >> 1, ri = kp & 1; const int e = dir == 0 ? t + 1 : 16 - t;
                      const f32x2 c = Cc[cout * 64 + n], pw = Pw[e * 64 + n]; const float zr = c.x * pw.x - c.y * pw.y, zi = c.x * pw.y + c.y * pw.x;
                      WFb[(size_t)unit * 32768 + idx] = (bf16_t)f2bf(ri ? -zi : zr); } }
                if (tid < 128) { const f32x2 pw = Pw[16 * 64 + (tid >> 1)]; LAM16[unit * 128 + tid] = (tid & 1) ? pw.y : pw.x; }
                __syncthreads();
            }
        }
        __syncthreads();
        LAS float* sl = (LAS float*)(lds + LDS_STAGE);
        LAS float* red = (LAS float*)(lds + LDS_STAGE + 1024 * 20 * 4);
        for (int i = tid; i < 17 * 1024; i += NTHR) { const int row = i >> 10, k = i & 1023; const float v = (row < 16) ? in_c[row * 1024 + k] : in_cctx[k]; sl[k * 20 + row] = v / (1.0f + __expf(-v)); }
        __syncthreads();
        for (int it = vcu; it < 4 * 96; it += G) {
            const int l = it / 96, cb = it % 96, col = cb * 64 + (tid & 63), kg = tid >> 6;
            float a[17];
#pragma unroll
            for (int r = 0; r < 17; ++r) a[r] = 0.f;
            const float* wp = w_mod + ((size_t)l * 1024 + kg * 128) * 6144 + col;
#pragma unroll 4
            for (int k = 0; k < 128; ++k) { const float w = wp[(size_t)k * 6144]; const LAS float* sp = sl + (kg * 128 + k) * 20;
                const f32x4 s0 = *(const LAS f32x4*)(sp), s1 = *(const LAS f32x4*)(sp + 4), s2 = *(const LAS f32x4*)(sp + 8), s3 = *(const LAS f32x4*)(sp + 12); const float s4 = sp[16];
                a[0] += s0[0] * w; a[1] += s0[1] * w; a[2] += s0[2] * w; a[3] += s0[3] * w; a[4] += s1[0] * w; a[5] += s1[1] * w; a[6] += s1[2] * w; a[7] += s1[3] * w;
                a[8] += s2[0] * w; a[9] += s2[1] * w; a[10] += s2[2] * w; a[11] += s2[3] * w; a[12] += s3[0] * w; a[13] += s3[1] * w; a[14] += s3[2] * w; a[15] += s3[3] * w; a[16] += s4 * w; }
#pragma unroll
            for (int r = 0; r < 17; ++r) red[(kg * 64 + (tid & 63)) * 17 + r] = a[r];
            __syncthreads();
            for (int o = tid; o < 64 * 17; o += NTHR) { const int c2 = o / 17, r = o % 17; float s = 0.f;
#pragma unroll
                for (int g8 = 0; g8 < 8; ++g8) s += red[(g8 * 64 + c2) * 17 + r];
                MOD[((size_t)l * 17 + r) * 6144 + cb * 64 + c2] = s + b_mod[l * 6144 + cb * 64 + c2]; }
            __syncthreads();
        }
    }
    GRID_BAR();
    { PHASE_IDS(); PHASE_ARGS();
    const float* in_x = IN(0); const float* in_ctx = IN(2); const float* MOD = WSP(float, WS_MOD); float* X = WSP(float, WS_X); bf16_t* H = WSP(bf16_t, WS_H);
    for (int row = gw; row < M; row += NGW) {
        const int b = row / TPB, t = row % TPB; const bool isctx = t < CTXL;
        const float* src = isctx ? in_ctx + ((size_t)b * CTXL + t) * DM : in_x + ((size_t)b * SEQ + (t - CTXL)) * DM;
        const float* mr = MOD + (size_t)(0 * 17 + (isctx ? 16 : b)) * 6144;
#pragma unroll
        for (int j = 0; j < 4; ++j) { const int col = 4 * lane + 256 * j; const f32x4 v = *(const f32x4*)(src + col); *(f32x4*)(X + (size_t)row * DM + col) = v;
            const f32x4 sh = *(const f32x4*)(mr + col), sc = *(const f32x4*)(mr + 1024 + col); const f32x4 h = v * (sc + 1.0f) + sh;
            u32x2 w; w.x = pk2(h[0], h[1]); w.y = pk2(h[2], h[3]); *(u32x2*)(H + (size_t)row * DM + col) = w; }
    } }
    GRID_BAR();

    for (int layer = 0; layer < DEPTH; ++layer) {
        const bool lastl = (layer == DEPTH - 1);
        const int li = layer >> 1;
        const bool even = (layer & 1) == 0;
#if !defined(NO_MIXER)
        if (even) {
            { PHASE_ARGS(); pg8::SchedDense S; S.nM = NPANEL; S.nN = 6; S.G = G; S.c = bx; S.g = 0; S.A = (const char*)WSP(bf16_t, WS_H); S.B = (const char*)(WSP(bf16_t, WS_WINAB) + (size_t)li * 1536 * 1024); S.a_tstep = (size_t)256 * 1024 * 2; S.b_tstep = (size_t)256 * 1024 * 2;
              pg8::EpiBf16 E; E.O = WSP(bf16_t, WS_PROJ); E.ldc = 1536;
              pg8::gemm_phase<pg8::EpiBf16, pg8::SchedDense, false>(lds + LDS_STAGE, 1024, 1024, nullptr, S, E); }
            GRID_BAR();
            { PHASE_IDS(); PHASE_ARGS();
              bf16_t* PROJ = WSP(bf16_t, WS_PROJ); bf16_t* UT = WSP(bf16_t, WS_UT); const float* T32 = WSP(float, WS_ROPE);
              const float* gq = IN(16) + li * 128; const float* gk = IN(17) + li * 128;
              for (int row = gw; row < M; row += NGW) {
                const int t = row % TPB; const bool isctx = t < CTXL; const int pos = t - CTXL; const int ri = pos >> 6, ci = pos & 63;
                bf16_t* pr = PROJ + (size_t)row * 1536;
                const int sub = lane & 15, half = sub >> 3, i0 = (sub & 7) * 4;
#pragma unroll
                for (int pass = 0; pass < 2; ++pass) {
                    const int hd = pass ? ((lane >> 4) & 1) : (lane >> 4); const int col = (pass ? 512 : 0) + hd * 128 + half * 64 + i0;
                    const u32x2 a = *(const u32x2*)(pr + col), c2 = *(const u32x2*)(pr + col + 32);
                    float x1[4] = {bflo(a.x), bfhi(a.x), bflo(a.y), bfhi(a.y)}, x2[4] = {bflo(c2.x), bfhi(c2.x), bflo(c2.y), bfhi(c2.y)};
                    float ss = 0.f;
#pragma unroll
                    for (int i = 0; i < 4; ++i) ss += x1[i] * x1[i] + x2[i] * x2[i];
                    ss += __shfl_xor(ss, 1); ss += __shfl_xor(ss, 2); ss += __shfl_xor(ss, 4); ss += __shfl_xor(ss, 8);
                    const float rinv = 1.0f / sqrtf(ss * (1.0f / 128.0f) + 1e-6f);
                    const float* gg = (pass ? gk : gq) + half * 64 + i0;
                    const f32x4 g1 = *(const f32x4*)gg, g2 = *(const f32x4*)(gg + 32);
#pragma unroll
                    for (int i = 0; i < 4; ++i) { x1[i] = x1[i] * rinv * g1[i]; x2[i] = x2[i] * rinv * g2[i]; }
                    if (!isctx) { const float* tp = T32 + ((half ? ci : ri) * 32 + i0) * 2;
#pragma unroll
                        for (int i = 0; i < 4; ++i) { const float cs = tp[2 * i], sn = tp[2 * i + 1]; const float o1 = x1[i] * cs - x2[i] * sn, o2 = x2[i] * cs + x1[i] * sn; x1[i] = o1; x2[i] = o2; } }
                    if (pass == 0 || lane < 32) { u32x2 w; w.x = pk2(x1[0], x1[1]); w.y = pk2(x1[2], x1[3]); *(u32x2*)(pr + col) = w; w.x = pk2(x2[0], x2[1]); w.y = pk2(x2[2], x2[3]); *(u32x2*)(pr + col + 32) = w; }
                }
                { const int b = row / TPB; const int g = lane >> 1, hf = lane & 1;
                  *(u32x4*)(UT + (((size_t)g * TPB + t) * 16 + b) * 16 + hf * 8) = *(const u32x4*)(pr + 1024 + g * 16 + hf * 8); }
              } }
            GRID_BAR();
            { PHASE_IDS(); PHASE_ARGS();
              const bf16_t* UT = WSP(bf16_t, WS_UT); const bf16_t* SFb = WSP(bf16_t, WS_SF); float* XS = WSP(float, WS_XS);
              for (int unit = vcu; unit < 256; unit += G) {
                const int g = unit >> 3, r8 = unit & 7;
                bf16x8 sa[2][8];
#pragma unroll
                for (int d = 0; d < 2; ++d)
#pragma unroll
                    for (int j = 0; j < 8; ++j) sa[d][j] = *(const bf16x8*)(SFb + ((size_t)((li * 2 + d) * 32 + g) * 64 + wave * 8 + j) * 512 + lane * 8);
                const int b = lane & 15, kq = lane >> 4;
                for (int c = r8 * 18; c < r8 * 18 + 18; ++c) {
                    f32x4 a0 = (f32x4){0.f, 0.f, 0.f, 0.f}, a1 = a0;
#pragma unroll
                    for (int j = 0; j < 8; ++j) { const bf16x8 ub = *(const bf16x8*)(UT + (((size_t)g * TPB + c * 16 + 2 * j + (kq >> 1)) * 16 + b) * 16 + (kq & 1) * 8);
                        a0 = __builtin_amdgcn_mfma_f32_16x16x32_bf16(sa[0][j], ub, a0, 0, 0, 0); a1 = __builtin_amdgcn_mfma_f32_16x16x32_bf16(sa[1][j], ub, a1, 0, 0, 0); }
                    *(f32x4*)(XS + ((size_t)(g * 2 + 0) * 144 + c) * 2048 + b * 128 + wave * 16 + 4 * kq) = a0;
                    *(f32x4*)(XS + ((size_t)(g * 2 + 1) * 144 + c) * 2048 + b * 128 + wave * 16 + 4 * kq) = a1;
                }
              } }
            { PHASE_ARGS(); bf16_t* PROJ = WSP(bf16_t, WS_PROJ); bf16_t* OL = WSP(bf16_t, WS_OL);
              for (int u = vcu; u < 576; u += G) {
                att::Unit U; int b, h, row0;
                if (u < 512) { b = u >> 5; h = (u >> 3) & 3; row0 = b * TPB + CTXL + (u & 7) * 256; U.NT = 36; } else { const int uc = u - 512; b = uc >> 2; h = uc & 3; row0 = b * TPB; U.NT = 4; }
                const bf16_t* kb = PROJ + (size_t)b * TPB * 1536;
                U.Q = PROJ + (size_t)row0 * 1536 + h * 128; U.ldq = 1536; U.K = kb + 512 + (h >> 1) * 128; U.ldk = 1536; U.KR = nullptr; U.ldkr = 0; U.V = kb + 768 + (h >> 1) * 128; U.ldv = 1536;
                U.O = OL + (size_t)row0 * 1024 + h * 128; U.ldo = 1024; U.kofs = 0; U.q0 = 0; U.sink = 0.f; U.has_sink = 0; U.rope = nullptr; U.rope_row = 0; U.rope_col_base = 0;
                att::attn_unit<128, false, 2, false>(U, (LAS char*)(lds + LDS_STAGE));
              } }
            GRID_BAR();
            { PHASE_IDS(); PHASE_ARGS();
              const float* XS = WSP(float, WS_XS); bf16_t* HIN = WSP(bf16_t, WS_HIN); const float* LAM16 = WSP(float, WS_LAM16);
              const int id = vcu * NTHR + tid;
              if (id < 65536) {
                const int n = id & 63, b = (id >> 6) & 15, gd = id >> 10, g = gd >> 1, dir = gd & 1;
                const f32x2 lam = *(const f32x2*)(LAM16 + ((li * 2 + dir) * 32 + g) * 128 + 2 * n);
                const float* xp = XS + (size_t)gd * 144 * 2048 + b * 128 + 2 * n;
                bf16_t* hp = HIN + (size_t)gd * 144 * 2048 + (((2 * n) >> 5) * 64 + (((2 * n) >> 3) & 3) * 16 + b) * 8 + ((2 * n) & 7);
                float hr = 0.f, hi2 = 0.f;
                for (int s0 = 0; s0 < 144; s0 += 8) {
                    f32x2 xv[8]; int cc[8];
#pragma unroll
                    for (int q = 0; q < 8; ++q) { const int st = s0 + q; cc[q] = dir == 0 ? st : (st < 16 ? 15 - st : 159 - st); xv[q] = *(const f32x2*)(xp + (size_t)cc[q] * 2048); }
#pragma unroll
                    for (int q = 0; q < 8; ++q) { *(unsigned*)(hp + (size_t)cc[q] * 2048) = pk2(hr, hi2);
                        const float nr = lam.x * hr - lam.y * hi2 + xv[q].x, ni = lam.x * hi2 + lam.y * hr + xv[q].y; hr = nr; hi2 = ni; }
                }
              } }
            GRID_BAR();
            { PHASE_IDS(); PHASE_ARGS();
              const bf16_t* UT = WSP(bf16_t, WS_UT); const bf16_t* TFb = WSP(bf16_t, WS_TF); const bf16_t* WFb = WSP(bf16_t, WS_WF); const bf16_t* HIN = WSP(bf16_t, WS_HIN);
              const bf16_t* PROJ = WSP(bf16_t, WS_PROJ); bf16_t* ZG = WSP(bf16_t, WS_ZG); const float* s5d = IN(25) + li * 512;
              LAS unsigned char* tfl = lds + LDS_STAGE;
              for (int unit = vcu; unit < 256; unit += G) {
                const int g = unit >> 3, r8 = unit & 7;
                __syncthreads();
                for (int i = tid; i < 2048; i += NTHR) { const int d = i >> 10, q = i & 1023; *(LAS u32x4*)(tfl + (size_t)i * 16) = *(const u32x4*)(TFb + (size_t)((li * 2 + d) * 32 + g) * 8192 + q * 8); }
                bf16x8 wf[2][2][4];
#pragma unroll
                for (int d = 0; d < 2; ++d)
#pragma unroll
                    for (int tt = 0; tt < 2; ++tt)
#pragma unroll
                        for (int ks = 0; ks < 4; ++ks) wf[d][tt][ks] = *(const bf16x8*)(WFb + ((size_t)((li * 2 + d) * 32 + g) * 64 + (2 * wave + tt) * 4 + ks) * 512 + lane * 8);
                __syncthreads();
                const int b = lane & 15, kq = lane >> 4;
                const f32x4 dsk = *(const f32x4*)(s5d + g * 16 + 4 * kq);
                for (int c = r8 * 18; c < r8 * 18 + 18; ++c) {
                    f32x4 a0 = (f32x4){0.f, 0.f, 0.f, 0.f}, a1 = a0;
#pragma unroll
                    for (int d = 0; d < 2; ++d)
#pragma unroll
                        for (int ks = 0; ks < 4; ++ks) { const bf16x8 hb = *(const bf16x8*)(HIN + ((size_t)(g * 2 + d) * 144 + c) * 2048 + (ks * 64 + lane) * 8);
                            a0 = __builtin_amdgcn_mfma_f32_16x16x32_bf16(wf[d][0][ks], hb, a0, 0, 0, 0); a1 = __builtin_amdgcn_mfma_f32_16x16x32_bf16(wf[d][1][ks], hb, a1, 0, 0, 0); }
                    for (int j = 0; j < 8; ++j) { const bf16x8 ub = *(const bf16x8*)(UT + (((size_t)g * TPB + c * 16 + 2 * j + (kq >> 1)) * 16 + b) * 16 + (kq & 1) * 8);
                        if (j <= wave) { const bf16x8 t0 = *(const LAS bf16x8*)(tfl + ((2 * wave - 2 * j) * 64 + lane) * 16), t1 = *(const LAS bf16x8*)(tfl + ((2 * wave + 1 - 2 * j) * 64 + lane) * 16);
                            a0 = __builtin_amdgcn_mfma_f32_16x16x32_bf16(t0, ub, a0, 0, 0, 0); a1 = __builtin_amdgcn_mfma_f32_16x16x32_bf16(t1, ub, a1, 0, 0, 0); }
                        if (j >= wave) { const bf16x8 t0 = *(const LAS bf16x8*)(tfl + ((16 + 2 * j - 2 * wave + 1) * 64 + lane) * 16), t1 = *(const LAS bf16x8*)(tfl + ((16 + 2 * j - 2 * wave) * 64 + lane) * 16);
                            a0 = __builtin_amdgcn_mfma_f32_16x16x32_bf16(t0, ub, a0, 0, 0, 0); a1 = __builtin_amdgcn_mfma_f32_16x16x32_bf16(t1, ub, a1, 0, 0, 0); } }
#pragma unroll
                    for (int tt = 0; tt < 2; ++tt) { const size_t row = (size_t)b * TPB + c * 16 + 2 * wave + tt; const f32x4 av = tt ? a1 : a0;
                        const u32x2 uw = *(const u32x2*)(PROJ + row * 1536 + 1024 + g * 16 + 4 * kq); const float uu[4] = {bflo(uw.x), bfhi(uw.x), bflo(uw.y), bfhi(uw.y)}; float z[4];
#pragma unroll
                        for (int i = 0; i < 4; ++i) { const float y = av[i] + dsk[i] * uu[i]; const float a = 0.7978845608028654f * (y + 0.044715f * y * y * y);
                            const float th = 1.0f - 2.0f * __builtin_amdgcn_rcpf(1.0f + __expf(2.0f * a)); z[i] = 0.5f * y * (1.0f + th); }
                        u32x2 w; w.x = pk2(z[0], z[1]); w.y = pk2(z[2], z[3]); *(u32x2*)(ZG + row * 512 + g * 16 + 4 * kq) = w; }
                }
              } }
            GRID_BAR();
            { PHASE_ARGS(); pg8::SchedDense S; S.nM = NPANEL; S.nN = 2; S.G = G; S.c = bx; S.g = 0; S.A = (const char*)WSP(bf16_t, WS_ZG); S.B = (const char*)(WSP(bf16_t, WS_WGLU) + (size_t)li * 512 * 512); S.a_tstep = (size_t)256 * 512 * 2; S.b_tstep = (size_t)256 * 512 * 2;
              pg8::EpiGlu E; E.ZG = WSP(bf16_t, WS_ZG); E.bias = IN(27) + li * 512; E.OL = WSP(bf16_t, WS_OL);
              pg8::gemm_phase<pg8::EpiGlu, pg8::SchedDense, false>(lds + LDS_STAGE, 512, 512, nullptr, S, E); }
            GRID_BAR();
        } else {
#if !defined(NO_ODD)
            { PHASE_ARGS(); pg8::SchedDense S; S.nM = NPANEL; S.nN = 7; S.G = G; S.c = bx; S.g = 0; S.A = (const char*)WSP(bf16_t, WS_H); S.B = (const char*)(WSP(bf16_t, WS_WINCD) + (size_t)li * 1792 * 1024); S.a_tstep = (size_t)256 * 1024 * 2; S.b_tstep = (size_t)256 * 1024 * 2;
              pg8::EpiBf16 E; E.O = WSP(bf16_t, WS_PROJ); E.ldc = 1792;
              pg8::gemm_phase<pg8::EpiBf16, pg8::SchedDense, false>(lds + LDS_STAGE, 1024, 1024, nullptr, S, E); }
            GRID_BAR();
            { PHASE_IDS(); PHASE_ARGS();
              bf16_t* PROJ = WSP(bf16_t, WS_PROJ); const float* T32 = WSP(float, WS_ROPE); const float* T16 = T32 + 64 * 32 * 2;
              const float* gq = IN(29) + li * 256; const float* gkv = IN(30) + li * 256;
              for (int row = gw; row < M; row += NGW) {
                const int t = row % TPB; const bool isctx = t < CTXL; const int pos = t - CTXL; const int ri = pos >> 6, ci = pos & 63;
                bf16_t* pr = PROJ + (size_t)row * 1792;
#pragma unroll
                for (int pass = 0; pass < 2; ++pass) { const int col = pass * 256 + lane * 4; const u32x2 a = *(const u32x2*)(pr + col);
                    float x[4] = {bflo(a.x), bfhi(a.x), bflo(a.y), bfhi(a.y)}; const float ss = wave_sum(x[0] * x[0] + x[1] * x[1] + x[2] * x[2] + x[3] * x[3]);
                    const float rinv = 1.0f / sqrtf(ss * (1.0f / 256.0f) + 1e-6f); const f32x4 g4 = *(const f32x4*)((pass ? gkv : gq) + lane * 4);
                    u32x2 w; w.x = pk2(x[0] * rinv * g4[0], x[1] * rinv * g4[1]); w.y = pk2(x[2] * rinv * g4[2], x[3] * rinv * g4[3]); *(u32x2*)(pr + col) = w; }
                if (!isctx) {
                    if (lane < 32) { const int half = lane >> 4, i = lane & 15; const int col = 512 + half * 32 + i; const float a = bf2f(pr[col]), c2 = bf2f(pr[col + 16]);
                        const float* tp = T16 + ((half ? ci : ri) * 16 + i) * 2; const float cs = tp[0], sn = tp[1];
                        pr[col] = (bf16_t)f2bf(a * cs - c2 * sn); pr[col + 16] = (bf16_t)f2bf(c2 * cs + a * sn); }
                    const int sub = lane & 15, half = sub >> 3, i0 = (sub & 7) * 4;
#pragma unroll
                    for (int pass = 0; pass < 2; ++pass) {
                        const int hd = pass ? ((lane >> 4) & 1) : (lane >> 4); const int col = (pass ? 1088 : 576) + hd * 128 + half * 64 + i0;
                        const u32x2 a = *(const u32x2*)(pr + col), c2 = *(const u32x2*)(pr + col + 32);
                        float x1[4] = {bflo(a.x), bfhi(a.x), bflo(a.y), bfhi(a.y)}, x2[4] = {bflo(c2.x), bfhi(c2.x), bflo(c2.y), bfhi(c2.y)};
                        const float* tp = T32 + ((half ? ci : ri) * 32 + i0) * 2;
#pragma unroll
                        for (int i = 0; i < 4; ++i) { const float cs = tp[2 * i], sn = tp[2 * i + 1]; const float o1 = x1[i] * cs - x2[i] * sn, o2 = x2[i] * cs + x1[i] * sn; x1[i] = o1; x2[i] = o2; }
                        if (pass == 0 || lane < 32) { u32x2 w; w.x = pk2(x1[0], x1[1]); w.y = pk2(x1[2], x1[3]); *(u32x2*)(pr + col) = w; w.x = pk2(x2[0], x2[1]); w.y = pk2(x2[2], x2[3]); *(u32x2*)(pr + col + 32) = w; }
                    }
                }
              } }
            GRID_BAR();
            { PHASE_ARGS(); bf16_t* PROJ = WSP(bf16_t, WS_PROJ); pg8::SchedDual S; S.nM = NPANEL; S.nN0 = 3; S.nN1 = 4; S.G = G; S.c = vcu; S.A0 = (const char*)PROJ; S.A1 = (const char*)(PROJ + 256);
              S.B0 = (const char*)(WSP(bf16_t, WS_WUQ) + (size_t)li * 768 * 256); S.B1 = (const char*)(WSP(bf16_t, WS_WUKV) + (size_t)li * 1024 * 256); S.a_tstep = (size_t)256 * 1792 * 2; S.b_tstep = (size_t)256 * 256 * 2;
              pg8::EpiBf16Dual E; E.O0 = WSP(bf16_t, WS_QM); E.ldc0 = 768; E.O1 = WSP(bf16_t, WS_KVM); E.ldc1 = 1024;
              pg8::gemm_phase<pg8::EpiBf16Dual, pg8::SchedDual, false>(lds + LDS_STAGE, 256, 1792, nullptr, S, E); }
            GRID_BAR();
            { PHASE_ARGS(); bf16_t* PROJ = WSP(bf16_t, WS_PROJ); bf16_t* OL = WSP(bf16_t, WS_OL); bf16_t* QM = WSP(bf16_t, WS_QM); bf16_t* KVM = WSP(bf16_t, WS_KVM); const float* T16 = WSP(float, WS_ROPE) + 64 * 32 * 2; const float* d_sink = IN(33);
              for (int u = vcu; u < 1152; u += G) {
                att::Unit U; int b, h, row0, qb; bool mla, ctxq;
                if (u < 512) { mla = true; ctxq = false; b = u >> 5; h = (u >> 3) & 3; qb = u & 7; }
                else if (u < 1024) { const int v2 = u - 512; mla = false; ctxq = false; b = v2 >> 5; h = (v2 >> 3) & 3; qb = v2 & 7; }
                else { const int v2 = u - 1024; mla = (v2 < 64); ctxq = true; b = (v2 & 63) >> 2; h = v2 & 3; qb = 0; }
                row0 = b * TPB + (ctxq ? 0 : CTXL + qb * 256);
                const int q0 = qb * 256;
                if (mla) {
                    const bf16_t* kvb = KVM + (size_t)b * TPB * 1024;
                    U.Q = QM + (size_t)row0 * 768 + h * 192; U.ldq = 768; U.K = kvb + h * 256; U.ldk = 1024; U.KR = PROJ + (size_t)b * TPB * 1792 + 512; U.ldkr = 1792; U.V = kvb + h * 256 + 128; U.ldv = 1024;
                    U.O = OL + (size_t)row0 * 1024 + h * 128; U.ldo = 1024; U.NT = ctxq ? 4 : 36; U.kofs = 0; U.q0 = q0; U.sink = 0.f; U.has_sink = 0; U.rope = ctxq ? nullptr : T16; U.rope_row = 0; U.rope_col_base = 0;
                    att::attn_unit<192, false, 1, true>(U, (LAS char*)(lds + LDS_STAGE));
                } else {
                    const bf16_t* kb = PROJ + (size_t)b * TPB * 1792;
                    const int kstart = (q0 - 128) < 0 ? 0 : (q0 - 128), kend = (q0 + 384) > SEQ ? SEQ : (q0 + 384);
                    U.Q = PROJ + (size_t)row0 * 1792 + 576 + h * 128; U.ldq = 1792; U.K = kb + 1088 + (h >> 1) * 128; U.ldk = 1792; U.KR = nullptr; U.ldkr = 0; U.V = kb + 1344 + (h >> 1) * 128; U.ldv = 1792;
                    U.O = OL + (size_t)row0 * 1024 + 512 + h * 128; U.ldo = 1024; U.NT = ctxq ? 4 : 4 + (kend - kstart) / 64; U.kofs = kstart; U.q0 = q0; U.sink = d_sink[li * 4 + h]; U.has_sink = 1; U.rope = nullptr; U.rope_row = 0; U.rope_col_base = 0;
                    att::attn_unit<128, true, 1, true>(U, (LAS char*)(lds + LDS_STAGE));
                }
              } }
            GRID_BAR();
#endif
        }
        const bool has_mix = even
#if !defined(NO_ODD)
            || true
#endif
            ;
        if (has_mix) {
            { PHASE_ARGS(); pg8::SchedDense S; S.nM = NPANEL; S.nN = 4; S.G = G; S.c = bx; S.g = 0; S.A = (const char*)WSP(bf16_t, WS_OL); S.B = (const char*)(WSP(bf16_t, WS_WMIX) + (size_t)layer * 1024 * 1024); S.a_tstep = (size_t)256 * 1024 * 2; S.b_tstep = (size_t)256 * 1024 * 2;
              pg8::EpiBf16 E; E.O = WSP(bf16_t, WS_Y); E.ldc = 1024;
              pg8::gemm_phase<pg8::EpiBf16, pg8::SchedDense, false>(lds + LDS_STAGE, 1024, 1024, nullptr, S, E); }
            GRID_BAR();
        }
#else
        const bool has_mix = false;
#endif
        {
            PHASE_IDS(); PHASE_ARGS();
            const float* ln_g = IN(6); const float* ln_b = IN(7); const float* w_router = IN(9); const float* b_router = IN(10);
            const float* MOD = WSP(float, WS_MOD); float* X = WSP(float, WS_X); bf16_t* H = WSP(bf16_t, WS_H); const bf16_t* Y = WSP(bf16_t, WS_Y);
            int* slot_tok = WSP(int, WS_SLOTTOK); float* slot_gate = WSP(float, WS_SLOTGATE); int* tok_pos = WSP(int, WS_TOKPOS); unsigned* ctl = WSP(unsigned, WS_CTL);
            LAS float* WT = (LAS float*)(lds + LDS_STAGE);
            LAS int* hist = (LAS int*)(lds + LDS_MISC + 64);
            LAS int* basel = (LAS int*)(lds + LDS_MISC + 64 + 128);
            LAS int* ent = (LAS int*)(lds + LDS_MISC + 512);
            const float* wr_l = w_router + (size_t)layer * 1024 * 32;
            for (int i = tid; i < 1024 * 32; i += NTHR) { const int col = i >> 5, e = i & 31; WT[e * 1028 + col] = wr_l[i]; }
            if (tid < 32) hist[tid] = 0;
            __syncthreads();
            const float* g1 = ln_g + (size_t)(layer * 2 + 0) * 1024; const float* b1 = ln_b + (size_t)(layer * 2 + 0) * 1024;
            const int rows_per_wg = M / G;
            const int rbase = vcu * rows_per_wg;
            for (int rl = wave; rl < rows_per_wg; rl += NWAVES) {
                const int row = rbase + rl; const int b = row / TPB, t = row % TPB; const bool isctx = t < CTXL;
                const float* mr = MOD + (size_t)(layer * 17 + (isctx ? 16 : b)) * 6144;
                f32x4 v[4]; float s = 0.f;
#pragma unroll
                for (int j = 0; j < 4; ++j) { const int col = 4 * lane + 256 * j; const f32x4 xv = *(const f32x4*)(X + (size_t)row * DM + col);
                    v[j] = xv * ALPHA;
                    if (has_mix) { const u32x2 yw = *(const u32x2*)(Y + (size_t)row * DM + col); const f32x4 gt = *(const f32x4*)(mr + 2048 + col);
                        v[j][0] += gt[0] * bflo(yw.x); v[j][1] += gt[1] * bfhi(yw.x); v[j][2] += gt[2] * bflo(yw.y); v[j][3] += gt[3] * bfhi(yw.y); }
                    s += (v[j][0] + v[j][1]) + (v[j][2] + v[j][3]); }
                const float mean = wave_sum(s) * (1.f / DM); float s2 = 0.f;
#pragma unroll
                for (int j = 0; j < 4; ++j) { v[j] = v[j] - mean; s2 += (v[j][0] * v[j][0] + v[j][1] * v[j][1]) + (v[j][2] * v[j][2] + v[j][3] * v[j][3]); }
                const float rstd = 1.f / sqrtf(wave_sum(s2) * (1.f / DM) + LN_EPS);
                f32x4 hv[4];
#pragma unroll
                for (int j = 0; j < 4; ++j) { const int col = 4 * lane + 256 * j; const f32x4 gg = *(const f32x4*)(g1 + col), bb = *(const f32x4*)(b1 + col);
                    const f32x4 xn = v[j] * rstd * gg + bb; *(f32x4*)(X + (size_t)row * DM + col) = xn;
                    const f32x4 sh = *(const f32x4*)(mr + 3072 + col), sc = *(const f32x4*)(mr + 4096 + col); hv[j] = xn * (sc + 1.0f) + sh;
                    u32x2 w; w.x = pk2(hv[j][0], hv[j][1]); w.y = pk2(hv[j][2], hv[j][3]); *(u32x2*)(H + (size_t)row * DM + col) = w; }
                if (lastl && isctx) continue;
                float part[32];
#pragma unroll
                for (int e = 0; e < 32; ++e) { float p = 0.f;
#pragma unroll
                    for (int j = 0; j < 4; ++j) { const f32x4 w4 = *(const LAS f32x4*)(WT + e * 1028 + 4 * lane + 256 * j); p += hv[j][0] * w4[0] + hv[j][1] * w4[1] + hv[j][2] * w4[2] + hv[j][3] * w4[3]; }
                    part[e] = p; }
#pragma unroll
                for (int e = 0; e < 16; ++e) { const bool up = (lane & 32) != 0; const float keep = up ? part[e + 16] : part[e], send = up ? part[e] : part[e + 16]; part[e] = keep + __shfl_xor(send, 32); }
#pragma unroll
                for (int e = 0; e < 8; ++e) { const bool up = (lane & 16) != 0; const float keep = up ? part[e + 8] : part[e], send = up ? part[e] : part[e + 8]; part[e] = keep + __shfl_xor(send, 16); }
#pragma unroll
                for (int e = 0; e < 4; ++e) { const bool up = (lane & 8) != 0; const float keep = up ? part[e + 4] : part[e], send = up ? part[e] : part[e + 4]; part[e] = keep + __shfl_xor(send, 8); }
#pragma unroll
                for (int e = 0; e < 2; ++e) { const bool up = (lane & 4) != 0; const float keep = up ? part[e + 2] : part[e], send = up ? part[e] : part[e + 2]; part[e] = keep + __shfl_xor(send, 4); }
                { const bool up = (lane & 2) != 0; const float keep = up ? part[1] : part[0], send = up ? part[0] : part[1]; part[0] = keep + __shfl_xor(send, 2); }
                float lg = part[0] + __shfl_xor(part[0], 1);
                const int my_e = lane >> 1;
                lg += b_router[layer * 32 + my_e];
                float tv[4]; int te[4];
#pragma unroll
                for (int k = 0; k < 4; ++k) { const float mx = wave_max(lg); const unsigned long long bal = __ballot(lg == mx); const int ln = __ffsll((long long)bal) - 1; const int e = ln >> 1;
                    tv[k] = mx; te[k] = e; if (my_e == e) lg = -3.0e38f; }
                const float e1 = __expf(tv[1] - tv[0]), e2 = __expf(tv[2] - tv[0]), e3 = __expf(tv[3] - tv[0]); const float inv = 1.0f / (1.0f + e1 + e2 + e3);
                if (lane < 4) { const int e = lane == 0 ? te[0] : lane == 1 ? te[1] : lane == 2 ? te[2] : te[3]; const float gt = (lane == 0 ? 1.0f : lane == 1 ? e1 : lane == 2 ? e2 : e3) * inv;
                    const int lr = __hip_atomic_fetch_add(hist + e, 1, __ATOMIC_RELAXED, __HIP_MEMORY_SCOPE_WORKGROUP);
                    LAS int* en = ent + (rl * 4 + lane) * 3; en[0] = e; en[1] = lr; en[2] = __builtin_bit_cast(int, gt); }
            }
            __syncthreads();
            if (tid < 32) { const int hc = hist[tid]; basel[tid] = hc ? (int)__hip_atomic_fetch_add(ctl + CW_CURSOR + layer * 32 + tid, (unsigned)hc, __ATOMIC_RELAXED, __HIP_MEMORY_SCOPE_AGENT) : 0; }
            __syncthreads();
            for (int i = tid; i < rows_per_wg * 4; i += NTHR) { const int rl = i >> 2; const int row = rbase + rl; const bool isctx = (row % TPB) < CTXL; if (lastl && isctx) continue;
                const LAS int* en = ent + i * 3; const int e = en[0]; const int pos = e * CAP + basel[e] + en[1];
                slot_tok[pos] = row; slot_gate[pos] = __builtin_bit_cast(float, en[2]); tok_pos[row * 4 + (i & 3)] = pos; }
        }
        GRID_BAR();
        LAS int* tb_bb = (LAS int*)(lds + LDS_MISC + 64);
        LAS int* tb_cnt = (LAS int*)(lds + LDS_MISC + 64 + 256);
        if (threadIdx.x == 0) { PHASE_ARGS(); unsigned* ctl = WSP(unsigned, WS_CTL); int acc = 0; for (int e = 0; e < 32; ++e) { const int c = (int)__hip_atomic_load(ctl + CW_CURSOR + layer * 32 + e, __ATOMIC_RELAXED, __HIP_MEMORY_SCOPE_AGENT); tb_cnt[e] = c; tb_bb[e] = acc; acc += (c + 255) >> 8; } tb_bb[32] = acc; }
        __syncthreads();
        {
            PHASE_ARGS(); pg8::SchedMoE S; S.bb = tb_bb; S.cnt = tb_cnt; S.NT = 8; S.G = G; S.c = vcu; S.Acompact = nullptr; S.a_tstep = 0;
            const int* slot_tok = WSP(int, WS_SLOTTOK); const float* slot_gate = WSP(float, WS_SLOTGATE);
            S.W = (const char*)(WSP(bf16_t, WS_WEXPIN) + (size_t)layer * 32 * 2048 * 1024); S.w_estep = (size_t)2048 * 1024 * 2; S.w_tstep = (size_t)256 * 1024 * 2; S.slot_tok = slot_tok; S.slot_gate = slot_gate;
            pg8::EpiSwiglu E; E.Z = WSP(bf16_t, WS_Z); E.bias = IN(12) + (size_t)layer * 32 * 2048;
            pg8::gemm_phase<pg8::EpiSwiglu, pg8::SchedMoE, true>(lds + LDS_STAGE, 1024, 1024, (const char*)WSP(bf16_t, WS_H), S, E);
        }
        GRID_BAR();
        {
            PHASE_ARGS(); pg8::SchedMoE S; S.bb = tb_bb; S.cnt = tb_cnt; S.NT = 4; S.G = G; S.c = vcu; S.Acompact = (const char*)WSP(bf16_t, WS_Z); S.a_tstep = (size_t)256 * 1024 * 2;
            const int* slot_tok = WSP(int, WS_SLOTTOK); const float* slot_gate = WSP(float, WS_SLOTGATE);
            S.W = (const char*)(WSP(bf16_t, WS_WEXPOUT) + (size_t)layer * 32 * 1024 * 1024); S.w_estep = (size_t)1024 * 1024 * 2; S.w_tstep = (size_t)256 * 1024 * 2; S.slot_tok = slot_tok; S.slot_gate = slot_gate;
            pg8::EpiMoeOut E; E.Y2 = WSP(bf16_t, WS_Y2); E.bias = IN(14) + (size_t)layer * 32 * 1024;
            pg8::gemm_phase<pg8::EpiMoeOut, pg8::SchedMoE, false>(lds + LDS_STAGE, 1024, 1024, nullptr, S, E);
        }
        GRID_BAR();
        {
            PHASE_IDS(); PHASE_ARGS();
            const float* ln_g = IN(6); const float* ln_b = IN(7); const float* MOD = WSP(float, WS_MOD); float* X = WSP(float, WS_X); bf16_t* H = WSP(bf16_t, WS_H);
            const bf16_t* Y2 = WSP(bf16_t, WS_Y2); const int* tok_pos = WSP(int, WS_TOKPOS); float* outp = A_->out;
            const float* g2 = ln_g + (size_t)(layer * 2 + 1) * 1024; const float* b2 = ln_b + (size_t)(layer * 2 + 1) * 1024;
            for (int row = gw; row < M; row += NGW) {
                const int b = row / TPB, t = row % TPB; const bool isctx = t < CTXL;
                if (lastl && isctx) continue;
                const float* mr = MOD + (size_t)(layer * 17 + (isctx ? 16 : b)) * 6144;
                int zr[4];
#pragma unroll
                for (int k = 0; k < 4; ++k) { const int pos = tok_pos[row * 4 + k]; const int e = pos / CAP, rk = pos % CAP; zr[k] = tb_bb[e] * 256 + rk; }
                f32x4 v[4]; float s = 0.f;
#pragma unroll
                for (int j = 0; j < 4; ++j) { const int col = 4 * lane + 256 * j; f32x4 y = (f32x4){0.f, 0.f, 0.f, 0.f};
#pragma unroll
                    for (int k = 0; k < 4; ++k) { const u32x2 w = *(const u32x2*)(Y2 + (size_t)zr[k] * 1024 + col); y[0] += bflo(w.x); y[1] += bfhi(w.x); y[2] += bflo(w.y); y[3] += bfhi(w.y); }
                    const f32x4 xv = *(const f32x4*)(X + (size_t)row * DM + col); const f32x4 gt = *(const f32x4*)(mr + 5120 + col);
                    v[j] = xv * ALPHA + gt * y; s += (v[j][0] + v[j][1]) + (v[j][2] + v[j][3]); }
                const float mean = wave_sum(s) * (1.f / DM); float s2 = 0.f;
#pragma unroll
                for (int j = 0; j < 4; ++j) { v[j] = v[j] - mean; s2 += (v[j][0] * v[j][0] + v[j][1] * v[j][1]) + (v[j][2] * v[j][2] + v[j][3] * v[j][3]); }
                const float rstd = 1.f / sqrtf(wave_sum(s2) * (1.f / DM) + LN_EPS);
                const float* mn = MOD + (size_t)((layer + 1 < DEPTH ? layer + 1 : layer) * 17 + (isctx ? 16 : b)) * 6144;
#pragma unroll
                for (int j = 0; j < 4; ++j) { const int col = 4 * lane + 256 * j; const f32x4 gg = *(const f32x4*)(g2 + col), bb = *(const f32x4*)(b2 + col);
                    const f32x4 xn = v[j] * rstd * gg + bb;
                    if (lastl) { *(f32x4*)(outp + ((size_t)b * SEQ + (t - CTXL)) * DM + col) = xn; }
                    else { *(f32x4*)(X + (size_t)row * DM + col) = xn;
                        const f32x4 sh = *(const f32x4*)(mn + col), sc = *(const f32x4*)(mn + 1024 + col); const f32x4 h = xn * (sc + 1.0f) + sh;
                        u32x2 w; w.x = pk2(h[0], h[1]); w.y = pk2(h[2], h[3]); *(u32x2*)(H + (size_t)row * DM + col) = w; } }
            }
        }
        if (!lastl) GRID_BAR();
    }
}

extern "C" void kernel_launch(void* const* d_in, const int* in_sizes, int n_in, void* d_out, int out_size, void* d_ws, size_t ws_size, hipStream_t stream) {
    static int grid = 0;
    if (grid == 0) {
        if (n_in != 34 || ws_size < WS_END) { fprintf(stderr, "kernel_launch: unexpected n_in %d / ws %zu (need %zu)\n", n_in, ws_size, (size_t)WS_END); grid = -1; return; }
        int dev = 0, cus = 0, per_cu = 0;
        if (hipGetDevice(&dev) != hipSuccess || hipDeviceGetAttribute(&cus, hipDeviceAttributeMultiprocessorCount, dev) != hipSuccess) { grid = -1; return; }
        if (hipFuncSetAttribute((const void*)fwd_kernel, hipFuncAttributeMaxDynamicSharedMemorySize, LDS_BYTES) != hipSuccess) { fprintf(stderr, "kernel_launch: hipFuncSetAttribute failed\n"); grid = -1; return; }
        if (hipOccupancyMaxActiveBlocksPerMultiprocessor(&per_cu, (const void*)fwd_kernel, NTHR, LDS_BYTES) != hipSuccess || per_cu < 1) { fprintf(stderr, "kernel_launch: occupancy query says %d\n", per_cu); }
        (void)hipGetLastError();
        grid = cus;
        if (M % grid != 0) { fprintf(stderr, "kernel_launch: grid %d does not divide %d rows\n", grid, M); grid = -1; return; }
    }
    if (grid < 0) return;
    (void)hipMemsetAsync((char*)d_ws + WS_CTL, 0, CTL_BYTES, stream);
    Args a{};
    for (int i = 0; i < 34; ++i) a.in[i] = (const float*)d_in[i];
    a.out = (float*)d_out; a.ws = (unsigned char*)d_ws;
    hipLaunchKernelGGL(fwd_kernel, dim3(grid), dim3(NTHR), LDS_BYTES, stream, a);
    const hipError_t le = hipPeekAtLastError();
    if (le != hipSuccess) fprintf(stderr, "kernel_launch: launch failed: %s\n", hipGetErrorName(le));
}
```

```cpp
#include <hip/hip_runtime.h>
#include <stdint.h>
#include <stdio.h>
#ifndef DUPSEL
#define DUPSEL 0
#endif
#define DUPN(k) ((DUPSEL == (k)) ? 2 : 1)
#define PROBE_MASK 0ull

#define LAS __attribute__((address_space(3)))
#define GAS __attribute__((address_space(1)))
typedef unsigned short bf16_t;
typedef short bf16x8 __attribute__((ext_vector_type(8)));
typedef float f32x4 __attribute__((ext_vector_type(4)));
typedef float f32x2 __attribute__((ext_vector_type(2)));
typedef unsigned u32x4 __attribute__((ext_vector_type(4)));
typedef unsigned u32x2 __attribute__((ext_vector_type(2)));

constexpr int DM = 1024, NB = 16, SEQ = 2048, CTXL = 256, TPB = SEQ + CTXL  ;
constexpr int M = NB * TPB;
constexpr int NPANEL = M / 256;
constexpr int DEPTH = 4, NEXP = 32, TOPK = 4, DFF = 1024;
constexpr int CAP = M;
constexpr int NPAD = M * TOPK + NEXP * 256;
constexpr float ALPHA = 1.681792830507429f;
constexpr float LN_EPS = 1e-5f;
constexpr int NWAVES = 8, NTHR = 512;

constexpr size_t MiB = 1ull << 20;
constexpr size_t WS_CTL = 0, CTL_BYTES = 1 * MiB;
constexpr size_t WS_MOD = 1 * MiB;
constexpr size_t WS_X = 4 * MiB;
constexpr size_t WS_H = WS_X + 144 * MiB;
constexpr size_t WS_Y = WS_H + 72 * MiB;
constexpr size_t WS_OL = WS_Y + 72 * MiB;
constexpr size_t WS_PROJ = WS_OL + 72 * MiB;
constexpr size_t WS_Z = WS_PROJ + 126 * MiB;
constexpr size_t WS_Y2 = WS_Z + 304 * MiB;
constexpr size_t WS_SLOTTOK = WS_Y2 + 304 * MiB;
constexpr size_t WS_SLOTGATE = WS_SLOTTOK + 5 * MiB;
constexpr size_t WS_TOKPOS = WS_SLOTGATE + 5 * MiB;
constexpr size_t WS_WEXPIN = WS_TOKPOS + 1 * MiB;
constexpr size_t WS_WEXPOUT = WS_WEXPIN + 512 * MiB;
constexpr size_t WS_WMIX = WS_WEXPOUT + 256 * MiB;
constexpr size_t WS_WINAB = WS_WMIX + 8 * MiB;
constexpr size_t WS_WINCD = WS_WINAB + 6 * MiB;
constexpr size_t WS_WGLU = WS_WINCD + 7 * MiB;
constexpr size_t WS_WUQ = WS_WGLU + 1 * MiB;
constexpr size_t WS_WUKV = WS_WUQ + 1 * MiB;
constexpr size_t WS_ROPE = WS_WUKV + 1 * MiB;
constexpr size_t WS_QM = WS_ROPE + 1 * MiB;
constexpr size_t WS_KVM = WS_QM + 54 * MiB;
constexpr size_t WS_UT = WS_KVM + 72 * MiB;
constexpr size_t WS_XS = WS_UT + 36 * MiB;
constexpr size_t WS_HIN = WS_XS + 72 * MiB;
constexpr size_t WS_ZG = WS_HIN + 36 * MiB;
constexpr size_t WS_TF = WS_ZG + 36 * MiB;
constexpr size_t WS_SF = WS_TF + 2 * MiB;
constexpr size_t WS_WF = WS_SF + 8 * MiB;
constexpr size_t WS_LAM16 = WS_WF + 8 * MiB;
constexpr size_t WS_X1 = WS_LAM16 + 1 * MiB;
constexpr size_t WS_H8 = WS_X1 + 144 * MiB;
constexpr size_t WS_WRF = WS_H8 + 36 * MiB;
constexpr size_t WS_END = WS_WRF + 1 * MiB;

constexpr int CW_BAR = 4096;
constexpr int CW_CURSOR = 8192;

constexpr int LDS_STAGE = 0, LDS_MISC = 133120, LDS_BYTES = 147456;

__device__ __forceinline__ int lane_now() { int l; asm volatile("v_mbcnt_lo_u32_b32 %0, -1, 0\n\tv_mbcnt_hi_u32_b32 %0, -1, %0" : "=v"(l)); return l; }
__device__ __forceinline__ unsigned f2bf(float f) { unsigned u = __builtin_bit_cast(unsigned, f); return (u + 0x7fffu + ((u >> 16) & 1u)) >> 16; }
__device__ __forceinline__ unsigned pk2(float lo, float hi) { return f2bf(lo) | (f2bf(hi) << 16); }
__device__ __forceinline__ float bf2f(unsigned short b) { return __builtin_bit_cast(float, ((unsigned)b) << 16); }
__device__ __forceinline__ float bflo(unsigned w) { return __builtin_bit_cast(float, w << 16); }
__device__ __forceinline__ float bfhi(unsigned w) { return __builtin_bit_cast(float, w & 0xffff0000u); }
__device__ __forceinline__ float shx(float v, int o, int lane) { return __builtin_bit_cast(float, __builtin_amdgcn_ds_bpermute((lane ^ o) << 2, __builtin_bit_cast(int, v))); }
__device__ __forceinline__ float row16_sum(float v) {
    v += __builtin_bit_cast(float, __builtin_amdgcn_update_dpp(0, __builtin_bit_cast(int, v), 0xB1, 0xF, 0xF, true));
    v += __builtin_bit_cast(float, __builtin_amdgcn_update_dpp(0, __builtin_bit_cast(int, v), 0x4E, 0xF, 0xF, true));
    v += __builtin_bit_cast(float, __builtin_amdgcn_update_dpp(0, __builtin_bit_cast(int, v), 0x141, 0xF, 0xF, true));
    v += __builtin_bit_cast(float, __builtin_amdgcn_update_dpp(0, __builtin_bit_cast(int, v), 0x140, 0xF, 0xF, true));
    return v;
}
__device__ __forceinline__ float row16_max(float v) {
    v = fmaxf(v, __builtin_bit_cast(float, __builtin_amdgcn_update_dpp(__builtin_bit_cast(int, v), __builtin_bit_cast(int, v), 0xB1, 0xF, 0xF, false)));
    v = fmaxf(v, __builtin_bit_cast(float, __builtin_amdgcn_update_dpp(__builtin_bit_cast(int, v), __builtin_bit_cast(int, v), 0x4E, 0xF, 0xF, false)));
    v = fmaxf(v, __builtin_bit_cast(float, __builtin_amdgcn_update_dpp(__builtin_bit_cast(int, v), __builtin_bit_cast(int, v), 0x141, 0xF, 0xF, false)));
    v = fmaxf(v, __builtin_bit_cast(float, __builtin_amdgcn_update_dpp(__builtin_bit_cast(int, v), __builtin_bit_cast(int, v), 0x140, 0xF, 0xF, false)));
    return v;
}
__device__ __forceinline__ float wave_sum(float v, int lane) {
    (void)lane;
    v += __builtin_bit_cast(float, __builtin_amdgcn_update_dpp(0, __builtin_bit_cast(int, v), 0xB1, 0xF, 0xF, true));
    v += __builtin_bit_cast(float, __builtin_amdgcn_update_dpp(0, __builtin_bit_cast(int, v), 0x4E, 0xF, 0xF, true));
    v += __builtin_bit_cast(float, __builtin_amdgcn_update_dpp(0, __builtin_bit_cast(int, v), 0x141, 0xF, 0xF, true));
    v += __builtin_bit_cast(float, __builtin_amdgcn_update_dpp(0, __builtin_bit_cast(int, v), 0x140, 0xF, 0xF, true));
    const int vi = __builtin_bit_cast(int, v);
    return (__builtin_bit_cast(float, __builtin_amdgcn_readlane(vi, 0)) + __builtin_bit_cast(float, __builtin_amdgcn_readlane(vi, 16))) +
           (__builtin_bit_cast(float, __builtin_amdgcn_readlane(vi, 32)) + __builtin_bit_cast(float, __builtin_amdgcn_readlane(vi, 48)));
}
__device__ __forceinline__ int uni(int v) { return __builtin_amdgcn_readfirstlane(v); }
typedef _Float16 h16x4 __attribute__((ext_vector_type(4)));
__device__ __forceinline__ float h2f(unsigned short b) { return (float)__builtin_bit_cast(_Float16, b); }
__device__ __forceinline__ f32x4 h4_to_f32(unsigned lo, unsigned hi) { return (f32x4){h2f((unsigned short)(lo & 0xffffu)), h2f((unsigned short)(lo >> 16)), h2f((unsigned short)(hi & 0xffffu)), h2f((unsigned short)(hi >> 16))}; }
__device__ __forceinline__ u32x2 f32_to_h4(f32x4 v) { const h16x4 h = {(_Float16)v[0], (_Float16)v[1], (_Float16)v[2], (_Float16)v[3]}; return __builtin_bit_cast(u32x2, h); }
__device__ __forceinline__ const char* unip(const char* p) { const unsigned long long v = (unsigned long long)p; const unsigned lo = (unsigned)__builtin_amdgcn_readfirstlane((int)(unsigned)v), hi = (unsigned)__builtin_amdgcn_readfirstlane((int)(unsigned)(v >> 32)); return (const char*)(((unsigned long long)hi << 32) | lo); }
#define PHASE_IDS() const int lane = lane_now(); const int wave = wave0; const int tid = wave0 * 64 + lane; const int gw = vcu * NWAVES + wave; (void)lane; (void)gw
#define LDS_WAIT() asm volatile("s_waitcnt lgkmcnt(0)" ::: "memory")
#define VM_WAIT() asm volatile("s_waitcnt vmcnt(0)" ::: "memory")

#define XB_TMO      128
#define XB_XCNT(j)  (256  + 64 * (j))
#define XB_XSUB(j)  (1280 + 64 * (j))
#define XB_XGEN(j)  (2304 + 64 * (j))
#define XB_TOP      3328
#define XB_TOPGEN   3392
#define XCD_BAR_WORDS 3456
#define XB_SPIN_CAP (1u << 22)

__device__ __forceinline__ unsigned xb_ld(unsigned* p)              { return __hip_atomic_load(p, __ATOMIC_RELAXED, __HIP_MEMORY_SCOPE_AGENT); }
__device__ __forceinline__ unsigned xb_add(unsigned* p, unsigned v) { return __hip_atomic_fetch_add(p, v, __ATOMIC_RELAXED, __HIP_MEMORY_SCOPE_AGENT); }
__device__ __forceinline__ unsigned xb_xcc_id() { return (unsigned)__builtin_amdgcn_s_getreg((3 << 11) | 20) & 0xFu; }
#define XB_SPIN(cond, bar) do { unsigned _sp = 0; while (cond) { __builtin_amdgcn_s_sleep(1); \
    if ((++_sp & 255u) == 0u) { if (xb_ld(&(bar)[XB_TMO])) break; if (_sp > XB_SPIN_CAP) { atomicAdd(&(bar)[XB_TMO], 1u); break; } } } } while (0)

struct XcdBarrier { unsigned* bar; unsigned x; volatile LAS unsigned* st; };

__device__ __forceinline__ XcdBarrier xcd_barrier_post(unsigned* bar, volatile LAS unsigned* st) {
    XcdBarrier b; b.bar = bar; b.x = 0; b.st = st;
    if (threadIdx.x == 0) (void)xb_add(&bar[XB_XCNT(xb_xcc_id())], 1u);
    return b;
}
__device__ __forceinline__ void xcd_barrier_complete(unsigned* bar, unsigned x, unsigned& nloc, unsigned& nx) {
    const unsigned G = gridDim.x * gridDim.y * gridDim.z;
    unsigned sum, cnt, mine, sp = 0u;
    for (;;) {
        sum = 0u; cnt = 0u; mine = 0u;
#pragma unroll
        for (unsigned j = 0; j < 16; ++j) { const unsigned c = xb_ld(&bar[XB_XCNT(j)]); sum += c; cnt += (c > 0u) ? 1u : 0u; mine = (j == x) ? c : mine; }
        if (sum == G) break;
        __builtin_amdgcn_s_sleep(1);
        if ((++sp & 255u) == 0u) { if (xb_ld(&bar[XB_TMO])) break; if (sp > XB_SPIN_CAP) { atomicAdd(&bar[XB_TMO], 1u); break; } }
    }
    nloc = mine > 0u ? mine : 1u; nx = cnt > 0u ? cnt : 1u;
}
__device__ __forceinline__ void xcd_barrier(const XcdBarrier& b) {
    asm volatile("s_waitcnt vmcnt(0)" ::: "memory");
    __syncthreads();
    if (b.x == 0u && lane_now() == 0) {
        unsigned* bar = b.bar;
        __builtin_amdgcn_s_waitcnt(0);
        unsigned bx_; asm volatile("s_getreg_b32 %0, hwreg(HW_REG_XCC_ID, 0, 4)" : "=s"(bx_));
        unsigned nloc = b.st[0], nx = b.st[1];
        if (nloc == 0u) { xcd_barrier_complete(bar, bx_, nloc, nx); b.st[0] = nloc; b.st[1] = nx; }
        const unsigned old = xb_add(&bar[XB_XSUB(bx_)], 1u);
        const unsigned gen = old / nloc;
        if (old + 1u == (gen + 1u) * nloc) {
            __builtin_amdgcn_fence(__ATOMIC_RELEASE, "agent");
            asm volatile("s_waitcnt vmcnt(0)" ::: "memory");
            const unsigned og = xb_add(&bar[XB_TOP], 1u);
            const unsigned tg = og / nx;
            if (og + 1u == (tg + 1u) * nx) xb_add(&bar[XB_TOPGEN], 1u);
            else XB_SPIN(xb_ld(&bar[XB_TOPGEN]) == tg, bar);
            __builtin_amdgcn_fence(__ATOMIC_ACQUIRE, "agent");
            xb_add(&bar[XB_XGEN(bx_)], 1u);
            asm volatile("s_waitcnt vmcnt(0)" ::: "memory");
        } else {
            XB_SPIN(xb_ld(&bar[XB_XGEN(bx_)]) == gen, bar);
            __builtin_amdgcn_fence(__ATOMIC_ACQUIRE, "agent");
            asm volatile("s_waitcnt vmcnt(0)" ::: "memory");
        }
    }
    __syncthreads();
}

namespace pg8 {
constexpr int BM = 256, BK = 64, HALF = 128, HTB = HALF * BK * 2, STAGE_BYTES = 8 * HTB;
__device__ __forceinline__ int lds_byte(int r, int c) { const int st = (r >> 4) * 2 + (c >> 5), rr = r & 15, cc = c & 31, ob = rr * 64 + cc * 2; return st * 1024 + (ob ^ (((ob >> 9) & 1) << 5)); }
__device__ __forceinline__ void stage_rc(int b, int& R, int& C) { const int st = b / 1024, sb = b % 1024, swz = sb ^ (((sb >> 9) & 1) << 5); R = (st >> 1) * 16 + swz / 64; C = (st & 1) * 32 + (swz % 64) / 2; }
__device__ __forceinline__ int perm32(int rho) { const int n = rho >> 4, i = rho & 15; return 8 * (i >> 2) + 4 * n + (i & 3); }

struct Unit { int pm, pn, g, e, nvalid, pad; const char* A; const char* B; const int* rows; const float* gates; const float* bias0; const float* bias1; };
constexpr int SIDE_BYTES = 3072;

__device__ __forceinline__ unsigned cvt_pk_bf16(float lo, float hi) { unsigned r; asm volatile("v_cvt_pk_bf16_f32 %0, %1, %2" : "=v"(r) : "v"(lo), "v"(hi)); return r; }

typedef int i32x8 __attribute__((ext_vector_type(8)));
typedef int i32x4 __attribute__((ext_vector_type(4)));
__device__ __forceinline__ i32x8 cat8(bf16x8 lo, bf16x8 hi) { const i32x4 a = __builtin_bit_cast(i32x4, lo), b = __builtin_bit_cast(i32x4, hi); return (i32x8){a[0], a[1], a[2], a[3], b[0], b[1], b[2], b[3]}; }
template <class Epi, class Sched, bool GATHER, bool FP8, bool SIDE = false, bool P16 = false>
__device__ __forceinline__ void gemm_phase(const int wid0, LAS unsigned char* lds, const int Kb, const int ldab, const char* Agather, const Sched& S, const Epi& E, LAS unsigned char* side = nullptr) {
    const int lane = lane_now(); const int wid = wid0; const int tid = wid0 * 64 + lane;
    const int wr = wid >> 2, wc = wid & 3, fr = lane & 15, fq = lane >> 4;
    const int nt = Kb / 128;
    constexpr bool PG_PROBE = FP8 && SIDE && ((GATHER && ((PROBE_MASK >> 31) & 1ull)) || (!GATHER && ((PROBE_MASK >> 30) & 1ull)));
    unsigned voffA[2], voffB[2]; int rowA[2]; unsigned colA2[2];
#pragma unroll
    for (int i = 0; i < 2; ++i) { int R, C; stage_rc(tid * 16 + i * 8192, R, C); const int Rb = P16 ? (64 * (R >> 5) + 16 * ((R & 15) >> 2) + 4 * ((R >> 4) & 1) + (R & 3)) : ((R & ~31) + perm32(R & 31));
        voffA[i] = (unsigned)(R * ldab + C * 2); voffB[i] = (unsigned)(Rb * Kb + C * 2); rowA[i] = R; colA2[i] = (unsigned)C * 2u; }
    const size_t kstep = (size_t)(BK * 2);
    const size_t hstepA = (size_t)HALF * ldab, hstepB = P16 ? (size_t)8 * Kb : (size_t)HALF * Kb;
    const unsigned ldsw = (unsigned)wid * 1024u;
    const int aoff = lds_byte(wr * 64 + fr, fq * 8), boff = lds_byte(wc * 32 + fr, fq * 8);
#define PG8_SA(b, h) (((b) * 2 + (h)) * HTB)
#define PG8_SB(b, h) ((4 + (b) * 2 + (h)) * HTB)
#define PG8_GLDS(gp, lp) __builtin_amdgcn_global_load_lds((const unsigned*)(gp), (LAS unsigned*)(lp), 16, 0, 0)
#define PG8_GLDS4(gp, lp) __builtin_amdgcn_global_load_lds((const unsigned*)(gp), (LAS unsigned*)(lp), 4, 0, 0)
#define PG8_STAGE_B(bufoff, gbase) do { const char* _q = (const char*)(gbase); asm volatile("" : "+s"(_q)); _Pragma("unroll") for (int _i = 0; _i < 2; ++_i) PG8_GLDS(_q + voffB[_i], lds + (bufoff) + ldsw + _i * 8192); } while (0)
#define PG8_STAGE_A(bufoff, h, nx, kb) do { if constexpr (GATHER) { const char* _p = Agather + (kb); asm volatile("" : "+s"(_p)); _Pragma("unroll") for (int _i = 0; _i < 2; ++_i) PG8_GLDS(_p + ((nx) ? nvo[h][_i] : cvo[h][_i]), lds + (bufoff) + ldsw + _i * 8192); } \
        else { const char* _p = ((nx) ? nA : cA) + (size_t)(h) * hstepA + (kb); asm volatile("" : "+s"(_p)); _Pragma("unroll") for (int _i = 0; _i < 2; ++_i) PG8_GLDS(_p + voffA[_i], lds + (bufoff) + ldsw + _i * 8192); } } while (0)
#define PG8_LDA(dst, b, h) do { _Pragma("unroll") for (int m = 0; m < 4; ++m) _Pragma("unroll") for (int k = 0; k < 2; ++k) dst[m][k] = *(const LAS bf16x8*)(lds + PG8_SA(b, h) + aoff + m * 2048 + k * 1024); } while (0)
#define PG8_LDB(dst, b, h) do { _Pragma("unroll") for (int n = 0; n < 2; ++n) _Pragma("unroll") for (int k = 0; k < 2; ++k) dst[n][k] = *(const LAS bf16x8*)(lds + PG8_SB(b, h) + boff + n * 2048 + k * 1024); } while (0)
#define PG8_MMA(ai, bj, At, Bt) do { __builtin_amdgcn_s_setprio(1); if constexpr (FP8) { _Pragma("unroll") for (int m = 0; m < 4; ++m) _Pragma("unroll") for (int n = 0; n < 2; ++n) \
        asm volatile("v_mfma_f32_16x16x128_f8f6f4 %0, %1, %2, %0" : "+v"(acc[ai][bj][m][n]) : "v"(cat8(Bt[n][0], Bt[n][1])), "v"(cat8(At[m][0], At[m][1]))); } \
      else { _Pragma("unroll") for (int m = 0; m < 4; ++m) _Pragma("unroll") for (int n = 0; n < 2; ++n) _Pragma("unroll") for (int k = 0; k < 2; ++k) \
        acc[ai][bj][m][n] = __builtin_amdgcn_mfma_f32_16x16x32_bf16(Bt[n][k], At[m][k], acc[ai][bj][m][n], 0, 0, 0); } __builtin_amdgcn_s_setprio(0); } while (0)
#define PG8_WAIT_V(n) asm volatile("s_waitcnt vmcnt(" #n ")" ::: "memory")
#define PG8_WAIT_L(n) asm volatile("s_waitcnt lgkmcnt(" #n ")" ::: "memory")
#define PG8_BAR __builtin_amdgcn_s_barrier()
#define PG8_SCHED __builtin_amdgcn_sched_barrier(0)
#define PG8_LOADVO(dst, par) do { if constexpr (GATHER) { const LAS int* _rw = (const LAS int*)(side + (par) * SIDE_BYTES); _Pragma("unroll") for (int _h = 0; _h < 2; ++_h) _Pragma("unroll") for (int _i = 0; _i < 2; ++_i) { \
        const int _t = _rw[_h * 128 + rowA[_i]]; dst[_h][_i] = (unsigned)_t * (unsigned)ldab + colA2[_i]; } } } while (0)
#define PG8_SIDE_DMA(u, par) do { if constexpr (SIDE) { LAS unsigned char* _sb = side + (par) * SIDE_BYTES; const int _e = (wid & 3) * 64 + lane; \
        if (wid < 4) { const int _ec = (_e < (u).nvalid) ? _e : 0; if constexpr (GATHER) PG8_GLDS4((const char*)((u).rows + _ec), _sb + (wid & 3) * 256); else PG8_GLDS4((const char*)((u).gates + _ec), _sb + 2048 + (wid & 3) * 256); } \
        else { const float* _bp = (_e < 128) ? (u).bias0 + _e : (u).bias1 + (_e - 128); PG8_GLDS4((const char*)_bp, _sb + 1024 + (wid & 3) * 256); } } } while (0)
    Unit cur, nxt; int ui = 0;
    if (!S.next(0, cur)) return;
    f32x4 acc[2][2][4][2];
#pragma unroll
    for (int a = 0; a < 2; ++a)
#pragma unroll
        for (int b = 0; b < 2; ++b)
#pragma unroll
            for (int m = 0; m < 4; ++m)
#pragma unroll
                for (int n = 0; n < 2; ++n) acc[a][b][m][n] = (f32x4){0.f, 0.f, 0.f, 0.f};
    bf16x8 At[4][2], B0[2][2], B1[2][2];
    unsigned cvo[2][2] = {{0u, 0u}, {0u, 0u}}, nvo[2][2] = {{0u, 0u}, {0u, 0u}};
    const char* cA = cur.A; const char* cB = cur.B; const char* nA = cA; const char* nB = cB;
    if constexpr (SIDE) { PG8_SIDE_DMA(cur, 0); PG8_WAIT_V(0); PG8_BAR; }
    PG8_LOADVO(cvo, 0);
    PG8_STAGE_B(PG8_SB(0, 0), cB); PG8_STAGE_A(PG8_SA(0, 0), 0, false, 0); PG8_STAGE_B(PG8_SB(0, 1), cB + hstepB); PG8_STAGE_A(PG8_SA(0, 1), 1, false, 0);
    if (wr == 1) PG8_BAR;
    PG8_WAIT_V(4); PG8_BAR;
    PG8_STAGE_B(PG8_SB(1, 0), cB + kstep); PG8_STAGE_A(PG8_SA(1, 0), 0, false, kstep); PG8_STAGE_B(PG8_SB(1, 1), cB + hstepB + kstep);
    PG8_WAIT_V(6); PG8_BAR;
    for (;;) {
        const bool has_next = S.next(ui + 1, nxt);
        const int npar = (ui + 1) % 3;
        if (has_next) { nA = nxt.A; nB = nxt.B; PG8_SIDE_DMA(nxt, npar); }
        else { nA = cA; nB = cB;
#pragma unroll
            for (int h = 0; h < 2; ++h)
#pragma unroll
                for (int i = 0; i < 2; ++i) nvo[h][i] = cvo[h][i]; }
        unsigned pg_t0_ = 0; if constexpr (PG_PROBE) pg_t0_ = (unsigned)__builtin_amdgcn_s_memrealtime();
#pragma clang loop unroll(disable)
        for (int t = 0; t < nt; t += 2) {
            const bool last = (t == nt - 2);
            if (last && has_next) PG8_LOADVO(nvo, npar);
            const size_t k1 = (size_t)(t + 1) * kstep;
            const size_t k2 = last ? 0 : (size_t)(t + 2) * kstep, k3 = k2 + kstep;
            const char* b2 = last ? nB : cB + (size_t)(t + 2) * kstep; const char* b3 = b2 + kstep;
            PG8_LDB(B0, 0, 0); PG8_SCHED; PG8_LDA(At, 0, 0); PG8_STAGE_A(PG8_SA(1, 1), 1, false, k1);
            PG8_WAIT_L(8); PG8_BAR; PG8_WAIT_L(0); PG8_MMA(0, 0, At, B0); PG8_BAR; PG8_SCHED;
            PG8_LDB(B1, 0, 1); PG8_STAGE_B(PG8_SB(0, 0), b2);
            PG8_BAR; PG8_WAIT_L(0); PG8_MMA(0, 1, At, B1); PG8_BAR;
            PG8_LDA(At, 0, 1); PG8_STAGE_A(PG8_SA(0, 0), 0, last, k2);
            PG8_BAR; PG8_WAIT_L(0); PG8_MMA(1, 0, At, B0); PG8_BAR; PG8_SCHED;
            PG8_STAGE_B(PG8_SB(0, 1), b2 + hstepB);
            PG8_WAIT_V(6); PG8_BAR; PG8_MMA(1, 1, At, B1); PG8_BAR;
            PG8_LDB(B0, 1, 0); PG8_SCHED; PG8_LDA(At, 1, 0); PG8_STAGE_A(PG8_SA(0, 1), 1, last, k2);
            PG8_WAIT_L(8); PG8_BAR; PG8_WAIT_L(0); PG8_MMA(0, 0, At, B0); PG8_BAR; PG8_SCHED;
            PG8_LDB(B1, 1, 1); PG8_STAGE_B(PG8_SB(1, 0), b3);
            PG8_BAR; PG8_WAIT_L(0); PG8_MMA(0, 1, At, B1); PG8_BAR;
            PG8_LDA(At, 1, 1); PG8_STAGE_A(PG8_SA(1, 0), 0, last, k3);
            PG8_BAR; PG8_WAIT_L(0); PG8_MMA(1, 0, At, B0); PG8_BAR; PG8_SCHED;
            PG8_STAGE_B(PG8_SB(1, 1), b3 + hstepB);
            PG8_WAIT_V(6); PG8_BAR; PG8_MMA(1, 1, At, B1); PG8_BAR;
        }
        if constexpr (PG_PROBE) { const unsigned pg_t1_ = (unsigned)__builtin_amdgcn_s_memrealtime(); if (wid == 0 && lane_now() == 0) { volatile LAS unsigned* pm_ = (volatile LAS unsigned*)(lds + LDS_MISC); pm_[3401] = pm_[3401] + (pg_t1_ - pg_t0_); } }
        if constexpr (FP8) asm volatile("s_nop 15\n\ts_nop 15" ::: "memory");
        { int fr2 = fr, fq2 = fq; asm volatile("" : "+v"(fr2), "+v"(fq2));
          E(acc, cur, wr, wc, fr2, fq2, side + (ui % 3) * SIDE_BYTES);
          if ((DUPSEL == 16 && FP8 && !GATHER) || (DUPSEL == 17 && FP8 && GATHER) || (DUPSEL == 18 && !FP8)) { asm volatile("" : "+v"(fr2), "+v"(fq2)); E(acc, cur, wr, wc, fr2, fq2, side + (ui % 3) * SIDE_BYTES); } }
        if (!has_next) break;
#pragma unroll
        for (int a = 0; a < 2; ++a)
#pragma unroll
            for (int b = 0; b < 2; ++b)
#pragma unroll
                for (int m = 0; m < 4; ++m)
#pragma unroll
                    for (int n = 0; n < 2; ++n) acc[a][b][m][n] = (f32x4){0.f, 0.f, 0.f, 0.f};
        cur = nxt; cA = nA; cB = nB; ++ui;
#pragma unroll
        for (int h = 0; h < 2; ++h)
#pragma unroll
            for (int i = 0; i < 2; ++i) cvo[h][i] = nvo[h][i];
    }
    PG8_WAIT_V(0);
    if (wr == 0) PG8_BAR;
    PG8_BAR;
#undef PG8_SA
#undef PG8_SB
#undef PG8_GLDS
#undef PG8_STAGE_A
#undef PG8_STAGE_B
#undef PG8_LDA
#undef PG8_LDB
#undef PG8_MMA
#undef PG8_WAIT_V
#undef PG8_WAIT_L
#undef PG8_BAR
#undef PG8_SCHED
#undef PG8_LOADVO
#undef PG8_SIDE_DMA
#undef PG8_GLDS4
}

struct SchedDense {
    int nM, nN, G, c, g; const char* A; const char* B; size_t a_tstep, b_tstep; int latent_only = 0;
    __device__ __forceinline__ bool next(int i, Unit& u) const {
        const int nwg = nM * nN; const long L = (long)i * G + c; if (L >= nwg) return false;
        int wgid = (int)L; { const int q = nwg / 8, r = nwg % 8, xcd = wgid % 8, off = wgid / 8; wgid = (xcd < r ? xcd * (q + 1) : r * (q + 1) + (xcd - r) * q) + off; }
        const int nig = 8 * nN, gid = wgid / nig, fm = gid * 8, gsz = (nM - fm) < 8 ? (nM - fm) : 8;
        u.pm = fm + ((wgid % nig) % gsz); u.pn = (wgid % nig) / gsz; u.g = g; u.e = 0; u.nvalid = 256; u.pad = 0;
        if (latent_only) u.pm = (u.pm >> 3) * 9 + 1 + (u.pm & 7);
        u.A = A + (size_t)u.pm * a_tstep; u.B = B + (size_t)u.pn * b_tstep; u.rows = nullptr; u.gates = nullptr; u.bias0 = nullptr; u.bias1 = nullptr; return true;
    }
};
struct SchedDual {
    int nM, nN0, nN1, G, c; const char* A0; const char* A1; const char* B0; const char* B1; size_t a_tstep, b_tstep;
    __device__ __forceinline__ bool next(int i, Unit& u) const {
        const int n0 = nM * nN0, n1 = nM * nN1; int L = i * G + c; if (L >= n0 + n1) return false;
        const int g = (L >= n0) ? 1 : 0; if (g) L -= n0; const int nN = g ? nN1 : nN0;
        u.pm = L / nN; u.pn = L % nN; u.g = g; u.e = 0; u.nvalid = 256; u.pad = 0;
        u.A = (g ? A1 : A0) + (size_t)u.pm * a_tstep; u.B = (g ? B1 : B0) + (size_t)u.pn * b_tstep; u.rows = nullptr; u.gates = nullptr; u.bias0 = nullptr; u.bias1 = nullptr; return true;
    }
};
struct SchedMoE {
    const LAS int* bb; const LAS int* cnt; const LAS int* be; int NT, G, c; const char* Acompact; size_t a_tstep; const char* W; size_t w_estep, w_tstep; const int* slot_tok; const float* slot_gate;
    const float* bias; int bias_estride, bias_seg1;
    int bias_pnstep;
    __device__ __forceinline__ bool next(int i, Unit& u) const {
        const int L = i * G + c; const int blk = L / NT, pn = L % NT;
        if (blk >= uni(bb[32])) return false;
        const int e = uni(be[blk]);
        const int rank0 = (blk - uni(bb[e])) * 256; int nv = uni(cnt[e]) - rank0; nv = nv > 256 ? 256 : nv;
        u.pm = blk; u.pn = pn; u.g = 0; u.e = e; u.nvalid = nv; u.pad = 0;
        u.A = unip(Acompact + (size_t)blk * a_tstep); u.B = unip(W + (size_t)e * w_estep + (size_t)pn * w_tstep);
        u.rows = (const int*)unip((const char*)(slot_tok + (size_t)e * CAP + rank0)); u.gates = (const float*)unip((const char*)(slot_gate + (size_t)e * CAP + rank0));
        u.bias0 = (const float*)unip((const char*)(bias + (size_t)e * bias_estride + pn * bias_pnstep)); u.bias1 = u.bias0 + bias_seg1; return true;
    }
};

__device__ __forceinline__ unsigned pk4_fp8(float a, float b, float c, float d) { int w = 0; w = __builtin_amdgcn_cvt_pk_fp8_f32(a, b, w, false); w = __builtin_amdgcn_cvt_pk_fp8_f32(c, d, w, true); return (unsigned)w; }
struct EpiBf16 {
    bf16_t* O; int ldc; float oscale = 1.0f;
    __device__ __forceinline__ void operator()(const f32x4 (&acc)[2][2][4][2], const Unit& u, int wr, int wc, int fr, int fq, LAS unsigned char* = nullptr) const {
        const int row0 = u.pm * BM + wr * 64 + fr, col0 = u.pn * BM + wc * 32 + 8 * fq;
#pragma unroll
        for (int ai = 0; ai < 2; ++ai)
#pragma unroll
            for (int m = 0; m < 4; ++m) { bf16_t* rowp = O + (size_t)(row0 + ai * HALF + m * 16) * ldc + col0;
#pragma unroll
                for (int bj = 0; bj < 2; ++bj) { const f32x4 v0 = acc[ai][bj][m][0] * oscale, v1 = acc[ai][bj][m][1] * oscale;
                    u32x4 w; w.x = cvt_pk_bf16(v0[0], v0[1]); w.y = cvt_pk_bf16(v0[2], v0[3]); w.z = cvt_pk_bf16(v1[0], v1[1]); w.w = cvt_pk_bf16(v1[2], v1[3]);
                    *(u32x4*)(rowp + bj * HALF) = w; } }
    }
};
struct EpiBf16U {
    bf16_t* O; int ldc; float oscale; bf16_t* UT;
    __device__ __forceinline__ void operator()(const f32x4 (&acc)[2][2][4][2], const Unit& u, int wr, int wc, int fr, int fq, LAS unsigned char* = nullptr) const {
        if (u.pn < 4) { EpiBf16 e; e.O = O; e.ldc = ldc; e.oscale = oscale; e(acc, u, wr, wc, fr, fq); return; }
        const int row0 = u.pm * BM + wr * 64 + fr, ch0 = (u.pn - 4) * BM + wc * 32 + 8 * fq;
        const int b = (u.pm * BM) / TPB, t0 = row0 - b * TPB;
#pragma unroll
        for (int ai = 0; ai < 2; ++ai)
#pragma unroll
            for (int m = 0; m < 4; ++m) { const int t = t0 + ai * HALF + m * 16;
#pragma unroll
                for (int bj = 0; bj < 2; ++bj) { const f32x4 v0 = acc[ai][bj][m][0] * oscale, v1 = acc[ai][bj][m][1] * oscale; const int ch = ch0 + bj * HALF;
                    u32x4 w; w.x = cvt_pk_bf16(v0[0], v0[1]); w.y = cvt_pk_bf16(v0[2], v0[3]); w.z = cvt_pk_bf16(v1[0], v1[1]); w.w = cvt_pk_bf16(v1[2], v1[3]);
                    *(u32x4*)(UT + ((((size_t)(ch >> 4) * TPB + t) * 16 + b) * 16 + (ch & 8))) = w; } }
    }
};
struct EpiFp8 {
    unsigned char* O; int ldc; float oscale;
    __device__ __forceinline__ void operator()(const f32x4 (&acc)[2][2][4][2], const Unit& u, int wr, int wc, int fr, int fq, LAS unsigned char* = nullptr) const {
        const int row0 = u.pm * BM + wr * 64 + fr, col0 = u.pn * BM + wc * 32 + 8 * fq;
#pragma unroll
        for (int ai = 0; ai < 2; ++ai)
#pragma unroll
            for (int m = 0; m < 4; ++m) { unsigned char* rowp = O + (size_t)(row0 + ai * HALF + m * 16) * ldc + col0;
#pragma unroll
                for (int bj = 0; bj < 2; ++bj) { const f32x4 v0 = acc[ai][bj][m][0] * oscale, v1 = acc[ai][bj][m][1] * oscale;
                    u32x2 w; w.x = pk4_fp8(v0[0], v0[1], v0[2], v0[3]); w.y = pk4_fp8(v1[0], v1[1], v1[2], v1[3]);
                    *(u32x2*)(rowp + bj * HALF) = w; } }
    }
};
struct EpiFp8P16 {
    unsigned char* O; int ldc; float oscale;
    __device__ __forceinline__ void operator()(const f32x4 (&acc)[2][2][4][2], const Unit& u, int wr, int wc, int fr, int fq, LAS unsigned char* = nullptr) const {
        const int row0 = u.pm * BM + wr * 64 + fr, col0 = u.pn * BM + wc * 64 + 16 * fq;
#pragma unroll
        for (int ai = 0; ai < 2; ++ai)
#pragma unroll
            for (int m = 0; m < 4; ++m) { u32x4 w;
#pragma unroll
                for (int bj = 0; bj < 2; ++bj) { const f32x4 v0 = acc[ai][bj][m][0] * oscale, v1 = acc[ai][bj][m][1] * oscale; w[2 * bj] = pk4_fp8(v0[0], v0[1], v0[2], v0[3]); w[2 * bj + 1] = pk4_fp8(v1[0], v1[1], v1[2], v1[3]); }
                *(u32x4*)(O + (size_t)(row0 + ai * HALF + m * 16) * ldc + col0) = w; }
    }
};
struct EpiGlu {
    const bf16_t* ZG; const float* bias; unsigned char* OL;
    __device__ __forceinline__ void operator()(const f32x4 (&acc)[2][2][4][2], const Unit& u, int wr, int wc, int fr, int fq, LAS unsigned char* = nullptr) const {
        const int row0 = u.pm * BM + wr * 64 + fr, col0 = u.pn * BM + wc * 32 + 8 * fq;
        f32x4 bv[2][2];
#pragma unroll
        for (int bj = 0; bj < 2; ++bj)
#pragma unroll
            for (int n = 0; n < 2; ++n) bv[bj][n] = *(const f32x4*)(bias + col0 + bj * HALF + 4 * n);
        u32x4 zwv[2][4][2];
#pragma unroll
        for (int ai = 0; ai < 2; ++ai)
#pragma unroll
            for (int m = 0; m < 4; ++m)
#pragma unroll
                for (int bj = 0; bj < 2; ++bj) zwv[ai][m][bj] = *(const u32x4*)(ZG + (size_t)(row0 + ai * HALF + m * 16) * 512 + col0 + bj * HALF);
#pragma unroll
        for (int ai = 0; ai < 2; ++ai)
#pragma unroll
            for (int m = 0; m < 4; ++m) { const int row = row0 + ai * HALF + m * 16;
#pragma unroll
                for (int bj = 0; bj < 2; ++bj) { const u32x4 zw = zwv[ai][m][bj];
                    const float z[8] = {bflo(zw.x), bfhi(zw.x), bflo(zw.y), bfhi(zw.y), bflo(zw.z), bfhi(zw.z), bflo(zw.w), bfhi(zw.w)}; float o[8];
#pragma unroll
                    for (int n = 0; n < 2; ++n)
#pragma unroll
                        for (int j = 0; j < 4; ++j) { const float a = acc[ai][bj][m][n][j] + bv[bj][n][j]; o[n * 4 + j] = 16.0f * z[n * 4 + j] * __builtin_amdgcn_rcpf(1.0f + __expf(-a)); }
                    u32x2 w; w.x = pk4_fp8(o[0], o[1], o[2], o[3]); w.y = pk4_fp8(o[4], o[5], o[6], o[7]);
                    *(u32x2*)(OL + (size_t)row * 1024 + 512 + col0 + bj * HALF) = w; } }
    }
};
struct EpiBf16Dual {
    bf16_t* O0; int ldc0; bf16_t* O1; int ldc1;
    __device__ __forceinline__ void operator()(const f32x4 (&acc)[2][2][4][2], const Unit& u, int wr, int wc, int fr, int fq, LAS unsigned char* = nullptr) const {
        EpiBf16 e; e.O = u.g ? O1 : O0; e.ldc = u.g ? ldc1 : ldc0; e(acc, u, wr, wc, fr, fq);
    }
};
constexpr float WSCALE = 64.0f, WSCALE_INV = 1.0f / 64.0f;
struct EpiSwiglu {
    unsigned char* Z; const float* bias;
    __device__ __forceinline__ void operator()(const f32x4 (&acc)[2][2][4][2], const Unit& u, int wr, int wc, int fr, int fq, LAS unsigned char* sd) const {
        const int row0 = u.pm * BM + wr * 64 + fr, c0 = u.pn * 128 + wc * 32 + 8 * fq;
        const LAS float* be = (const LAS float*)(sd + 1024) + wc * 32 + 8 * fq;
        const f32x4 bg0 = *(const LAS f32x4*)(be), bg1 = *(const LAS f32x4*)(be + 4), bl0 = *(const LAS f32x4*)(be + 128), bl1 = *(const LAS f32x4*)(be + 132);
#pragma unroll
        for (int ai = 0; ai < 2; ++ai)
#pragma unroll
            for (int m = 0; m < 4; ++m) {
                float o[8];
#pragma unroll
                for (int n = 0; n < 2; ++n) { const f32x4 ga = acc[ai][0][m][n], la = acc[ai][1][m][n], bg = n ? bg1 : bg0, bl = n ? bl1 : bl0;
#pragma unroll
                    for (int j = 0; j < 4; j += 2) {
                        f32x2 g2 = (f32x2){ga[j], ga[j + 1]} * WSCALE_INV + (f32x2){bg[j], bg[j + 1]}, l2 = (f32x2){la[j], la[j + 1]} * WSCALE_INV + (f32x2){bl[j], bl[j + 1]};
                        g2.x = __builtin_amdgcn_fmed3f(g2.x, -24.0f, 7.0f); g2.y = __builtin_amdgcn_fmed3f(g2.y, -24.0f, 7.0f); l2.x = __builtin_amdgcn_fmed3f(l2.x, -7.0f, 7.0f); l2.y = __builtin_amdgcn_fmed3f(l2.y, -7.0f, 7.0f);
                        const f32x2 t2 = g2 * -2.4554669595930157f; f32x2 a2; a2.x = __builtin_amdgcn_exp2f(t2.x); a2.y = __builtin_amdgcn_exp2f(t2.y); a2 = a2 + 1.0f;
                        const float r = __builtin_amdgcn_rcpf(a2.x * a2.y);
                        const f32x2 o2 = g2 * (l2 + 1.0f) * ((f32x2){a2.y, a2.x} * r);
                        o[n * 4 + j] = o2.x; o[n * 4 + j + 1] = o2.y; } }
                u32x2 w; w.x = pk4_fp8(o[0], o[1], o[2], o[3]); w.y = pk4_fp8(o[4], o[5], o[6], o[7]);
                *(u32x2*)(Z + (size_t)(row0 + ai * HALF + m * 16) * 1024 + c0) = w; }
    }
};
constexpr float Y2SCALE = 32.0f, Y2SCALE_INV = 1.0f / 32.0f;
struct EpiMoeOut {
    unsigned char* Y2; const float* bias;
    __device__ __forceinline__ void operator()(const f32x4 (&acc)[2][2][4][2], const Unit& u, int wr, int wc, int fr, int fq, LAS unsigned char* sd) const {
        const int r0 = wr * 64 + fr, col0 = u.pn * BM + wc * 64 + 16 * fq;
        const LAS float* be = (const LAS float*)(sd + 1024) + wc * 64 + 16 * fq;
        const LAS float* gts = (const LAS float*)(sd + 2048);
        f32x4 bv[2][2];
#pragma unroll
        for (int bj = 0; bj < 2; ++bj)
#pragma unroll
            for (int n = 0; n < 2; ++n) bv[bj][n] = *(const LAS f32x4*)(be + 8 * bj + 4 * n);
#pragma unroll
        for (int ai = 0; ai < 2; ++ai)
#pragma unroll
            for (int m = 0; m < 4; ++m) { const int r = r0 + ai * HALF + m * 16; const float gt = gts[r] * Y2SCALE;
                u32x4 w;
#pragma unroll
                for (int bj = 0; bj < 2; ++bj) { const f32x4 v0 = (acc[ai][bj][m][0] * WSCALE_INV + bv[bj][0]) * gt, v1 = (acc[ai][bj][m][1] * WSCALE_INV + bv[bj][1]) * gt;
                    w[2 * bj] = pk4_fp8(v0[0], v0[1], v0[2], v0[3]); w[2 * bj + 1] = pk4_fp8(v1[0], v1[1], v1[2], v1[3]); }
                *(u32x4*)(Y2 + (size_t)(u.pm * BM + r) * 1024 + col0) = w; }
    }
};
}


namespace att {
constexpr int NW = 8, QBLK = 32, KVBLK = 64, DV = 128;
typedef short s16x4 __attribute__((ext_vector_type(4)));
typedef float f32x16 __attribute__((ext_vector_type(16)));
#define SBAR() __builtin_amdgcn_sched_barrier(0)
__device__ __forceinline__ int crow(int r, int hi) { return (r & 3) + 8 * (r >> 2) + 4 * hi; }
__device__ __forceinline__ unsigned cvtpk(float lo, float hi) { unsigned r; asm volatile("v_cvt_pk_bf16_f32 %0, %1, %2" : "=v"(r) : "v"(lo), "v"(hi)); return r; }
template <int DK> __device__ __forceinline__ int kswz(int row, int colB) { return row * (DK * 2) + (colB ^ ((row & 7) << 4)); }
constexpr float THR = 8.f;

template <int DK, bool WINDOW>
__device__ __forceinline__ void partialSM(f32x16& p0, f32x16& p1, float& m_reg, float& mn, float& alpha, const bool masked, const int mbase) {
  constexpr float SCALE = (DK == 128) ? 0.088388347648318440f : 0.072168783648703220f;
  constexpr float C = SCALE * 1.4426950408889634f;
  if (WINDOW && masked) {
#pragma unroll
    for (int r = 0; r < 16; ++r) { const int d0 = mbase + (r & 3) + 8 * (r >> 2); const int d1 = d0 + 32;
      p0[r] = (d0 < -128 || d0 > 128) ? -1e30f : p0[r]; p1[r] = (d1 < -128 || d1 > 128) ? -1e30f : p1[r]; }
  }
  float pmax = p0[0];
#pragma unroll
  for (int r = 1; r < 16; ++r) pmax = fmaxf(pmax, p0[r]);
#pragma unroll
  for (int r = 0; r < 16; ++r) pmax = fmaxf(pmax, p1[r]);
  { auto rr = __builtin_amdgcn_permlane32_swap(__float_as_uint(pmax), __float_as_uint(pmax), false, false);
    pmax = fmaxf(__uint_as_float(rr[0]), __uint_as_float(rr[1])); }
  if (__builtin_expect(__all(pmax - m_reg <= THR / SCALE), 1)) { mn = m_reg; alpha = 1.f; }
  else { mn = fmaxf(m_reg, pmax); alpha = __builtin_amdgcn_exp2f((m_reg - mn) * C); m_reg = mn; }
  const float mnC = -mn * C;
#pragma unroll
  for (int r = 0; r < 16; ++r) p0[r] = fmaf(p0[r], C, mnC);
#pragma unroll
  for (int r = 0; r < 16; ++r) p1[r] = fmaf(p1[r], C, mnC);
#pragma unroll
  for (int r = 0; r < 16; ++r) p0[r] = __builtin_amdgcn_exp2f(p0[r]);
}
__device__ __forceinline__ void finishSM(f32x16& p0, f32x16& p1, float alpha, float& l_reg, bf16x8& pa0, bf16x8& pa1, bf16x8& pa2, bf16x8& pa3) {
#pragma unroll
  for (int r = 0; r < 16; ++r) p1[r] = __builtin_amdgcn_exp2f(p1[r]);
  float ps = 0;
#pragma unroll
  for (int r = 0; r < 16; ++r) ps += p0[r];
#pragma unroll
  for (int r = 0; r < 16; ++r) ps += p1[r];
  { auto rr = __builtin_amdgcn_permlane32_swap(__float_as_uint(ps), __float_as_uint(ps), false, false);
    ps = __uint_as_float(rr[0]) + __uint_as_float(rr[1]); }
  l_reg = l_reg * alpha + ps;
#define PK4(P, BASE, OUT) do { unsigned a0 = cvtpk(P[BASE + 0], P[BASE + 1]), a1 = cvtpk(P[BASE + 2], P[BASE + 3]);   \
    unsigned b0 = cvtpk(P[BASE + 4], P[BASE + 5]), b1 = cvtpk(P[BASE + 6], P[BASE + 7]);                              \
    auto r0 = __builtin_amdgcn_permlane32_swap(a0, b0, false, false); auto r1 = __builtin_amdgcn_permlane32_swap(a1, b1, false, false); \
    u32x4 w = {r0[0], r1[0], r0[1], r1[1]}; OUT = *reinterpret_cast<bf16x8*>(&w); } while (0)
  PK4(p0, 0, pa0); PK4(p0, 8, pa1); PK4(p1, 0, pa2); PK4(p1, 8, pa3);
#undef PK4
}
template <int DK>
__device__ __forceinline__ void qkt(f32x16& p0, f32x16& p1, const LAS char* Ks, const bf16x8* qr, int r32, int hi) {
  p0 = f32x16{}; p1 = f32x16{};
#pragma unroll
  for (int d0 = 0; d0 < DK / 16; ++d0) { const int cb = (d0 * 16 + hi * 8) * 2;
    const bf16x8 b0 = *reinterpret_cast<const LAS bf16x8*>(Ks + kswz<DK>(r32, cb));
    const bf16x8 b1 = *reinterpret_cast<const LAS bf16x8*>(Ks + kswz<DK>(32 + r32, cb));
    p0 = __builtin_amdgcn_mfma_f32_32x32x16_bf16(b0, qr[d0], p0, 0, 0, 0);
    p1 = __builtin_amdgcn_mfma_f32_32x32x16_bf16(b1, qr[d0], p1, 0, 0, 0); }
}
__device__ __forceinline__ int v_st(int k, int c) { const int kk = (k & ~0xC) | ((k & 4) << 1) | ((k & 8) >> 1); return ((kk >> 3) * 4 + (c >> 5)) * 512 + ((kk & 7) * 32 + (c & 31)) * 2; }
__device__ __forceinline__ int v_rd_base(int lane) { return ((lane & 3) << 3) | (((lane >> 2) & 3) << 6) | (((lane >> 4) & 1) << 5) | (((lane >> 5) & 1) << 8); }
constexpr int v_rd_off(int d0, int ks, int half) { return d0 * 512 + ks * 4096 + half * 2048; }
template <int OFF> __device__ __forceinline__ s16x4 tr_read(int vb) {
  s16x4 r; asm volatile("ds_read_b64_tr_b16 %0, %1 offset:%2" : "=&v"(r) : "v"(vb), "i"(OFF) : "memory"); return r;
}
template <int D0> __device__ __forceinline__ void pv_one(f32x16& od, int vb, bf16x8 pa0, bf16x8 pa1, bf16x8 pa2, bf16x8 pa3) {
  const s16x4 l0 = tr_read<v_rd_off(D0, 0, 0)>(vb), h0 = tr_read<v_rd_off(D0, 0, 1)>(vb), l1 = tr_read<v_rd_off(D0, 1, 0)>(vb), h1 = tr_read<v_rd_off(D0, 1, 1)>(vb);
  const s16x4 l2 = tr_read<v_rd_off(D0, 2, 0)>(vb), h2 = tr_read<v_rd_off(D0, 2, 1)>(vb), l3 = tr_read<v_rd_off(D0, 3, 0)>(vb), h3 = tr_read<v_rd_off(D0, 3, 1)>(vb);
  asm volatile("s_waitcnt lgkmcnt(0)" ::: "memory"); SBAR();
#define PK(L, H) (bf16x8){L[0], L[1], L[2], L[3], H[0], H[1], H[2], H[3]}
  od = __builtin_amdgcn_mfma_f32_32x32x16_bf16(pa0, PK(l0, h0), od, 0, 0, 0);
  od = __builtin_amdgcn_mfma_f32_32x32x16_bf16(pa1, PK(l1, h1), od, 0, 0, 0);
  od = __builtin_amdgcn_mfma_f32_32x32x16_bf16(pa2, PK(l2, h2), od, 0, 0, 0);
  od = __builtin_amdgcn_mfma_f32_32x32x16_bf16(pa3, PK(l3, h3), od, 0, 0, 0);
#undef PK
}
__device__ __forceinline__ void pv_d0(f32x16* o, int vb, bf16x8 pa0, bf16x8 pa1, bf16x8 pa2, bf16x8 pa3) {
  pv_one<0>(o[0], vb, pa0, pa1, pa2, pa3); pv_one<1>(o[1], vb, pa0, pa1, pa2, pa3); pv_one<2>(o[2], vb, pa0, pa1, pa2, pa3); pv_one<3>(o[3], vb, pa0, pa1, pa2, pa3);
}

struct Unit {
  const bf16_t* Q; int ldq;
  const bf16_t* K; int ldk;
  const bf16_t* KR; int ldkr;
  const bf16_t* V; int ldv;
  unsigned char* O; int ldo;
  int NT;
  int kofs;
  int q0;
  float sink; int has_sink;
  const float* rope; int rope_row, rope_col_base;
};

template <int DK, bool WINDOW, int SD, bool SIMPLE>
__device__ __forceinline__ void attn_unit(const Unit& U, LAS char* lds, const int wid0) {
  constexpr int SHM_V = KVBLK * DV * 2, SHM_K = KVBLK * DK * 2;
  constexpr float SCALE = (DK == 128) ? 0.088388347648318440f : 0.072168783648703220f;
  constexpr float C = SCALE * 1.4426950408889634f;
  constexpr int NKC = (DK == 128) ? 2 : 3;
  const int lane = lane_now(); const int wid = wid0; const int tid = wid0 * 64 + lane; const int r32 = lane & 31, hi = lane >> 5;
  LAS char* V_lds = lds; LAS char* K_lds = lds + 2 * SHM_V;
  LAS float* wsf = (LAS float*)(lds + 2 * SHM_V + 2 * SHM_K) + wid * 64; LAS float* li_l = wsf; LAS float* al_l = wsf + 32;
  float m_reg = -1e30f, l_reg = 0; f32x16 o[4] = {}; bf16x8 qr[DK / 16];
  const bf16_t* Qw = U.Q + (long)(wid * QBLK + r32) * U.ldq + hi * 8;
#pragma unroll
  for (int d0 = 0; d0 < DK / 16; ++d0) qr[d0] = *reinterpret_cast<const bf16x8*>(Qw + d0 * 16);
  if (DK == 192 && U.rope != nullptr) {
    const int pos = U.q0 + wid * QBLK + r32; const int ri = pos >> 6, ci = pos & 63;
#pragma unroll
    for (int hf = 0; hf < 2; ++hf) { const float* tp = U.rope + ((hf ? ci : ri) * 16 + hi * 8) * 2;
      bf16x8 x1 = qr[8 + 2 * hf], x2 = qr[9 + 2 * hf];
#pragma unroll
      for (int i = 0; i < 8; ++i) { const float c = tp[2 * i], sn = tp[2 * i + 1]; const float a = bf2f((unsigned short)x1[i]), b = bf2f((unsigned short)x2[i]);
        x1[i] = (short)f2bf(a * c - b * sn); x2[i] = (short)f2bf(b * c + a * sn); }
      qr[8 + 2 * hf] = x1; qr[9 + 2 * hf] = x2; }
  }
  const int sr = tid >> 4, sc = (tid & 15) * 8, vst0 = v_st(sr, sc), vst1 = v_st(32 + sr, sc);
  int krw[NKC], kcs[NKC], kdst[NKC];
#pragma unroll
  for (int i = 0; i < NKC; ++i) { const int id = tid + 512 * i; if (DK == 128) { krw[i] = (i == 0) ? sr : 32 + sr; kcs[i] = sc; } else { krw[i] = id / 24; kcs[i] = (id % 24) * 8; }
    kdst[i] = kswz<DK>(krw[i], kcs[i] * 2); }
  const int vb0 = (int)(uintptr_t)V_lds + v_rd_base(lane);
  struct { bf16x8 vs0, vs1, ks[NKC]; } sr_[SD];
  constexpr int SO = SD - 1;
  const int kofs = U.kofs;
#define KROW(j) (64 * (j) + (((j) >= 4) ? kofs : 0))
#define SLOAD(i, jt) do { const int _k0 = KROW(jt); sr_[i].vs0 = *reinterpret_cast<const bf16x8*>(&U.V[(long)(_k0 + sr) * U.ldv + sc]); sr_[i].vs1 = *reinterpret_cast<const bf16x8*>(&U.V[(long)(_k0 + 32 + sr) * U.ldv + sc]); \
    _Pragma("unroll") for (int _c = 0; _c < NKC; ++_c) { if (DK == 128 || kcs[_c] < 128) sr_[i].ks[_c] = *reinterpret_cast<const bf16x8*>(&U.K[(long)(_k0 + krw[_c]) * U.ldk + kcs[_c]]); \
      else sr_[i].ks[_c] = *reinterpret_cast<const bf16x8*>(&U.KR[(long)(_k0 + krw[_c]) * U.ldkr + (kcs[_c] - 128)]); } } while (0)
#define SWRITE(b, i) do { *(LAS bf16x8*)(V_lds + (b) * SHM_V + vst0) = sr_[i].vs0; *(LAS bf16x8*)(V_lds + (b) * SHM_V + vst1) = sr_[i].vs1; \
    _Pragma("unroll") for (int _c = 0; _c < NKC; ++_c) *(LAS bf16x8*)(K_lds + (b) * SHM_K + kdst[_c]) = sr_[i].ks[_c]; } while (0)
#define SWAIT() asm volatile("s_waitcnt vmcnt(%0)" :: "n"(SD == 2 ? 2 + NKC : 0) : "memory")
#define RESC(a) do { if (__any((a) < 1.f)) { if (hi == 0) al_l[r32] = (a); asm volatile("s_waitcnt lgkmcnt(0)" ::: "memory"); \
    _Pragma("unroll") for (int d = 0; d < 4; ++d) _Pragma("unroll") for (int r = 0; r < 16; ++r) o[d][r] *= al_l[crow(r, hi)]; } } while (0)
  const int qpos = U.q0 + wid * QBLK + r32;
#define MBASE(jt) (kofs + 64 * (jt) - 256 - qpos + 4 * hi)
  bf16x8 pa0, pa1, pa2, pa3; const int NT = U.NT;
  if constexpr (SIMPLE) {
    f32x16 p0, p1; float mn, al;
    SLOAD(0, 0); asm volatile("s_waitcnt vmcnt(0)" ::: "memory"); SWRITE(0, 0); __syncthreads();
    for (int j = 0; j < NT; ++j) {
      const int bsel = j & 1;
      if (j + 1 < NT) SLOAD(0, j + 1);
      SBAR(); qkt<DK>(p0, p1, K_lds + bsel * SHM_K, qr, r32, hi);
      partialSM<DK, WINDOW>(p0, p1, m_reg, mn, al, j >= 4, MBASE(j));
      RESC(al);
      finishSM(p0, p1, al, l_reg, pa0, pa1, pa2, pa3); SBAR();
      pv_d0(o, vb0 + bsel * SHM_V, pa0, pa1, pa2, pa3);
      if (j + 1 < NT) { asm volatile("s_waitcnt vmcnt(0)" ::: "memory"); SWRITE(bsel ^ 1, 0); }
      __syncthreads();
    }
  } else {
  f32x16 pA0, pA1, pB0, pB1; float mnA, mnB, alA, alB;
  SLOAD(0, 0); asm volatile("s_waitcnt vmcnt(0)" ::: "memory"); SWRITE(0, 0); __syncthreads();
  qkt<DK>(pA0, pA1, K_lds, qr, r32, hi); partialSM<DK, WINDOW>(pA0, pA1, m_reg, mnA, alA, false, 0);
  SLOAD(SO, 1); if (SD == 2 && 2 < NT) SLOAD(0, 2);
  SWAIT(); SWRITE(1, SO); __syncthreads();
  for (int j = 1; j + 1 < NT; j += 2) {
    SBAR(); qkt<DK>(pB0, pB1, K_lds + SHM_K, qr, r32, hi);
    finishSM(pA0, pA1, alA, l_reg, pa0, pa1, pa2, pa3); SBAR();
    SLOAD(SO, j + SD); SBAR();
    pv_d0(o, vb0, pa0, pa1, pa2, pa3); partialSM<DK, WINDOW>(pB0, pB1, m_reg, mnB, alB, j >= 4, MBASE(j));
    __syncthreads(); SWAIT(); SWRITE(0, 0);
    RESC(alB); __syncthreads();
    SBAR(); qkt<DK>(pA0, pA1, K_lds, qr, r32, hi);
    finishSM(pB0, pB1, alB, l_reg, pa0, pa1, pa2, pa3); SBAR();
    if (SD == 1 || j + 3 < NT) SLOAD(0, j + 1 + SD); SBAR();
    pv_d0(o, vb0 + SHM_V, pa0, pa1, pa2, pa3); partialSM<DK, WINDOW>(pA0, pA1, m_reg, mnA, alA, j + 1 >= 4, MBASE(j + 1));
    __syncthreads(); SWAIT(); SWRITE(1, SO);
    RESC(alA); __syncthreads();
  }
  SBAR(); qkt<DK>(pB0, pB1, K_lds + SHM_K, qr, r32, hi);
  finishSM(pA0, pA1, alA, l_reg, pa0, pa1, pa2, pa3); SBAR();
  pv_d0(o, vb0, pa0, pa1, pa2, pa3); partialSM<DK, WINDOW>(pB0, pB1, m_reg, mnB, alB, NT - 1 >= 4, MBASE(NT - 1));
  __syncthreads(); RESC(alB);
  finishSM(pB0, pB1, alB, l_reg, pa0, pa1, pa2, pa3); SBAR();
  pv_d0(o, vb0 + SHM_V, pa0, pa1, pa2, pa3);
  }
  if (WINDOW && U.has_sink) l_reg += __builtin_amdgcn_exp2f(U.sink * 1.4426950408889634f - m_reg * C);
  if (hi == 0) li_l[r32] = l_reg; asm volatile("s_waitcnt lgkmcnt(0)" ::: "memory");
  float rli[16];
#pragma unroll
  for (int r = 0; r < 16; ++r) rli[r] = __builtin_amdgcn_rcpf(li_l[crow(r, hi)]);
  __syncthreads();
  { LAS unsigned char* ot = (LAS unsigned char*)V_lds + wid * 4096;
#pragma unroll
    for (int r = 0; r < 16; ++r) { const int orow = crow(r, hi);
#pragma unroll
      for (int d0 = 0; d0 < 4; ++d0) { const float ov = o[d0][r] * rli[r] * 16.0f; ot[orow * 128 + d0 * 32 + r32] = (unsigned char)(__builtin_amdgcn_cvt_pk_fp8_f32(ov, ov, 0, false) & 0xff); } }
    asm volatile("s_waitcnt lgkmcnt(0)" ::: "memory");
    unsigned char* Ow = U.O + (long)(wid * QBLK + (lane >> 1)) * U.ldo + (lane & 1) * 64;
    const LAS unsigned char* os = ot + (lane >> 1) * 128 + (lane & 1) * 64;
#pragma unroll
    for (int q = 0; q < 4; ++q) *(u32x4*)(Ow + q * 16) = *(const LAS u32x4*)(os + q * 16); }
  __syncthreads();
#undef KROW
#undef SLOAD
#undef SWRITE
#undef SWAIT
#undef RESC
#undef MBASE
}
}

struct Args { const float* in[34]; float* out; unsigned char* ws; };

__device__ __forceinline__ void transpose_item(const float* W, int ldw, int K, bf16_t* WT, int k0, int n0, int drow0, LAS float* scr, int lane) {
#pragma unroll 32
    for (int i = 0; i < 32; ++i) { const int kk = 2 * i + (lane >> 5); scr[kk * 33 + (lane & 31)] = W[(size_t)(k0 + kk) * ldw + n0 + (lane & 31)]; }
    LDS_WAIT(); asm volatile("" ::: "memory");
    const int c = lane & 7;
#pragma unroll
    for (int j = 0; j < 4; ++j) { const int n = (lane >> 3) + 8 * j; const LAS float* s = scr + (8 * c) * 33 + n;
        u32x4 o; o.x = pk2(s[0 * 33], s[1 * 33]); o.y = pk2(s[2 * 33], s[3 * 33]); o.z = pk2(s[4 * 33], s[5 * 33]); o.w = pk2(s[6 * 33], s[7 * 33]);
        *(u32x4*)(WT + (size_t)(drow0 + n) * K + k0 + 8 * c) = o; }
    LDS_WAIT(); asm volatile("" ::: "memory");
}

__device__ __forceinline__ void transpose_item_fp8(const float* W, int ldw, int K, unsigned char* WT, int k0, int n0, int drow0, LAS float* scr, int lane) {
#pragma unroll 32
    for (int i = 0; i < 32; ++i) { const int kk = 2 * i + (lane >> 5); scr[kk * 33 + (lane & 31)] = W[(size_t)(k0 + kk) * ldw + n0 + (lane & 31)] * 64.0f; }
    LDS_WAIT(); asm volatile("" ::: "memory");
    const int c = lane & 7;
#pragma unroll
    for (int j = 0; j < 4; ++j) { const int n = (lane >> 3) + 8 * j; const LAS float* s = scr + (8 * c) * 33 + n;
        u32x2 o; o.x = pg8::pk4_fp8(s[0 * 33], s[1 * 33], s[2 * 33], s[3 * 33]); o.y = pg8::pk4_fp8(s[4 * 33], s[5 * 33], s[6 * 33], s[7 * 33]);
        *(u32x2*)(WT + (size_t)(drow0 + n) * K + k0 + 8 * c) = o; }
    LDS_WAIT(); asm volatile("" ::: "memory");
}
struct ConvHalf { const float* src; unsigned char* dst; int ldw; int drow[2]; };
__device__ __forceinline__ ConvHalf conv_half_of(const float* w_exp_in, const float* w_exp_out, unsigned char* WexpIn, unsigned char* WexpOut, int layer, int hidx) {
    const int g = hidx >> 1, hp = hidx & 1; ConvHalf c;
    if (g < 8192) { const int le = layer * 32 + (g >> 8), q = g & 255; const int k0 = (q >> 4) * 64, n0 = (q & 15) * 128 + 64 * hp;
        c.src = w_exp_in + (size_t)le * 1024 * 2048 + (size_t)k0 * 2048 + n0; c.ldw = 2048; c.dst = WexpIn + (size_t)le * 2048 * 1024 + k0;
#pragma unroll
        for (int sb = 0; sb < 2; ++sb) { const int nn = n0 + 32 * sb; c.drow[sb] = (nn < 1024) ? ((nn >> 7) * 256 + (nn & 127)) : (((nn - 1024) >> 7) * 256 + 128 + ((nn - 1024) & 127)); } }
    else { const int g2 = g - 8192; const int le = layer * 32 + (g2 >> 7), q = g2 & 127; const int k0 = (q >> 3) * 64, n0 = (q & 7) * 128 + 64 * hp;
        c.src = w_exp_out + (size_t)le * 1024 * 1024 + (size_t)k0 * 1024 + n0; c.ldw = 1024; c.dst = WexpOut + (size_t)le * 1024 * 1024 + k0; c.drow[0] = n0; c.drow[1] = n0 + 32; }
    return c;
}
#define CONV_LOAD(ch, wv) do { _Pragma("unroll") for (int sb_ = 0; sb_ < 2; ++sb_) _Pragma("unroll") for (int i_ = 0; i_ < 32; ++i_) { const int kk_ = 2 * i_ + (lane >> 5); wv[sb_][i_] = __builtin_nontemporal_load((ch).src + (size_t)kk_ * (ch).ldw + 32 * sb_ + (lane & 31)); } } while (0)
#define CONV_STORE(ch, wv) do { _Pragma("unroll") for (int sb_ = 0; sb_ < 2; ++sb_) { \
        _Pragma("unroll") for (int i_ = 0; i_ < 32; ++i_) { const int kk_ = 2 * i_ + (lane >> 5); scr[kk_ * 33 + (lane & 31)] = wv[sb_][i_] * 64.0f; } \
        LDS_WAIT(); asm volatile("" ::: "memory"); \
        _Pragma("unroll") for (int j_ = 0; j_ < 4; ++j_) { const int n_ = (lane >> 3) + 8 * j_; const LAS float* sp_ = scr + (8 * (lane & 7)) * 33 + n_; \
            u32x2 o_; o_.x = pg8::pk4_fp8(sp_[0 * 33], sp_[1 * 33], sp_[2 * 33], sp_[3 * 33]); o_.y = pg8::pk4_fp8(sp_[4 * 33], sp_[5 * 33], sp_[6 * 33], sp_[7 * 33]); \
            *(u32x2*)((ch).dst + (size_t)((ch).drow[sb_] + n_) * 1024 + 8 * (lane & 7)) = o_; } \
        LDS_WAIT(); asm volatile("" ::: "memory"); } } while (0)
__device__ __forceinline__ void expert_conv_run(const float* w_exp_in, const float* w_exp_out, unsigned char* WexpIn, unsigned char* WexpOut, int layer, int h0, int nh, LAS float* scr, int lane) {
    float wa[2][32], wb[2][32];
    ConvHalf ca = conv_half_of(w_exp_in, w_exp_out, WexpIn, WexpOut, layer, h0), cb = ca;
    CONV_LOAD(ca, wa);
#pragma clang loop unroll(disable)
    for (int h = 0; h < nh; h += 2) {
        cb = conv_half_of(w_exp_in, w_exp_out, WexpIn, WexpOut, layer, h0 + (h + 1) * 8); CONV_LOAD(cb, wb);
        CONV_STORE(ca, wa);
        if (h + 2 < nh) { ca = conv_half_of(w_exp_in, w_exp_out, WexpIn, WexpOut, layer, h0 + (h + 2) * 8); CONV_LOAD(ca, wa); }
        CONV_STORE(cb, wb);
    }
}
__device__ __forceinline__ bool conv_group(int& r, const float* W, int nmat, int K, int N, bf16_t* WT, int ldrows, LAS float* scr, int lane) {
    const int per = (K / 64) * (N / 32); if (r >= nmat * per) { r -= nmat * per; return false; }
    const int mi = r / per, q = r % per, kb = q / (N / 32), nb = q % (N / 32);
    transpose_item(W + (size_t)mi * K * N, N, K, WT + (size_t)mi * ldrows * K, kb * 64, nb * 32, nb * 32, scr, lane); return true;
}

typedef const Args __attribute__((address_space(4))) CArgs;
#define PHASE_ARGS() CArgs* A_ = (CArgs*)__builtin_amdgcn_kernarg_segment_ptr(); asm volatile("" : "+s"(A_)); unsigned char* const ws = A_->ws; (void)ws; int Gp = G, vcup = vcu, bxp = bx; asm volatile("" : "+s"(Gp), "+s"(vcup), "+s"(bxp)); (void)Gp; (void)vcup; (void)bxp
#define IN(k) (A_->in[k])
#define WSP(T, off) ((T*)(ws + (off)))
__global__ void __launch_bounds__(NTHR, 2) fwd_kernel(Args args) {
    extern __shared__ __attribute__((aligned(16))) unsigned char lds_raw[];
    LAS unsigned char* lds = (LAS unsigned char*)lds_raw;
    const int G = gridDim.x; const int bx = blockIdx.x; const int vcu = (G % 8 == 0) ? (bx % 8) * (G / 8) + bx / 8 : bx;
    volatile LAS unsigned* MISC = (volatile LAS unsigned*)(lds + LDS_MISC);
    const int wave0 = __builtin_amdgcn_readfirstlane((int)threadIdx.x >> 6);
    for (int u = threadIdx.x; u < (LDS_BYTES - LDS_MISC) / 4; u += NTHR) MISC[u] = 0u;
    __syncthreads();
    XcdBarrier bar = xcd_barrier_post((unsigned*)(args.ws + WS_CTL) + CW_BAR, MISC + 0);
    bar.x = (unsigned)wave0;
#define GRID_BAR() do { xcd_barrier(bar); if (DUPSEL == 15) xcd_barrier(bar); } while (0)
#define PROBE_MULT 4u
#define PT_SAMPLE(id) do { if (PROBE_MASK != 0ull) { const unsigned pt_now_ = (unsigned)__builtin_amdgcn_s_memrealtime(); if (wave0 == 0 && lane_now() == 0) { const unsigned pt_last_ = MISC[3400]; if ((PROBE_MASK >> (id)) & 1ull) MISC[3401] = MISC[3401] + (pt_now_ - pt_last_); MISC[3400] = pt_now_; } } } while (0)
#define GRID_BARP(id) do { GRID_BAR(); PT_SAMPLE(id); } while (0)
    const int NGW = G * NWAVES;
    PT_SAMPLE(0);

    {
        PHASE_IDS(); PHASE_ARGS();
        const float* in_c = IN(1); const float* in_cctx = IN(3); const float* w_mod = IN(4); const float* b_mod = IN(5);
        const float* w_mix_out = IN(8); const float* w_exp_in = IN(11); const float* w_exp_out = IN(13);
        const float* w_in_ab = IN(15); const float* w_glu = IN(26); const float* w_in_cd = IN(28); const float* w_uq = IN(31); const float* w_ukv = IN(32);
        float* MOD = WSP(float, WS_MOD); unsigned char* WexpIn = WSP(unsigned char, WS_WEXPIN); unsigned char* WexpOut = WSP(unsigned char, WS_WEXPOUT); unsigned char* Wmix = WSP(unsigned char, WS_WMIX);
        unsigned char* WinAB = WSP(unsigned char, WS_WINAB); unsigned char* WinCD = WSP(unsigned char, WS_WINCD); bf16_t* Wglu = WSP(bf16_t, WS_WGLU); bf16_t* Wuq = WSP(bf16_t, WS_WUQ); bf16_t* Wukv = WSP(bf16_t, WS_WUKV);
        float* T32 = WSP(float, WS_ROPE); float* T16 = T32 + 64 * 32 * 2;
        LAS float* scr = (LAS float*)(lds + LDS_STAGE + wave * 16384);
        constexpr int I_MIX = 16 * 32;
        constexpr int NIT = 4 * I_MIX + 2 * (16 * 48 + 16 * 50 + 8 * 16 + 4 * 24 + 4 * 32);
        for (int rep_ = 0; rep_ < DUPN(1); ++rep_)
        for (int it = gw; it < NIT; it += NGW) {
            int r = it;
            if (r < 4 * I_MIX) { const int mi = r / I_MIX, q = r % I_MIX, kb = q / 32, nb = q % 32;
                transpose_item_fp8(w_mix_out + (size_t)mi * 1024 * 1024, 1024, 1024, Wmix + (size_t)mi * 1024 * 1024, kb * 64, nb * 32, nb * 32, scr, lane); continue; }
            r -= 4 * I_MIX;
            if (r < 2 * 16 * 48) { const int mi = r / (16 * 48), q = r % (16 * 48), kb = q / 48, nb = q % 48;
                transpose_item_fp8(w_in_ab + (size_t)mi * 1024 * 1536, 1536, 1024, WinAB + (size_t)mi * 1536 * 1024, kb * 64, nb * 32, nb * 32, scr, lane); continue; }
            r -= 2 * 16 * 48;
            if (r < 2 * 16 * 50) { const int mi = r / (16 * 50), q = r % (16 * 50), kb = q / 50, nb = q % 50;
                transpose_item_fp8(w_in_cd + (size_t)mi * 1024 * 1600, 1600, 1024, WinCD + (size_t)mi * 1792 * 1024, kb * 64, nb * 32, nb * 32, scr, lane); continue; }
            r -= 2 * 16 * 50;
            if (conv_group(r, w_glu, 2, 512, 512, Wglu, 512, scr, lane)) continue;
            if (conv_group(r, w_uq, 2, 256, 768, Wuq, 768, scr, lane)) continue;
            (void)conv_group(r, w_ukv, 2, 256, 1024, Wukv, 1024, scr, lane);
        }
        PT_SAMPLE(20);
        for (int i = vcu * NTHR + tid; i < 2 * 192 * 1024 / 16; i += G * NTHR) { const int mi = i / (192 * 64), q = i % (192 * 64); *(u32x4*)(WinCD + ((size_t)mi * 1792 + 1600) * 1024 + (size_t)q * 16) = (u32x4){0u, 0u, 0u, 0u}; }
        { const float* w_router = IN(9); bf16_t* WRFo = WSP(bf16_t, WS_WRF);
          for (int i = vcu * NTHR + tid; i < 4 * 2 * 32 * 64 * 8; i += G * NTHR) { const int ii = i & 7, ln = (i >> 3) & 63, sidx = (i >> 9) & 31, nt = (i >> 14) & 1, l = i >> 15;
            const int k = 32 * sidx + 8 * (ln >> 4) + ii, e = nt * 16 + (ln & 15); const float w = w_router[((size_t)l * 1024 + k) * 32 + e]; const unsigned hi = f2bf(w); const unsigned lo = f2bf(w - bflo(hi));
            WRFo[(size_t)l * 65536 + ((size_t)(0 * 2 + nt) * 32 + sidx) * 512 + ln * 8 + ii] = (bf16_t)hi; WRFo[(size_t)l * 65536 + ((size_t)(1 * 2 + nt) * 32 + sidx) * 512 + ln * 8 + ii] = (bf16_t)lo; } }
        for (int i = vcu * NTHR + tid; i < 64 * 32 + 64 * 16; i += G * NTHR) {
            if (i < 64 * 32) { const int idx = i >> 5, j = i & 31; const float ang = (float)idx * expf(-(float)j * (1.0f / 32.0f) * 9.210340371976184f); float sn, cs; sincosf(ang, &sn, &cs); T32[i * 2] = cs; T32[i * 2 + 1] = sn; }
            else { const int q = i - 64 * 32, idx = q >> 4, j = q & 15; const float ang = (float)idx * expf(-(float)j * (1.0f / 16.0f) * 9.210340371976184f); float sn, cs; sincosf(ang, &sn, &cs); T16[q * 2] = cs; T16[q * 2 + 1] = sn; }
        }

        PT_SAMPLE(21);
        {
            const float* lam_re = IN(18); const float* lam_im = IN(19); const float* log_dt = IN(20); const float* b_re = IN(21); const float* b_im = IN(22); const float* c_re = IN(23); const float* c_im = IN(24);
            bf16_t* TFb = WSP(bf16_t, WS_TF); bf16_t* SFb = WSP(bf16_t, WS_SF); bf16_t* WFb = WSP(bf16_t, WS_WF); float* LAM16 = WSP(float, WS_LAM16);
            __syncthreads();
            LAS f32x2* Pw = (LAS f32x2*)(lds + LDS_STAGE);
            LAS f32x2* Bb = Pw + 17 * 64;
            LAS f32x2* Cc = Bb + 64 * 16;
            LAS float* Kt = (LAS float*)(Cc + 64 * 16);
            for (int unit = vcu - (G - 128); unit >= 0 && unit < 128; unit += G) {
                const int dir = (unit >> 5) & 1;
                for (int idx = tid; idx < 17 * 64; idx += NTHR) { const int tau = idx >> 6, n = idx & 63; const float lr = lam_re[unit * 64 + n], lim = lam_im[unit * 64 + n], dt = expf(log_dt[unit]);
                    const float mag = expf((float)tau * dt * lr); float sn, cs; sincosf((float)tau * dt * lim, &sn, &cs); Pw[idx] = (f32x2){mag * cs, mag * sn}; }
                for (int idx = tid; idx < 64 * 16; idx += NTHR) { const int n = idx >> 4; const float lr = lam_re[unit * 64 + n], lim = lam_im[unit * 64 + n], dt = expf(log_dt[unit]);
                    const float mag = expf(dt * lr); float sn, cs; sincosf(dt * lim, &sn, &cs); const float nr = mag * cs - 1.0f, ni = mag * sn; const float den = 1.0f / (lr * lr + lim * lim);
                    const float cbr = (nr * lr + ni * lim) * den, cbi = (ni * lr - nr * lim) * den;
                    const float br = b_re[(size_t)unit * 1024 + idx], bi = b_im[(size_t)unit * 1024 + idx]; Bb[idx] = (f32x2){cbr * br - cbi * bi, cbr * bi + cbi * br};
                    Cc[(idx & 63) * 16 + (idx >> 6)] = (f32x2){c_re[(size_t)unit * 1024 + idx], c_im[(size_t)unit * 1024 + idx]}; }
                __syncthreads();
                { const int tau = tid >> 5, cout = (tid >> 1) & 15, ch = tid & 1; float ka[8];
#pragma unroll
                  for (int j = 0; j < 8; ++j) ka[j] = 0.f;
                  for (int n = 0; n < 64; ++n) { const f32x2 c = Cc[n * 16 + cout], pw = Pw[tau * 64 + n]; const float tr = c.x * pw.x - c.y * pw.y, ti = c.x * pw.y + c.y * pw.x;
                      const LAS f32x4* bp = (const LAS f32x4*)(Bb + n * 16 + ch * 8);
#pragma unroll
                      for (int j = 0; j < 4; ++j) { const f32x4 b2 = bp[j]; ka[2 * j] += tr * b2[0] - ti * b2[1]; ka[2 * j + 1] += tr * b2[2] - ti * b2[3]; } }
#pragma unroll
                  for (int j = 0; j < 8; ++j) Kt[(tau * 16 + cout) * 16 + ch * 8 + j] = ka[j]; }
                __syncthreads();
                for (int pq = tid; pq < 16 * 64; pq += NTHR) { const int f = pq >> 6, l = pq & 63; const int cout = l & 15, kq = l >> 4, sl = kq >> 1;
                    const int tau = dir == 0 ? f - sl : f - 1 + sl; u32x4 w = (u32x4){0u, 0u, 0u, 0u};
                    if (tau >= 0 && tau <= 15) { const LAS f32x4* kp = (const LAS f32x4*)(Kt + (tau * 16 + cout) * 16 + (kq & 1) * 8); const f32x4 a = kp[0], b2 = kp[1];
                        w.x = pk2(a[0], a[1]); w.y = pk2(a[2], a[3]); w.z = pk2(b2[0], b2[1]); w.w = pk2(b2[2], b2[3]); }
                    *(u32x4*)(TFb + (size_t)unit * 8192 + (size_t)pq * 8) = w; }
                for (int pq = tid; pq < 64 * 64; pq += NTHR) { const int fr = pq >> 6, l = pq & 63;
                    { const int mt = fr >> 3, j = fr & 7; const int kp = mt * 16 + (l & 15), n = kp >> 1, ri = kp & 1; const int kidx0 = j * 32 + (l >> 4) * 8, sidx = kidx0 >> 4, cin0 = kidx0 & 15;
                      const int e = dir == 0 ? 15 - sidx : sidx; const f32x2 pw = Pw[e * 64 + n]; const LAS f32x4* bp = (const LAS f32x4*)(Bb + n * 16 + cin0); float o[8];
#pragma unroll
                      for (int q = 0; q < 4; ++q) { const f32x4 b2 = bp[q];
                          o[2 * q] = ri ? (pw.x * b2[1] + pw.y * b2[0]) : (pw.x * b2[0] - pw.y * b2[1]); o[2 * q + 1] = ri ? (pw.x * b2[3] + pw.y * b2[2]) : (pw.x * b2[2] - pw.y * b2[3]); }
                      u32x4 w; w.x = pk2(o[0], o[1]); w.y = pk2(o[2], o[3]); w.z = pk2(o[4], o[5]); w.w = pk2(o[6], o[7]);
                      *(u32x4*)(SFb + (size_t)unit * 32768 + (size_t)pq * 8) = w; }
                    { const int t = fr >> 2, ks = fr & 3; const int cout = l & 15, n0 = (ks * 32 + (l >> 4) * 8) >> 1; const int e = dir == 0 ? t + 1 : 16 - t; float o[8];
#pragma unroll
                      for (int q = 0; q < 4; ++q) { const f32x2 c = Cc[(n0 + q) * 16 + cout], pw = Pw[e * 64 + n0 + q]; o[2 * q] = c.x * pw.x - c.y * pw.y; o[2 * q + 1] = -(c.x * pw.y + c.y * pw.x); }
                      u32x4 w; w.x = pk2(o[0], o[1]); w.y = pk2(o[2], o[3]); w.z = pk2(o[4], o[5]); w.w = pk2(o[6], o[7]);
                      *(u32x4*)(WFb + (size_t)unit * 32768 + (size_t)pq * 8) = w; } }
                if (tid < 128) { const f32x2 pw = Pw[16 * 64 + (tid >> 1)]; LAM16[unit * 128 + tid] = (tid & 1) ? pw.y : pw.x; }
                __syncthreads();
            }
        }
        __syncthreads();
        PT_SAMPLE(22);
        LAS float* sl = (LAS float*)(lds + LDS_STAGE);
        LAS float* red = (LAS float*)(lds + LDS_STAGE + 1024 * 20 * 4);
        for (int i = tid; i < 17 * 1024; i += NTHR) { const int row = i >> 10, k = i & 1023; const float v = (row < 16) ? in_c[row * 1024 + k] : in_cctx[k]; sl[k * 20 + row] = v / (1.0f + __expf(-v)); }
        __syncthreads();
        PT_SAMPLE(23);
        for (int rep_ = 0; rep_ < DUPN(14); ++rep_)
        for (int it = vcu; it < 4 * 96 && vcu < G - 128; it += G - 128) {
            const int l = it / 96, cb = it % 96, c4 = lane & 15, ksub = lane >> 4, kg = wave;
            f32x4 a[17];
#pragma unroll
            for (int r = 0; r < 17; ++r) a[r] = (f32x4){0.f, 0.f, 0.f, 0.f};
            const float* wp = w_mod + ((size_t)l * 1024 + kg * 128 + ksub) * 6144 + cb * 64 + c4 * 4;
            for (int s0_ = 0; s0_ < 32; s0_ += 16) {
                f32x4 wv[16];
#pragma unroll
                for (int q = 0; q < 16; ++q) wv[q] = *(const f32x4*)(wp + (size_t)((s0_ + q) * 4) * 6144);
#pragma unroll
                for (int q = 0; q < 16; ++q) { const f32x4 w = wv[q]; const LAS float* sp = sl + (kg * 128 + (s0_ + q) * 4 + ksub) * 20;
                    const f32x4 s0 = *(const LAS f32x4*)(sp), s1 = *(const LAS f32x4*)(sp + 4), s2 = *(const LAS f32x4*)(sp + 8), s3 = *(const LAS f32x4*)(sp + 12); const float s4 = sp[16];
                    a[0] += s0[0] * w; a[1] += s0[1] * w; a[2] += s0[2] * w; a[3] += s0[3] * w; a[4] += s1[0] * w; a[5] += s1[1] * w; a[6] += s1[2] * w; a[7] += s1[3] * w;
                    a[8] += s2[0] * w; a[9] += s2[1] * w; a[10] += s2[2] * w; a[11] += s2[3] * w; a[12] += s3[0] * w; a[13] += s3[1] * w; a[14] += s3[2] * w; a[15] += s3[3] * w; a[16] += s4 * w; }
            }
#pragma unroll
            for (int r = 0; r < 17; ++r)
#pragma unroll
                for (int j = 0; j < 4; ++j) { float v = a[r][j]; v += shx(v, 16, lane); v += shx(v, 32, lane); a[r][j] = v; }
            if (lane < 16) {
#pragma unroll
                for (int r = 0; r < 17; ++r)
#pragma unroll
                    for (int j = 0; j < 4; ++j) red[(kg * 64 + c4 * 4 + j) * 17 + r] = a[r][j]; }
            __syncthreads();
            for (int o = tid; o < 64 * 17; o += NTHR) { const int c2 = o / 17, r = o % 17; float s = 0.f;
#pragma unroll
                for (int g8 = 0; g8 < 8; ++g8) s += red[(g8 * 64 + c2) * 17 + r];
                MOD[((size_t)l * 17 + r) * 6144 + cb * 64 + c2] = s + b_mod[l * 6144 + cb * 64 + c2]; }
            __syncthreads();
        }
    }
    GRID_BARP(1);
    { PHASE_IDS(); PHASE_ARGS();
    const float* in_x = IN(0); const float* in_ctx = IN(2); const float* MOD = WSP(float, WS_MOD); unsigned char* H = WSP(unsigned char, WS_H8);
    for (int row = gw; row < M; row += NGW) {
        const int b = row / TPB, t = row % TPB; const bool isctx = t < CTXL;
        const float* src = isctx ? in_ctx + ((size_t)b * CTXL + t) * DM : in_x + ((size_t)b * SEQ + (t - CTXL)) * DM;
        const float* mr = MOD + (size_t)(0 * 17 + (isctx ? 16 : b)) * 6144;
        f32x4 vq[4], shq[4], scq[4];
#pragma unroll
        for (int j = 0; j < 4; ++j) { const int col = 4 * lane + 256 * j; vq[j] = *(const f32x4*)(src + col); shq[j] = *(const f32x4*)(mr + col); scq[j] = *(const f32x4*)(mr + 1024 + col); }
#pragma unroll
        for (int j = 0; j < 4; ++j) { const int col = 4 * lane + 256 * j; const f32x4 v = vq[j];
            const f32x4 sh = shq[j], sc = scq[j]; const f32x4 h = v * (sc + 1.0f) + sh;
            *(unsigned*)(H + (size_t)row * DM + col) = pg8::pk4_fp8(h[0], h[1], h[2], h[3]); }
    } }
    GRID_BARP(2);

    for (int layer = 0; layer < DEPTH; ++layer) {
        const bool lastl = (layer == DEPTH - 1);
        const int li = layer >> 1;
        const bool even = (layer & 1) == 0;
#if !defined(NO_MIXER)
        if (even) {
            { PHASE_ARGS(); pg8::SchedDense S; S.nM = NPANEL; S.nN = 6; S.G = Gp; S.c = bxp; S.g = 0; S.A = (const char*)WSP(unsigned char, WS_H8); S.B = (const char*)(WSP(unsigned char, WS_WINAB) + (size_t)li * 1536 * 1024); S.a_tstep = (size_t)256 * 1024; S.b_tstep = (size_t)256 * 1024;
              pg8::EpiBf16U E; E.O = WSP(bf16_t, WS_PROJ); E.ldc = 1536; E.oscale = 1.0f / 64.0f; E.UT = WSP(bf16_t, WS_UT);
            for (int rep_ = 0; rep_ < DUPN(2); ++rep_)
              pg8::gemm_phase<pg8::EpiBf16U, pg8::SchedDense, false, true>(wave0, lds + LDS_STAGE, 1024, 1024, nullptr, S, E); }
            GRID_BARP(3);
            { PHASE_IDS(); PHASE_ARGS();
              bf16_t* PROJ = WSP(bf16_t, WS_PROJ); bf16_t* UT = WSP(bf16_t, WS_UT); const float* T32 = WSP(float, WS_ROPE);
              const float* gq = IN(16) + li * 128; const float* gk = IN(17) + li * 128;
              const int sub = lane & 15, half = sub >> 3, i0 = (sub & 7) * 4;
              const int colp[2] = {(lane >> 4) * 128 + half * 64 + i0, 512 + ((lane >> 4) & 1) * 128 + half * 64 + i0};
              f32x4 g1[2], g2[2];
#pragma unroll
              for (int pass = 0; pass < 2; ++pass) { const float* gg = (pass ? gk : gq) + half * 64 + i0; g1[pass] = *(const f32x4*)gg; g2[pass] = *(const f32x4*)(gg + 32); }
              for (int rb = gw * 3; rb < M; rb += NGW * 3) {
                u32x2 av[3][2], cv[3][2]; f32x4 tb[3][2];
#pragma unroll
                for (int r = 0; r < 3; ++r) { const bf16_t* pr = PROJ + (size_t)(rb + r) * 1536;
#pragma unroll
                    for (int pass = 0; pass < 2; ++pass) { av[r][pass] = *(const u32x2*)(pr + colp[pass]); cv[r][pass] = *(const u32x2*)(pr + colp[pass] + 32); }
                    { const int t_ = (rb + r) % TPB; const int pos_ = t_ < CTXL ? 0 : t_ - CTXL; const float* tp_ = T32 + ((half ? (pos_ & 63) : (pos_ >> 6)) * 32 + i0) * 2; tb[r][0] = *(const f32x4*)tp_; tb[r][1] = *(const f32x4*)(tp_ + 4); } }
#pragma unroll
                for (int r = 0; r < 3; ++r) { const int row = rb + r; const int b = row / TPB, t = row % TPB; const bool isctx = t < CTXL; const int pos = t - CTXL; const int ri = pos >> 6, ci = pos & 63;
                    bf16_t* pr = PROJ + (size_t)row * 1536;
#pragma unroll
                    for (int pass = 0; pass < 2; ++pass) {
                        const u32x2 a = av[r][pass], c2 = cv[r][pass];
                        float x1[4] = {bflo(a.x), bfhi(a.x), bflo(a.y), bfhi(a.y)}, x2[4] = {bflo(c2.x), bfhi(c2.x), bflo(c2.y), bfhi(c2.y)};
                        float ss = 0.f;
#pragma unroll
                        for (int i = 0; i < 4; ++i) ss += x1[i] * x1[i] + x2[i] * x2[i];
                        ss = row16_sum(ss);
                        const float rinv = 1.0f / sqrtf(ss * (1.0f / 128.0f) + 1e-6f);
#pragma unroll
                        for (int i = 0; i < 4; ++i) { x1[i] = x1[i] * rinv * g1[pass][i]; x2[i] = x2[i] * rinv * g2[pass][i]; }
                        if (!isctx) { const float tpv[8] = {tb[r][0][0], tb[r][0][1], tb[r][0][2], tb[r][0][3], tb[r][1][0], tb[r][1][1], tb[r][1][2], tb[r][1][3]};
#pragma unroll
                            for (int i = 0; i < 4; ++i) { const float cs = tpv[2 * i], sn = tpv[2 * i + 1]; const float o1 = x1[i] * cs - x2[i] * sn, o2 = x2[i] * cs + x1[i] * sn; x1[i] = o1; x2[i] = o2; } }
                        if (pass == 0 || lane < 32) { u32x2 w; w.x = pk2(x1[0], x1[1]); w.y = pk2(x1[2], x1[3]); *(u32x2*)(pr + colp[pass]) = w; w.x = pk2(x2[0], x2[1]); w.y = pk2(x2[2], x2[3]); *(u32x2*)(pr + colp[pass] + 32) = w; }
                    }
                }
              } }
            GRID_BARP(4);
            { PHASE_IDS(); PHASE_ARGS();
              const bf16_t* UT = WSP(bf16_t, WS_UT); const bf16_t* SFb = WSP(bf16_t, WS_SF); unsigned short* XS = WSP(unsigned short, WS_XS);
              for (int rep_ = 0; rep_ < DUPN(7); ++rep_)
              for (int unit = vcu; unit < 256; unit += G) {
                const int g = unit >> 3, r8 = unit & 7;
                bf16x8 sa[2][8];
#pragma unroll
                for (int d = 0; d < 2; ++d)
#pragma unroll
                    for (int j = 0; j < 8; ++j) sa[d][j] = *(const bf16x8*)(SFb + ((size_t)((li * 2 + d) * 32 + g) * 64 + wave * 8 + j) * 512 + lane * 8);
                const int b = lane & 15, kq = lane >> 4;
                for (int c = r8 * 18; c < r8 * 18 + 18; ++c) {
                    f32x4 a0 = (f32x4){0.f, 0.f, 0.f, 0.f}, a1 = a0; bf16x8 ub[8];
#pragma unroll
                    for (int j = 0; j < 8; ++j) ub[j] = *(const bf16x8*)(UT + (((size_t)g * TPB + c * 16 + 2 * j + (kq >> 1)) * 16 + b) * 16 + (kq & 1) * 8);
#pragma unroll
                    for (int j = 0; j < 8; ++j) { a0 = __builtin_amdgcn_mfma_f32_16x16x32_bf16(sa[0][j], ub[j], a0, 0, 0, 0); a1 = __builtin_amdgcn_mfma_f32_16x16x32_bf16(sa[1][j], ub[j], a1, 0, 0, 0); }
                    *(u32x2*)(XS + ((size_t)(g * 2 + 0) * 144 + c) * 2048 + b * 128 + wave * 16 + 4 * kq) = f32_to_h4(a0);
                    *(u32x2*)(XS + ((size_t)(g * 2 + 1) * 144 + c) * 2048 + b * 128 + wave * 16 + 4 * kq) = f32_to_h4(a1);
                }
              } }
            { PHASE_ARGS(); bf16_t* PROJ = WSP(bf16_t, WS_PROJ); unsigned char* OL8 = WSP(unsigned char, WS_OL);
              const float* w_exp_in = IN(11); const float* w_exp_out = IN(13); unsigned char* WexpIn = WSP(unsigned char, WS_WEXPIN); unsigned char* WexpOut = WSP(unsigned char, WS_WEXPOUT);
#define EXPERT_CONV() do { __syncthreads(); const int ln_ = lane_now(); LAS float* scr_ = (LAS float*)(lds + LDS_STAGE + wave0 * 16384); \
                expert_conv_run(w_exp_in, w_exp_out, WexpIn, WexpOut, layer, vcu * 96 + wave0, 12, scr_, ln_); __syncthreads(); } while (0)
              for (int rep_ = 0; rep_ < DUPN(3); ++rep_) {
              int it_ = 0; const int slot_ = (rep_ == 0) ? (vcu % 3) : 99;
              for (int u = vcu; u < 576; u += G, ++it_) {
                if (it_ == slot_) EXPERT_CONV();
                att::Unit U; int b, h, row0;
                if (u < 512) { b = u >> 5; h = (u >> 3) & 3; row0 = b * TPB + CTXL + (u & 7) * 256; U.NT = 36; } else { const int uc = u - 512; b = uc >> 2; h = uc & 3; row0 = b * TPB; U.NT = 4; }
                const bf16_t* kb = PROJ + (size_t)b * TPB * 1536;
                U.Q = PROJ + (size_t)row0 * 1536 + h * 128; U.ldq = 1536; U.K = kb + 512 + (h >> 1) * 128; U.ldk = 1536; U.KR = nullptr; U.ldkr = 0; U.V = kb + 768 + (h >> 1) * 128; U.ldv = 1536;
                U.O = OL8 + (size_t)row0 * 1024 + h * 128; U.ldo = 1024; U.kofs = 0; U.q0 = 0; U.sink = 0.f; U.has_sink = 0; U.rope = nullptr; U.rope_row = 0; U.rope_col_base = 0;
                att::attn_unit<128, false, 2, false>(U, (LAS char*)(lds + LDS_STAGE), wave0);
              }
              if (it_ <= slot_ && slot_ != 99) EXPERT_CONV(); } }
            GRID_BARP(5);
            { PHASE_IDS(); PHASE_ARGS();
              const unsigned short* XS = WSP(unsigned short, WS_XS); bf16_t* HIN = WSP(bf16_t, WS_HIN); const float* LAM16 = WSP(float, WS_LAM16);
              const int id = vcu * 256 + (tid & 255);
              for (int rep_ = 0; rep_ < DUPN(8); ++rep_)
              if (wave < 4) {
                const int n = id & 63, b = (id >> 6) & 15, gd = id >> 10, g = gd >> 1, dir = gd & 1;
                const f32x2 lam = *(const f32x2*)(LAM16 + ((li * 2 + dir) * 32 + g) * 128 + 2 * n);
                const unsigned short* xp = XS + (size_t)gd * 144 * 2048 + b * 128 + 2 * n;
                bf16_t* hp = HIN + (size_t)gd * 144 * 2048 + (((2 * n) >> 5) * 64 + (((2 * n) >> 3) & 3) * 16 + b) * 8 + ((2 * n) & 7);
                float hr = 0.f, hi2 = 0.f;
#define S5B_CC(st) (dir == 0 ? (st) : ((st) < 16 ? 15 - (st) : 159 - (st)))
#define S5B_LOAD(buf, s1) do { _Pragma("unroll") for (int q = 0; q < 12; ++q) buf[q] = *(const unsigned*)(xp + (size_t)S5B_CC((s1) + q) * 2048); } while (0)
#define S5B_USE(buf, s1) do { _Pragma("unroll") for (int q = 0; q < 12; ++q) { *(unsigned*)(hp + (size_t)S5B_CC((s1) + q) * 2048) = pk2(hr, hi2); \
                        const float nr = lam.x * hr - lam.y * hi2 + h2f((unsigned short)(buf[q] & 0xffffu)), ni = lam.x * hi2 + lam.y * hr + h2f((unsigned short)(buf[q] >> 16)); hr = nr; hi2 = ni; } } while (0)
                unsigned xa[12], xb[12];
                S5B_LOAD(xa, 0); S5B_LOAD(xb, 12);
                for (int s0 = 0; s0 < 144; s0 += 24) {
                    S5B_USE(xa, s0); if (s0 + 24 < 144) S5B_LOAD(xa, s0 + 24);
                    S5B_USE(xb, s0 + 12); if (s0 + 36 < 144) S5B_LOAD(xb, s0 + 36);
                }
#undef S5B_CC
#undef S5B_LOAD
#undef S5B_USE
              } }
            GRID_BARP(6);
            { PHASE_IDS(); PHASE_ARGS();
              const bf16_t* UT = WSP(bf16_t, WS_UT); const bf16_t* TFb = WSP(bf16_t, WS_TF); const bf16_t* WFb = WSP(bf16_t, WS_WF); const bf16_t* HIN = WSP(bf16_t, WS_HIN);
              const bf16_t* PROJ = WSP(bf16_t, WS_PROJ); bf16_t* ZG = WSP(bf16_t, WS_ZG); const float* s5d = IN(25) + li * 512;
              LAS unsigned char* tfl = lds + LDS_STAGE;
              for (int rep_ = 0; rep_ < DUPN(9); ++rep_)
              for (int unit = vcu; unit < 256; unit += G) {
                const int g = unit >> 3, r8 = unit & 7;
                __syncthreads();
                for (int i = tid; i < 2048; i += NTHR) { const int d = i >> 10, q = i & 1023; *(LAS u32x4*)(tfl + (size_t)i * 16) = *(const u32x4*)(TFb + (size_t)((li * 2 + d) * 32 + g) * 8192 + q * 8); }
                bf16x8 wf[2][2][4];
#pragma unroll
                for (int d = 0; d < 2; ++d)
#pragma unroll
                    for (int tt = 0; tt < 2; ++tt)
#pragma unroll
                        for (int ks = 0; ks < 4; ++ks) wf[d][tt][ks] = *(const bf16x8*)(WFb + ((size_t)((li * 2 + d) * 32 + g) * 64 + (2 * wave + tt) * 4 + ks) * 512 + lane * 8);
                __syncthreads();
                const int b = lane & 15, kq = lane >> 4;
                const f32x4 dsk = *(const f32x4*)(s5d + g * 16 + 4 * kq);
                for (int c = r8 * 18; c < r8 * 18 + 18; ++c) {
                    f32x4 a0 = (f32x4){0.f, 0.f, 0.f, 0.f}, a1 = a0; bf16x8 hbv[2][4], ubv[8]; u32x2 uwv[2];
#pragma unroll
                    for (int d = 0; d < 2; ++d)
#pragma unroll
                        for (int ks = 0; ks < 4; ++ks) hbv[d][ks] = *(const bf16x8*)(HIN + ((size_t)(g * 2 + d) * 144 + c) * 2048 + (ks * 64 + lane) * 8);
#pragma unroll
                    for (int j = 0; j < 8; ++j) ubv[j] = *(const bf16x8*)(UT + (((size_t)g * TPB + c * 16 + 2 * j + (kq >> 1)) * 16 + b) * 16 + (kq & 1) * 8);
#pragma unroll
                    for (int tt = 0; tt < 2; ++tt) uwv[tt] = *(const u32x2*)(UT + (((size_t)g * TPB + c * 16 + 2 * wave + tt) * 16 + b) * 16 + 4 * kq);
#pragma unroll
                    for (int d = 0; d < 2; ++d)
#pragma unroll
                        for (int ks = 0; ks < 4; ++ks) { const bf16x8 hb = hbv[d][ks];
                            a0 = __builtin_amdgcn_mfma_f32_16x16x32_bf16(wf[d][0][ks], hb, a0, 0, 0, 0); a1 = __builtin_amdgcn_mfma_f32_16x16x32_bf16(wf[d][1][ks], hb, a1, 0, 0, 0); }
#pragma unroll
                    for (int j = 0; j < 8; ++j) { const bf16x8 ub = ubv[j];
                        if (j <= wave) { const bf16x8 t0 = *(const LAS bf16x8*)(tfl + ((2 * wave - 2 * j) * 64 + lane) * 16), t1 = *(const LAS bf16x8*)(tfl + ((2 * wave + 1 - 2 * j) * 64 + lane) * 16);
                            a0 = __builtin_amdgcn_mfma_f32_16x16x32_bf16(t0, ub, a0, 0, 0, 0); a1 = __builtin_amdgcn_mfma_f32_16x16x32_bf16(t1, ub, a1, 0, 0, 0); }
                        if (j >= wave) { const bf16x8 t0 = *(const LAS bf16x8*)(tfl + ((16 + 2 * j - 2 * wave + 1) * 64 + lane) * 16), t1 = *(const LAS bf16x8*)(tfl + ((16 + 2 * j - 2 * wave) * 64 + lane) * 16);
                            a0 = __builtin_amdgcn_mfma_f32_16x16x32_bf16(t0, ub, a0, 0, 0, 0); a1 = __builtin_amdgcn_mfma_f32_16x16x32_bf16(t1, ub, a1, 0, 0, 0); } }
#pragma unroll
                    for (int tt = 0; tt < 2; ++tt) { const size_t row = (size_t)b * TPB + c * 16 + 2 * wave + tt; const f32x4 av = tt ? a1 : a0;
                        const u32x2 uw = uwv[tt]; const float uu[4] = {bflo(uw.x), bfhi(uw.x), bflo(uw.y), bfhi(uw.y)}; float z[4];
#pragma unroll
                        for (int i = 0; i < 4; ++i) { const float y = av[i] + dsk[i] * uu[i]; const float a = 0.7978845608028654f * (y + 0.044715f * y * y * y);
                            const float th = 1.0f - 2.0f * __builtin_amdgcn_rcpf(1.0f + __expf(2.0f * a)); z[i] = 0.5f * y * (1.0f + th); }
                        u32x2 w; w.x = pk2(z[0], z[1]); w.y = pk2(z[2], z[3]); *(u32x2*)(ZG + row * 512 + g * 16 + 4 * kq) = w; }
                }
              } }
            GRID_BARP(7);
            { PHASE_ARGS(); pg8::SchedDense S; S.nM = NPANEL; S.nN = 2; S.G = Gp; S.c = bxp; S.g = 0; S.A = (const char*)WSP(bf16_t, WS_ZG); S.B = (const char*)(WSP(bf16_t, WS_WGLU) + (size_t)li * 512 * 512); S.a_tstep = (size_t)256 * 512 * 2; S.b_tstep = (size_t)256 * 512 * 2;
              pg8::EpiGlu E; E.ZG = WSP(bf16_t, WS_ZG); E.bias = IN(27) + li * 512; E.OL = WSP(unsigned char, WS_OL);
            for (int rep_ = 0; rep_ < DUPN(10); ++rep_)
              pg8::gemm_phase<pg8::EpiGlu, pg8::SchedDense, false, false>(wave0, lds + LDS_STAGE, 1024, 1024, nullptr, S, E); }
            GRID_BARP(8);
        } else {
#if !defined(NO_ODD)
            { PHASE_ARGS(); pg8::SchedDense S; S.nM = NPANEL; S.nN = 7; S.G = Gp; S.c = bxp; S.g = 0; S.A = (const char*)WSP(unsigned char, WS_H8); S.B = (const char*)(WSP(unsigned char, WS_WINCD) + (size_t)li * 1792 * 1024); S.a_tstep = (size_t)256 * 1024; S.b_tstep = (size_t)256 * 1024;
              pg8::EpiBf16 E; E.O = WSP(bf16_t, WS_PROJ); E.ldc = 1792; E.oscale = 1.0f / 64.0f;
            for (int rep_ = 0; rep_ < DUPN(2); ++rep_)
              pg8::gemm_phase<pg8::EpiBf16, pg8::SchedDense, false, true>(wave0, lds + LDS_STAGE, 1024, 1024, nullptr, S, E); }
            GRID_BARP(9);
            { PHASE_IDS(); PHASE_ARGS();
              bf16_t* PROJ = WSP(bf16_t, WS_PROJ); const float* T32 = WSP(float, WS_ROPE); const float* T16 = T32 + 64 * 32 * 2;
              const float* gq = IN(29) + li * 256; const float* gkv = IN(30) + li * 256;
              const f32x4 gq4 = *(const f32x4*)(gq + lane * 4), gkv4 = *(const f32x4*)(gkv + lane * 4);
              const int sub = lane & 15, half = sub >> 3, i0 = (sub & 7) * 4;
              const int colp[2] = {576 + (lane >> 4) * 128 + half * 64 + i0, 1088 + ((lane >> 4) & 1) * 128 + half * 64 + i0};
              const int kh = (lane >> 4) & 1, ki = lane & 15, kcol = 512 + kh * 32 + ki;
              for (int rb = gw * 3; rb < M; rb += NGW * 3) {
                u32x2 nv[3][2], av[3][2], cv[3][2]; unsigned short kr[3][2]; f32x4 tb[3][2]; f32x2 tk[3];
#pragma unroll
                for (int r = 0; r < 3; ++r) { const bf16_t* pr = PROJ + (size_t)(rb + r) * 1792;
#pragma unroll
                    for (int pass = 0; pass < 2; ++pass) { nv[r][pass] = *(const u32x2*)(pr + pass * 256 + lane * 4); av[r][pass] = *(const u32x2*)(pr + colp[pass]); cv[r][pass] = *(const u32x2*)(pr + colp[pass] + 32); }
                    kr[r][0] = pr[kcol]; kr[r][1] = pr[kcol + 16];
                    { const int t_ = (rb + r) % TPB; const int pos_ = t_ < CTXL ? 0 : t_ - CTXL; const float* tp_ = T32 + ((half ? (pos_ & 63) : (pos_ >> 6)) * 32 + i0) * 2; tb[r][0] = *(const f32x4*)tp_; tb[r][1] = *(const f32x4*)(tp_ + 4);
                      tk[r] = *(const f32x2*)(T16 + ((kh ? (pos_ & 63) : (pos_ >> 6)) * 16 + ki) * 2); } }
#pragma unroll
                for (int r = 0; r < 3; ++r) { const int row = rb + r; const int t = row % TPB; const bool isctx = t < CTXL; const int pos = t - CTXL; const int ri = pos >> 6, ci = pos & 63;
                    bf16_t* pr = PROJ + (size_t)row * 1792;
#pragma unroll
                    for (int pass = 0; pass < 2; ++pass) { const u32x2 a = nv[r][pass];
                        float x[4] = {bflo(a.x), bfhi(a.x), bflo(a.y), bfhi(a.y)}; const float ss = wave_sum(x[0] * x[0] + x[1] * x[1] + x[2] * x[2] + x[3] * x[3], lane);
                        const float rinv = 1.0f / sqrtf(ss * (1.0f / 256.0f) + 1e-6f); const f32x4 g4 = pass ? gkv4 : gq4;
                        u32x2 w; w.x = pk2(x[0] * rinv * g4[0], x[1] * rinv * g4[1]); w.y = pk2(x[2] * rinv * g4[2], x[3] * rinv * g4[3]); *(u32x2*)(pr + pass * 256 + lane * 4) = w; }
                    if (!isctx) {
                        if (lane < 32) { const float a = bf2f(kr[r][0]), c2 = bf2f(kr[r][1]);
                            const float cs = tk[r][0], sn = tk[r][1];
                            pr[kcol] = (bf16_t)f2bf(a * cs - c2 * sn); pr[kcol + 16] = (bf16_t)f2bf(c2 * cs + a * sn); }
#pragma unroll
                        for (int pass = 0; pass < 2; ++pass) {
                            const u32x2 a = av[r][pass], c2 = cv[r][pass];
                            float x1[4] = {bflo(a.x), bfhi(a.x), bflo(a.y), bfhi(a.y)}, x2[4] = {bflo(c2.x), bfhi(c2.x), bflo(c2.y), bfhi(c2.y)};
                            const float tpv[8] = {tb[r][0][0], tb[r][0][1], tb[r][0][2], tb[r][0][3], tb[r][1][0], tb[r][1][1], tb[r][1][2], tb[r][1][3]};
#pragma unroll
                            for (int i = 0; i < 4; ++i) { const float cs = tpv[2 * i], sn = tpv[2 * i + 1]; const float o1 = x1[i] * cs - x2[i] * sn, o2 = x2[i] * cs + x1[i] * sn; x1[i] = o1; x2[i] = o2; }
                            if (pass == 0 || lane < 32) { u32x2 w; w.x = pk2(x1[0], x1[1]); w.y = pk2(x1[2], x1[3]); *(u32x2*)(pr + colp[pass]) = w; w.x = pk2(x2[0], x2[1]); w.y = pk2(x2[2], x2[3]); *(u32x2*)(pr + colp[pass] + 32) = w; }
                        }
                    }
                }
              } }
            GRID_BARP(10);
            { PHASE_ARGS(); bf16_t* PROJ = WSP(bf16_t, WS_PROJ); pg8::SchedDual S; S.nM = NPANEL; S.nN0 = 3; S.nN1 = 4; S.G = Gp; S.c = vcup; S.A0 = (const char*)PROJ; S.A1 = (const char*)(PROJ + 256);
              S.B0 = (const char*)(WSP(bf16_t, WS_WUQ) + (size_t)li * 768 * 256); S.B1 = (const char*)(WSP(bf16_t, WS_WUKV) + (size_t)li * 1024 * 256); S.a_tstep = (size_t)256 * 1792 * 2; S.b_tstep = (size_t)256 * 256 * 2;
              pg8::EpiBf16Dual E; E.O0 = WSP(bf16_t, WS_QM); E.ldc0 = 768; E.O1 = WSP(bf16_t, WS_KVM); E.ldc1 = 1024;
            for (int rep_ = 0; rep_ < DUPN(11); ++rep_)
              pg8::gemm_phase<pg8::EpiBf16Dual, pg8::SchedDual, false, false>(wave0, lds + LDS_STAGE, 512, 3584, nullptr, S, E); }
            GRID_BARP(11);
            { PHASE_ARGS(); bf16_t* PROJ = WSP(bf16_t, WS_PROJ); unsigned char* OL8 = WSP(unsigned char, WS_OL); bf16_t* QM = WSP(bf16_t, WS_QM); bf16_t* KVM = WSP(bf16_t, WS_KVM); const float* T16 = WSP(float, WS_ROPE) + 64 * 32 * 2; const float* d_sink = IN(33);
              const float* w_exp_in = IN(11); const float* w_exp_out = IN(13); unsigned char* WexpIn = WSP(unsigned char, WS_WEXPIN); unsigned char* WexpOut = WSP(unsigned char, WS_WEXPOUT);
              for (int rep_ = 0; rep_ < DUPN(3); ++rep_) {
              int it_ = 0; const int slot_ = (rep_ == 0) ? (vcu & 3) : 99;
              for (int u = vcu; u < (lastl ? 1024 : 1152); u += G, ++it_) {
                if (it_ == slot_) EXPERT_CONV();
                att::Unit U; int b, h, row0, qb; bool mla, ctxq;
                if (u < 512) { mla = true; ctxq = false; b = u >> 5; h = (u >> 3) & 3; qb = u & 7; }
                else if (u < 1024) { const int v2 = u - 512; mla = false; ctxq = false; b = v2 >> 5; h = (v2 >> 3) & 3; qb = v2 & 7; }
                else { const int v2 = u - 1024; mla = (v2 < 64); ctxq = true; b = (v2 & 63) >> 2; h = v2 & 3; qb = 0; }
                row0 = b * TPB + (ctxq ? 0 : CTXL + qb * 256);
                const int q0 = qb * 256;
                if (mla) {
                    const bf16_t* kvb = KVM + (size_t)b * TPB * 1024;
                    U.Q = QM + (size_t)row0 * 768 + h * 192; U.ldq = 768; U.K = kvb + h * 256; U.ldk = 1024; U.KR = PROJ + (size_t)b * TPB * 1792 + 512; U.ldkr = 1792; U.V = kvb + h * 256 + 128; U.ldv = 1024;
                    U.O = OL8 + (size_t)row0 * 1024 + h * 128; U.ldo = 1024; U.NT = ctxq ? 4 : 36; U.kofs = 0; U.q0 = q0; U.sink = 0.f; U.has_sink = 0; U.rope = ctxq ? nullptr : T16; U.rope_row = 0; U.rope_col_base = 0;
                    att::attn_unit<192, false, 1, true>(U, (LAS char*)(lds + LDS_STAGE), wave0);
                } else {
                    const bf16_t* kb = PROJ + (size_t)b * TPB * 1792;
                    const int kstart = (q0 - 128) < 0 ? 0 : (q0 - 128), kend = (q0 + 384) > SEQ ? SEQ : (q0 + 384);
                    U.Q = PROJ + (size_t)row0 * 1792 + 576 + h * 128; U.ldq = 1792; U.K = kb + 1088 + (h >> 1) * 128; U.ldk = 1792; U.KR = nullptr; U.ldkr = 0; U.V = kb + 1344 + (h >> 1) * 128; U.ldv = 1792;
                    U.O = OL8 + (size_t)row0 * 1024 + 512 + h * 128; U.ldo = 1024; U.NT = ctxq ? 4 : 4 + (kend - kstart) / 64; U.kofs = kstart; U.q0 = q0; U.sink = d_sink[li * 4 + h]; U.has_sink = 1; U.rope = nullptr; U.rope_row = 0; U.rope_col_base = 0;
                    att::attn_unit<128, true, 2, false>(U, (LAS char*)(lds + LDS_STAGE), wave0);
                }
              }
              if (it_ <= slot_ && slot_ != 99) EXPERT_CONV(); } }
            GRID_BARP(12);
#endif
        }
        const bool has_mix = even
#if !defined(NO_ODD)
            || true
#endif
            ;
        if (has_mix) {
            { PHASE_ARGS(); pg8::SchedDense S; S.nM = lastl ? 128 : NPANEL; S.latent_only = lastl ? 1 : 0; S.nN = 4; S.G = Gp; S.c = bxp; S.g = 0; S.A = (const char*)WSP(unsigned char, WS_OL); S.B = (const char*)(WSP(unsigned char, WS_WMIX) + (size_t)layer * 1024 * 1024); S.a_tstep = (size_t)256 * 1024; S.b_tstep = (size_t)256 * 1024;
              pg8::EpiFp8P16 E; E.O = WSP(unsigned char, WS_Y); E.ldc = 1024; E.oscale = 64.0f / (16.0f * 64.0f);
            for (int rep_ = 0; rep_ < DUPN(6); ++rep_)
              pg8::gemm_phase<pg8::EpiFp8P16, pg8::SchedDense, false, true, false, true>(wave0, lds + LDS_STAGE, 1024, 1024, nullptr, S, E); }
            GRID_BARP(13);
        }
#else
        const bool has_mix = false;
#endif
        {
            PHASE_IDS(); PHASE_ARGS();
            const float* ln_g = IN(6); const float* ln_b = IN(7); const float* b_router = IN(10);
            const float* MOD = WSP(float, WS_MOD); const unsigned short* X16 = WSP(unsigned short, WS_X); const float* in_x = IN(0); const float* in_ctx = IN(2); unsigned char* H8 = WSP(unsigned char, WS_H8); const unsigned char* Y = WSP(unsigned char, WS_Y);
            int* slot_tok = WSP(int, WS_SLOTTOK); float* slot_gate = WSP(float, WS_SLOTGATE); int* tok_pos = WSP(int, WS_TOKPOS); unsigned* ctl = WSP(unsigned, WS_CTL);
            const bf16_t* WRF = WSP(bf16_t, WS_WRF) + (size_t)layer * (2 * 2 * 32 * 512);
            LAS bf16_t* HT1 = (LAS bf16_t*)(lds + LDS_STAGE); LAS bf16_t* HT2 = HT1 + 16 * 1032;
            LAS float* PART = (LAS float*)(lds + LDS_STAGE + 2 * 16 * 1032 * 2);
            LAS int* hist = (LAS int*)(lds + LDS_MISC + 64);
            LAS int* basel = (LAS int*)(lds + LDS_MISC + 64 + 128);
            LAS int* ent = (LAS int*)(lds + LDS_MISC + 512);
            if (tid < 32) hist[tid] = 0;
            __syncthreads();
            const float* g1 = ln_g + (size_t)(layer * 2 + 0) * 1024; const float* b1 = ln_b + (size_t)(layer * 2 + 0) * 1024;
            const int rows_per_wg = M / G;
            const int rbase = vcu * rows_per_wg;
            for (int rep_ = 0; rep_ < DUPN(12); ++rep_) {
            if (rep_ > 0) { __syncthreads(); if (tid < 32) hist[tid] = 0; __syncthreads(); }
            const int NG = rows_per_wg / 16;
#define LN1_VALID(gq) (!(lastl && (((rbase + (gq) * 16) % TPB) < CTXL)))
#define LN1_LOAD(gq, vv, yy) do { _Pragma("unroll") for (int rr = 0; rr < 2; ++rr) { const size_t row_ = (size_t)(rbase + (gq) * 16 + 2 * wave + rr); \
                const int b_ = (int)(row_ / TPB), t_ = (int)(row_ % TPB); const float* src_ = ((t_ < CTXL) ? in_ctx + ((size_t)b_ * CTXL + t_) * DM : in_x + ((size_t)b_ * SEQ + (t_ - CTXL)) * DM); \
                if (layer != 0) { _Pragma("unroll") for (int j = 0; j < 4; ++j) { xh[rr][j] = *(const u32x2*)(X16 + row_ * DM + 4 * lane + 256 * j); } } \
                else { _Pragma("unroll") for (int j = 0; j < 4; ++j) vv[rr][j] = *(const f32x4*)(src_ + 4 * lane + 256 * j); } \
                _Pragma("unroll") for (int j = 0; j < 4; ++j) { const int col_ = 4 * lane + 256 * j; if (has_mix) yy[rr][j] = *(const unsigned*)(Y + row_ * DM + col_); } } } while (0)
            f32x4 g1v[4], b1v[4];
#pragma unroll
            for (int j = 0; j < 4; ++j) { g1v[j] = *(const f32x4*)(g1 + 4 * lane + 256 * j); b1v[j] = *(const f32x4*)(b1 + 4 * lane + 256 * j); }
            const float brv = b_router[layer * 32 + (lane & 31)];
            bf16x8 wrf[4][4];
#pragma unroll
            for (int s4 = 0; s4 < 4; ++s4) { const int s = 4 * wave + s4;
                wrf[s4][0] = *(const bf16x8*)(WRF + ((size_t)(0 * 2 + 0) * 32 + s) * 512 + lane * 8); wrf[s4][1] = *(const bf16x8*)(WRF + ((size_t)(0 * 2 + 1) * 32 + s) * 512 + lane * 8);
                wrf[s4][2] = *(const bf16x8*)(WRF + ((size_t)(1 * 2 + 0) * 32 + s) * 512 + lane * 8); wrf[s4][3] = *(const bf16x8*)(WRF + ((size_t)(1 * 2 + 1) * 32 + s) * 512 + lane * 8); }
            int grp = 0; while (grp < NG && !LN1_VALID(grp)) ++grp;
            f32x4 v[2][4]; unsigned yv[2][4]; u32x2 xh[2][4];
#pragma unroll
            for (int rr = 0; rr < 2; ++rr)
#pragma unroll
                for (int j = 0; j < 4; ++j) { v[rr][j] = (f32x4){0.f, 0.f, 0.f, 0.f}; yv[rr][j] = 0u; xh[rr][j] = (u32x2){0u, 0u}; }
            if (grp < NG) LN1_LOAD(grp, v, yv);
            while (grp < NG) {
                int gnx = grp + 1; while (gnx < NG && !LN1_VALID(gnx)) ++gnx;
                const int r0 = rbase + grp * 16; const int b = r0 / TPB; const bool isctx = (r0 % TPB) < CTXL;
                const float* mr = MOD + (size_t)(layer * 17 + (isctx ? 16 : b)) * 6144;
                f32x4 gtv[4], shv[4], scv[4];
#pragma unroll
                for (int j = 0; j < 4; ++j) { const int col = 4 * lane + 256 * j; gtv[j] = *(const f32x4*)(mr + 2048 + col); shv[j] = *(const f32x4*)(mr + 3072 + col); scv[j] = *(const f32x4*)(mr + 4096 + col); }
#pragma unroll
                for (int rr = 0; rr < 2; ++rr)
#pragma unroll
                    for (int j = 0; j < 4; ++j) { if (layer != 0) v[rr][j] = h4_to_f32(xh[rr][j].x, xh[rr][j].y);
                        v[rr][j] = v[rr][j] * ALPHA;
                        if (has_mix) { const int yw = (int)yv[rr][j]; const f32x4 gt = gtv[j] * (1.0f / 64.0f);
                            const f32x2 ylo = __builtin_amdgcn_cvt_pk_f32_fp8(yw, false), yhi = __builtin_amdgcn_cvt_pk_f32_fp8(yw, true);
                            v[rr][j][0] += gt[0] * ylo[0]; v[rr][j][1] += gt[1] * ylo[1]; v[rr][j][2] += gt[2] * yhi[0]; v[rr][j][3] += gt[3] * yhi[1]; } }
#pragma unroll
                for (int rr = 0; rr < 2; ++rr) { const size_t row = (size_t)(r0 + 2 * wave + rr); float s = 0.f;
#pragma unroll
                    for (int j = 0; j < 4; ++j) s += (v[rr][j][0] + v[rr][j][1]) + (v[rr][j][2] + v[rr][j][3]);
                    const float mean = wave_sum(s, lane) * (1.f / DM); float s2 = 0.f;
#pragma unroll
                    for (int j = 0; j < 4; ++j) { v[rr][j] = v[rr][j] - mean; s2 += (v[rr][j][0] * v[rr][j][0] + v[rr][j][1] * v[rr][j][1]) + (v[rr][j][2] * v[rr][j][2] + v[rr][j][3] * v[rr][j][3]); }
                    const float rstd = 1.f / sqrtf(wave_sum(s2, lane) * (1.f / DM) + LN_EPS);
#pragma unroll
                    for (int j = 0; j < 4; ++j) { const int col = 4 * lane + 256 * j; const f32x4 gg = g1v[j], bb = b1v[j];
                        const f32x4 xn = v[rr][j] * rstd * gg + bb;
                        const f32x4 sh = shv[j], sc = scv[j]; const f32x4 hv = xn * (sc + 1.0f) + sh;
                        *(unsigned*)(H8 + row * DM + col) = pg8::pk4_fp8(hv[0], hv[1], hv[2], hv[3]);
                        const unsigned h01 = pk2(hv[0], hv[1]), h23 = pk2(hv[2], hv[3]);
                        const unsigned l01 = pk2(hv[0] - bflo(h01), hv[1] - bfhi(h01)), l23 = pk2(hv[2] - bflo(h23), hv[3] - bfhi(h23));
                        *(LAS u32x2*)(HT1 + (2 * wave + rr) * 1032 + col) = (u32x2){h01, h23}; *(LAS u32x2*)(HT2 + (2 * wave + rr) * 1032 + col) = (u32x2){l01, l23}; } }
                if (gnx < NG) LN1_LOAD(gnx, v, yv);
                __syncthreads();
                { f32x4 a0 = (f32x4){0.f, 0.f, 0.f, 0.f}, a1 = a0;
#pragma unroll
                  for (int s4 = 0; s4 < 4; ++s4) { const int s = 4 * wave + s4;
                    const bf16x8 h1 = *(const LAS bf16x8*)(HT1 + (lane & 15) * 1032 + 32 * s + 8 * (lane >> 4)), h2 = *(const LAS bf16x8*)(HT2 + (lane & 15) * 1032 + 32 * s + 8 * (lane >> 4));
                    const bf16x8 w10 = wrf[s4][0], w11 = wrf[s4][1], w20 = wrf[s4][2], w21 = wrf[s4][3];
                    a0 = __builtin_amdgcn_mfma_f32_16x16x32_bf16(h1, w10, a0, 0, 0, 0); a0 = __builtin_amdgcn_mfma_f32_16x16x32_bf16(h1, w20, a0, 0, 0, 0); a0 = __builtin_amdgcn_mfma_f32_16x16x32_bf16(h2, w10, a0, 0, 0, 0);
                    a1 = __builtin_amdgcn_mfma_f32_16x16x32_bf16(h1, w11, a1, 0, 0, 0); a1 = __builtin_amdgcn_mfma_f32_16x16x32_bf16(h1, w21, a1, 0, 0, 0); a1 = __builtin_amdgcn_mfma_f32_16x16x32_bf16(h2, w11, a1, 0, 0, 0); }
#pragma unroll
                  for (int i = 0; i < 4; ++i) { PART[wave * 512 + (4 * (lane >> 4) + i) * 32 + (lane & 15)] = a0[i]; PART[wave * 512 + (4 * (lane >> 4) + i) * 32 + 16 + (lane & 15)] = a1[i]; } }
                __syncthreads();
                { const int half = lane >> 5, my_e = lane & 31, rloc = 2 * wave + half;
                  float lg = brv;
#pragma unroll
                  for (int w8 = 0; w8 < 8; ++w8) lg += PART[w8 * 512 + rloc * 32 + my_e];
                  float tv[4]; int te[4];
#pragma unroll
                  for (int k = 0; k < 4; ++k) { float mx = lg;
                    mx = row16_max(mx); mx = fmaxf(mx, shx(mx, 16, lane));
                    const unsigned long long bal = __ballot(lg == mx); const unsigned m32 = (unsigned)(bal >> (32 * half)); const int e = __ffs((int)m32) - 1;
                    tv[k] = mx; te[k] = e; if (my_e == e) lg = -3.0e38f; }
                  const float e1 = __expf(tv[1] - tv[0]), e2 = __expf(tv[2] - tv[0]), e3 = __expf(tv[3] - tv[0]); const float inv = 1.0f / (1.0f + e1 + e2 + e3);
                  if (my_e < 4) { const int e = my_e == 0 ? te[0] : my_e == 1 ? te[1] : my_e == 2 ? te[2] : te[3]; const float gt = (my_e == 0 ? 1.0f : my_e == 1 ? e1 : my_e == 2 ? e2 : e3) * inv;
                    const int lr = __hip_atomic_fetch_add(hist + e, 1, __ATOMIC_RELAXED, __HIP_MEMORY_SCOPE_WORKGROUP);
                    LAS int* en = ent + ((grp * 16 + rloc) * 4 + my_e) * 3; en[0] = e; en[1] = lr; en[2] = __builtin_bit_cast(int, gt); } }
                grp = gnx;
            } }
#undef LN1_VALID
#undef LN1_LOAD
            __syncthreads();
            if (tid < 32) { const int hc = hist[tid]; basel[tid] = hc ? (int)__hip_atomic_fetch_add(ctl + CW_CURSOR + layer * 32 + tid, (unsigned)hc, __ATOMIC_RELAXED, __HIP_MEMORY_SCOPE_AGENT) : 0; }
            __syncthreads();
            for (int i = tid; i < rows_per_wg * 4; i += NTHR) { const int rl = i >> 2; const int row = rbase + rl; const bool isctx = (row % TPB) < CTXL; if (lastl && isctx) continue;
                const LAS int* en = ent + i * 3; const int e = en[0]; const int pos = e * CAP + basel[e] + en[1];
                slot_tok[pos] = row; slot_gate[pos] = __builtin_bit_cast(float, en[2]); tok_pos[row * 4 + (i & 3)] = pos; }
        }
        GRID_BARP(14);
        LAS int* tb_bb = (LAS int*)(lds + LDS_MISC + 64);
        LAS int* tb_cnt = (LAS int*)(lds + LDS_MISC + 64 + 256);
        if (wave0 == 0) { PHASE_ARGS(); unsigned* ctl = WSP(unsigned, WS_CTL); const int ln = lane_now();
            const int c = (ln < 32) ? (int)__hip_atomic_load(ctl + CW_CURSOR + layer * 32 + ln, __ATOMIC_RELAXED, __HIP_MEMORY_SCOPE_AGENT) : 0;
            int incl = (c + 255) >> 8;
#pragma unroll
            for (int o = 1; o < 32; o <<= 1) { const int t = __builtin_amdgcn_ds_bpermute(((ln - o) & 63) << 2, incl); if ((ln & 31) >= o) incl += t; }
            if (ln < 32) { tb_cnt[ln] = c; tb_bb[ln] = incl - ((c + 255) >> 8); if (ln == 31) tb_bb[32] = incl; } }
        __syncthreads();
        LAS int* tb_be = (LAS int*)(lds + LDS_MISC + 512);
        { PHASE_IDS(); const int nblk = tb_bb[32];
#pragma clang loop vectorize(disable) unroll(disable)
          for (int i = tid; i < nblk; i += NTHR) { int e = 0;
#pragma unroll
            for (int j = 1; j < 32; ++j) e += (i >= tb_bb[j]) ? 1 : 0;
            tb_be[i] = e; } }
        __syncthreads();
        LAS unsigned char* side_buf = lds + LDS_MISC + 4096;
        {
            PHASE_ARGS(); pg8::SchedMoE S; S.bb = tb_bb; S.cnt = tb_cnt; S.be = tb_be; S.NT = 8; S.G = Gp; S.c = vcup; S.Acompact = nullptr; S.a_tstep = 0;
            S.bias = IN(12) + (size_t)layer * 32 * 2048; S.bias_estride = 2048; S.bias_pnstep = 128; S.bias_seg1 = 1024;
            const int* slot_tok = WSP(int, WS_SLOTTOK); const float* slot_gate = WSP(float, WS_SLOTGATE);
            S.W = (const char*)(WSP(unsigned char, WS_WEXPIN) + (size_t)layer * 32 * 2048 * 1024); S.w_estep = (size_t)2048 * 1024; S.w_tstep = (size_t)256 * 1024; S.slot_tok = slot_tok; S.slot_gate = slot_gate;
            pg8::EpiSwiglu E; E.Z = WSP(unsigned char, WS_Z); E.bias = IN(12) + (size_t)layer * 32 * 2048;
            for (int rep_ = 0; rep_ < DUPN(4); ++rep_)
            pg8::gemm_phase<pg8::EpiSwiglu, pg8::SchedMoE, true, true, true>(wave0, lds + LDS_STAGE, 1024, 1024, (const char*)WSP(unsigned char, WS_H8), S, E, side_buf);
        }
        GRID_BARP(15);
        {
            PHASE_ARGS(); pg8::SchedMoE S; S.bb = tb_bb; S.cnt = tb_cnt; S.be = tb_be; S.NT = 4; S.G = Gp; S.c = vcup;
            S.bias = IN(14) + (size_t)layer * 32 * 1024; S.bias_estride = 1024; S.bias_pnstep = 256; S.bias_seg1 = 128; S.Acompact = (const char*)WSP(unsigned char, WS_Z); S.a_tstep = (size_t)256 * 1024;
            const int* slot_tok = WSP(int, WS_SLOTTOK); const float* slot_gate = WSP(float, WS_SLOTGATE);
            S.W = (const char*)(WSP(unsigned char, WS_WEXPOUT) + (size_t)layer * 32 * 1024 * 1024); S.w_estep = (size_t)1024 * 1024; S.w_tstep = (size_t)256 * 1024; S.slot_tok = slot_tok; S.slot_gate = slot_gate;
            pg8::EpiMoeOut E; E.Y2 = WSP(unsigned char, WS_Y2); E.bias = IN(14) + (size_t)layer * 32 * 1024;
            for (int rep_ = 0; rep_ < DUPN(5); ++rep_)
            pg8::gemm_phase<pg8::EpiMoeOut, pg8::SchedMoE, false, true, true, true>(wave0, lds + LDS_STAGE, 1024, 1024, nullptr, S, E, side_buf);
        }
        GRID_BARP(16);
        {
            PHASE_IDS(); PHASE_ARGS();
            const float* ln_g = IN(6); const float* ln_b = IN(7); const float* MOD = WSP(float, WS_MOD); unsigned short* X16 = WSP(unsigned short, WS_X); const unsigned char* Y = WSP(unsigned char, WS_Y); const float* in_x = IN(0); const float* in_ctx = IN(2); unsigned char* H = WSP(unsigned char, WS_H8);
            const unsigned char* Y2 = WSP(unsigned char, WS_Y2); const int* tok_pos = WSP(int, WS_TOKPOS); float* outp = A_->out;
            const float* g2 = ln_g + (size_t)(layer * 2 + 1) * 1024; const float* b2 = ln_b + (size_t)(layer * 2 + 1) * 1024;
            const float* g1 = ln_g + (size_t)(layer * 2 + 0) * 1024; const float* b1 = ln_b + (size_t)(layer * 2 + 0) * 1024;
            f32x4 g2v[4], b2v[4], g1v[4], b1v[4];
#pragma unroll
            for (int j = 0; j < 4; ++j) { g2v[j] = *(const f32x4*)(g2 + 4 * lane + 256 * j); b2v[j] = *(const f32x4*)(b2 + 4 * lane + 256 * j); g1v[j] = *(const f32x4*)(g1 + 4 * lane + 256 * j); b1v[j] = *(const f32x4*)(b1 + 4 * lane + 256 * j); }
            for (int rep_ = 0; rep_ < DUPN(13); ++rep_) {
            u32x4 tpn[2];
#pragma unroll
            for (int rr = 0; rr < 2; ++rr) tpn[rr] = (gw < M / 2) ? *(const u32x4*)(tok_pos + (size_t)(2 * gw + rr) * 4) : (u32x4){0u, 0u, 0u, 0u};
            for (int rp = gw; rp < M / 2; rp += NGW) {
                const int row0 = 2 * rp; const int b = row0 / TPB, t = row0 % TPB; const bool isctx = t < CTXL;
                const u32x4 tpc[2] = {tpn[0], tpn[1]};
                if (rp + NGW < M / 2) {
#pragma unroll
                    for (int rr = 0; rr < 2; ++rr) tpn[rr] = *(const u32x4*)(tok_pos + (size_t)(2 * (rp + NGW) + rr) * 4); }
                if (lastl && isctx) continue;
                const float* mr = MOD + (size_t)(layer * 17 + (isctx ? 16 : b)) * 6144;
                int zr[2][4];
#pragma unroll
                for (int rr = 0; rr < 2; ++rr) { const u32x4 tp = tpc[rr];
#pragma unroll
                    for (int k = 0; k < 4; ++k) { const int pos = (int)tp[k]; const int e = pos / CAP, rk = pos % CAP; zr[rr][k] = tb_bb[e] * 256 + rk; } }
                const float* mn = MOD + (size_t)((layer + 1 < DEPTH ? layer + 1 : layer) * 17 + (isctx ? 16 : b)) * 6144;
                f32x4 gtv[4], shv[4], scv[4];
#pragma unroll
                for (int j = 0; j < 4; ++j) { const int col = 4 * lane + 256 * j; gtv[j] = *(const f32x4*)(mr + 5120 + col) * pg8::Y2SCALE_INV; shv[j] = *(const f32x4*)(mn + col); scv[j] = *(const f32x4*)(mn + 1024 + col); }
                f32x4 v[2][4], gt1v[4]; unsigned yw[2][4][4], y1w[2][4]; u32x2 xh[2][4];
#pragma unroll
                for (int j = 0; j < 4; ++j) gt1v[j] = *(const f32x4*)(mr + 2048 + 4 * lane + 256 * j) * (1.0f / 64.0f);
#pragma unroll
                for (int rr = 0; rr < 2; ++rr) { const size_t row_ = (size_t)(row0 + rr);
                    const float* src_ = (isctx ? in_ctx + ((size_t)b * CTXL + t + rr) * DM : in_x + ((size_t)b * SEQ + (t + rr - CTXL)) * DM);
                    if (layer != 0) {
#pragma unroll
                        for (int j = 0; j < 4; ++j) { xh[rr][j] = *(const u32x2*)(X16 + row_ * DM + 4 * lane + 256 * j); v[rr][j] = (f32x4){0.f, 0.f, 0.f, 0.f}; } }
                    else {
#pragma unroll
                        for (int j = 0; j < 4; ++j) { v[rr][j] = *(const f32x4*)(src_ + 4 * lane + 256 * j); xh[rr][j] = (u32x2){0u, 0u}; } }
#pragma unroll
                    for (int j = 0; j < 4; ++j) { const int col = 4 * lane + 256 * j; y1w[rr][j] = *(const unsigned*)(Y + row_ * DM + col);
#pragma unroll
                        for (int k = 0; k < 4; ++k) yw[rr][j][k] = *(const unsigned*)(Y2 + (size_t)zr[rr][k] * 1024 + col); } }
#pragma unroll
                for (int rr = 0; rr < 2; ++rr) { float s = 0.f;
#pragma unroll
                    for (int j = 0; j < 4; ++j) { const int yw1 = (int)y1w[rr][j]; const f32x2 ylo = __builtin_amdgcn_cvt_pk_f32_fp8(yw1, false), yhi = __builtin_amdgcn_cvt_pk_f32_fp8(yw1, true); const f32x4 gt = gt1v[j];
                        if (layer != 0) v[rr][j] = h4_to_f32(xh[rr][j].x, xh[rr][j].y);
                        v[rr][j] = v[rr][j] * ALPHA; v[rr][j][0] += gt[0] * ylo[0]; v[rr][j][1] += gt[1] * ylo[1]; v[rr][j][2] += gt[2] * yhi[0]; v[rr][j][3] += gt[3] * yhi[1];
                        s += (v[rr][j][0] + v[rr][j][1]) + (v[rr][j][2] + v[rr][j][3]); }
                    const float mean = wave_sum(s, lane) * (1.f / DM); float s2 = 0.f;
#pragma unroll
                    for (int j = 0; j < 4; ++j) { v[rr][j] = v[rr][j] - mean; s2 += (v[rr][j][0] * v[rr][j][0] + v[rr][j][1] * v[rr][j][1]) + (v[rr][j][2] * v[rr][j][2] + v[rr][j][3] * v[rr][j][3]); }
                    const float rstd = 1.f / sqrtf(wave_sum(s2, lane) * (1.f / DM) + LN_EPS);
#pragma unroll
                    for (int j = 0; j < 4; ++j) v[rr][j] = v[rr][j] * rstd * g1v[j] + b1v[j]; }
#pragma unroll
                for (int rr = 0; rr < 2; ++rr) { const int row = row0 + rr; float s = 0.f;
#pragma unroll
                    for (int j = 0; j < 4; ++j) { const int col = 4 * lane + 256 * j; f32x4 y = (f32x4){0.f, 0.f, 0.f, 0.f};
#pragma unroll
                        for (int k = 0; k < 4; ++k) { const int w = (int)yw[rr][j][k]; const f32x2 lo = __builtin_amdgcn_cvt_pk_f32_fp8(w, false), hi = __builtin_amdgcn_cvt_pk_f32_fp8(w, true); y[0] += lo[0]; y[1] += lo[1]; y[2] += hi[0]; y[3] += hi[1]; }
                        const f32x4 gt = gtv[j];
                        v[rr][j] = v[rr][j] * ALPHA + gt * y; s += (v[rr][j][0] + v[rr][j][1]) + (v[rr][j][2] + v[rr][j][3]); }
                    const float mean = wave_sum(s, lane) * (1.f / DM); float s2 = 0.f;
#pragma unroll
                    for (int j = 0; j < 4; ++j) { v[rr][j] = v[rr][j] - mean; s2 += (v[rr][j][0] * v[rr][j][0] + v[rr][j][1] * v[rr][j][1]) + (v[rr][j][2] * v[rr][j][2] + v[rr][j][3] * v[rr][j][3]); }
                    const float rstd = 1.f / sqrtf(wave_sum(s2, lane) * (1.f / DM) + LN_EPS);
#pragma unroll
                    for (int j = 0; j < 4; ++j) { const int col = 4 * lane + 256 * j; const f32x4 gg = g2v[j], bb = b2v[j];
                        const f32x4 xn = v[rr][j] * rstd * gg + bb;
                        if (lastl) { *(f32x4*)(outp + ((size_t)b * SEQ + (t + rr - CTXL)) * DM + col) = xn; }
                        else { *(u32x2*)(X16 + (size_t)row * DM + col) = f32_to_h4(xn);
                            const f32x4 sh = shv[j], sc = scv[j]; const f32x4 h = xn * (sc + 1.0f) + sh;
                            *(unsigned*)(H + (size_t)row * DM + col) = pg8::pk4_fp8(h[0], h[1], h[2], h[3]); } } }
            } }
        }
        if (!lastl) GRID_BARP(17);
    }
    if (PROBE_MASK != 0ull) {
        PT_SAMPLE(17);
        __syncthreads();
        const unsigned pt_target_ = MISC[3401] * PROBE_MULT; const unsigned pt_t0_ = (unsigned)__builtin_amdgcn_s_memrealtime();
        while ((unsigned)__builtin_amdgcn_s_memrealtime() - pt_t0_ < pt_target_) __builtin_amdgcn_s_sleep(32);
    }
}

extern "C" void kernel_launch(void* const* d_in, const int* in_sizes, int n_in, void* d_out, int out_size, void* d_ws, size_t ws_size, hipStream_t stream) {
    static int grid = 0;
    if (grid == 0) {
        if (n_in != 34 || ws_size < WS_END) { fprintf(stderr, "kernel_launch: unexpected n_in %d / ws %zu (need %zu)\n", n_in, ws_size, (size_t)WS_END); grid = -1; return; }
        int dev = 0, cus = 0, per_cu = 0;
        if (hipGetDevice(&dev) != hipSuccess || hipDeviceGetAttribute(&cus, hipDeviceAttributeMultiprocessorCount, dev) != hipSuccess) { grid = -1; return; }
        if (hipFuncSetAttribute((const void*)fwd_kernel, hipFuncAttributeMaxDynamicSharedMemorySize, LDS_BYTES) != hipSuccess) { fprintf(stderr, "kernel_launch: hipFuncSetAttribute failed\n"); grid = -1; return; }
        if (hipOccupancyMaxActiveBlocksPerMultiprocessor(&per_cu, (const void*)fwd_kernel, NTHR, LDS_BYTES) != hipSuccess || per_cu < 1) { fprintf(stderr, "kernel_launch: occupancy query says %d\n", per_cu); }
        (void)hipGetLastError();
        if (cus < 256) { fprintf(stderr, "kernel_launch: built for a 256-CU device (one resident workgroup per CU), found %d CUs\n", cus); grid = -1; return; }
        grid = 256;
    }
    if (grid < 0) return;
    (void)hipMemsetAsync((char*)d_ws + WS_CTL, 0, CTL_BYTES, stream);
    Args a{};
    for (int i = 0; i < 34; ++i) a.in[i] = (const float*)d_in[i];
    a.out = (float*)d_out; a.ws = (unsigned char*)d_ws;
    hipLaunchKernelGGL(fwd_kernel, dim3(grid), dim3(NTHR), LDS_BYTES, stream, a);
    const hipError_t le = hipPeekAtLastError();
    if (le != hipSuccess) fprintf(stderr, "kernel_launch: launch failed: %s\n", hipGetErrorName(le));
}
```

```cpp
#include <hip/hip_runtime.h>
#include <stdint.h>
#include <stdio.h>
#ifndef DUPSEL
#define DUPSEL 0
#endif
#define DUPN(k) ((DUPSEL == (k)) ? 2 : 1)
#define PROBE_MASK 0ull

#define LAS __attribute__((address_space(3)))
#define GAS __attribute__((address_space(1)))
typedef unsigned short bf16_t;
typedef short bf16x8 __attribute__((ext_vector_type(8)));
typedef float f32x4 __attribute__((ext_vector_type(4)));
typedef float f32x2 __attribute__((ext_vector_type(2)));
typedef unsigned u32x4 __attribute__((ext_vector_type(4)));
typedef unsigned u32x2 __attribute__((ext_vector_type(2)));

constexpr int DM = 1024, NB = 16, SEQ = 2048, CTXL = 256, TPB = SEQ + CTXL  ;
constexpr int M = NB * TPB;
constexpr int NPANEL = M / 256;
constexpr int DEPTH = 4, NEXP = 32, TOPK = 4, DFF = 1024;
constexpr int CAP = M;
constexpr int NPAD = M * TOPK + NEXP * 256;
constexpr float ALPHA = 1.681792830507429f;
constexpr float LN_EPS = 1e-5f;
constexpr int NWAVES = 8, NTHR = 512;

constexpr size_t MiB = 1ull << 20;
constexpr size_t WS_CTL = 0, CTL_BYTES = 1 * MiB;
constexpr size_t WS_MOD = 1 * MiB;
constexpr size_t WS_X = 4 * MiB;
constexpr size_t WS_H = WS_X + 144 * MiB;
constexpr size_t WS_Y = WS_H + 72 * MiB;
constexpr size_t WS_OL = WS_Y + 72 * MiB;
constexpr size_t WS_PROJ = WS_OL + 72 * MiB;
constexpr size_t WS_Z = WS_PROJ + 126 * MiB;
constexpr size_t WS_Y2 = WS_Z + 304 * MiB;
constexpr size_t WS_SLOTTOK = WS_Y2 + 304 * MiB;
constexpr size_t WS_SLOTGATE = WS_SLOTTOK + 5 * MiB;
constexpr size_t WS_TOKPOS = WS_SLOTGATE + 5 * MiB;
constexpr size_t WS_WEXPIN = WS_TOKPOS + 1 * MiB;
constexpr size_t WS_WEXPOUT = WS_WEXPIN + 512 * MiB;
constexpr size_t WS_WMIX = WS_WEXPOUT + 256 * MiB;
constexpr size_t WS_WINAB = WS_WMIX + 8 * MiB;
constexpr size_t WS_WINCD = WS_WINAB + 6 * MiB;
constexpr size_t WS_WGLU = WS_WINCD + 7 * MiB;
constexpr size_t WS_WUQ = WS_WGLU + 1 * MiB;
constexpr size_t WS_WUKV = WS_WUQ + 1 * MiB;
constexpr size_t WS_ROPE = WS_WUKV + 1 * MiB;
constexpr size_t WS_QM = WS_ROPE + 1 * MiB;
constexpr size_t WS_KVM = WS_QM + 54 * MiB;
constexpr size_t WS_UT = WS_KVM + 72 * MiB;
constexpr size_t WS_XS = WS_UT + 36 * MiB;
constexpr size_t WS_HIN = WS_XS + 72 * MiB;
constexpr size_t WS_ZG = WS_HIN + 36 * MiB;
constexpr size_t WS_TF = WS_ZG + 36 * MiB;
constexpr size_t WS_SF = WS_TF + 2 * MiB;
constexpr size_t WS_WF = WS_SF + 8 * MiB;
constexpr size_t WS_LAM16 = WS_WF + 8 * MiB;
constexpr size_t WS_X1 = WS_LAM16 + 1 * MiB;
constexpr size_t WS_H8 = WS_X1 + 144 * MiB;
constexpr size_t WS_WRF = WS_H8 + 36 * MiB;
constexpr size_t WS_END = WS_WRF + 1 * MiB;

constexpr int CW_BAR = 4096;
constexpr int CW_CURSOR = 8192;

constexpr int LDS_STAGE = 0, LDS_MISC = 133120, LDS_BYTES = 147456;

__device__ __forceinline__ int lane_now() { int l; asm volatile("v_mbcnt_lo_u32_b32 %0, -1, 0\n\tv_mbcnt_hi_u32_b32 %0, -1, %0" : "=v"(l)); return l; }
__device__ __forceinline__ unsigned f2bf(float f) { unsigned u = __builtin_bit_cast(unsigned, f); return (u + 0x7fffu + ((u >> 16) & 1u)) >> 16; }
__device__ __forceinline__ unsigned pk2(float lo, float hi) { unsigned r; asm("v_cvt_pk_bf16_f32 %0, %1, %2" : "=v"(r) : "v"(lo), "v"(hi)); return r; }
__device__ __forceinline__ float bf2f(unsigned short b) { return __builtin_bit_cast(float, ((unsigned)b) << 16); }
__device__ __forceinline__ float bflo(unsigned w) { return __builtin_bit_cast(float, w << 16); }
__device__ __forceinline__ float bfhi(unsigned w) { return __builtin_bit_cast(float, w & 0xffff0000u); }
__device__ __forceinline__ float shx(float v, int o, int lane) { return __builtin_bit_cast(float, __builtin_amdgcn_ds_bpermute((lane ^ o) << 2, __builtin_bit_cast(int, v))); }
__device__ __forceinline__ float row16_sum(float v) {
    v += __builtin_bit_cast(float, __builtin_amdgcn_update_dpp(0, __builtin_bit_cast(int, v), 0xB1, 0xF, 0xF, true));
    v += __builtin_bit_cast(float, __builtin_amdgcn_update_dpp(0, __builtin_bit_cast(int, v), 0x4E, 0xF, 0xF, true));
    v += __builtin_bit_cast(float, __builtin_amdgcn_update_dpp(0, __builtin_bit_cast(int, v), 0x141, 0xF, 0xF, true));
    v += __builtin_bit_cast(float, __builtin_amdgcn_update_dpp(0, __builtin_bit_cast(int, v), 0x140, 0xF, 0xF, true));
    return v;
}
__device__ __forceinline__ float row16_max(float v) {
    v = fmaxf(v, __builtin_bit_cast(float, __builtin_amdgcn_update_dpp(__builtin_bit_cast(int, v), __builtin_bit_cast(int, v), 0xB1, 0xF, 0xF, false)));
    v = fmaxf(v, __builtin_bit_cast(float, __builtin_amdgcn_update_dpp(__builtin_bit_cast(int, v), __builtin_bit_cast(int, v), 0x4E, 0xF, 0xF, false)));
    v = fmaxf(v, __builtin_bit_cast(float, __builtin_amdgcn_update_dpp(__builtin_bit_cast(int, v), __builtin_bit_cast(int, v), 0x141, 0xF, 0xF, false)));
    v = fmaxf(v, __builtin_bit_cast(float, __builtin_amdgcn_update_dpp(__builtin_bit_cast(int, v), __builtin_bit_cast(int, v), 0x140, 0xF, 0xF, false)));
    return v;
}
__device__ __forceinline__ float wave_sum(float v, int lane) {
    (void)lane;
    v += __builtin_bit_cast(float, __builtin_amdgcn_update_dpp(0, __builtin_bit_cast(int, v), 0xB1, 0xF, 0xF, true));
    v += __builtin_bit_cast(float, __builtin_amdgcn_update_dpp(0, __builtin_bit_cast(int, v), 0x4E, 0xF, 0xF, true));
    v += __builtin_bit_cast(float, __builtin_amdgcn_update_dpp(0, __builtin_bit_cast(int, v), 0x141, 0xF, 0xF, true));
    v += __builtin_bit_cast(float, __builtin_amdgcn_update_dpp(0, __builtin_bit_cast(int, v), 0x140, 0xF, 0xF, true));
    const int vi = __builtin_bit_cast(int, v);
    return (__builtin_bit_cast(float, __builtin_amdgcn_readlane(vi, 0)) + __builtin_bit_cast(float, __builtin_amdgcn_readlane(vi, 16))) +
           (__builtin_bit_cast(float, __builtin_amdgcn_readlane(vi, 32)) + __builtin_bit_cast(float, __builtin_amdgcn_readlane(vi, 48)));
}
__device__ __forceinline__ int uni(int v) { return __builtin_amdgcn_readfirstlane(v); }
typedef _Float16 h16x4 __attribute__((ext_vector_type(4)));
__device__ __forceinline__ float h2f(unsigned short b) { return (float)__builtin_bit_cast(_Float16, b); }
__device__ __forceinline__ f32x4 h4_to_f32(unsigned lo, unsigned hi) { return (f32x4){h2f((unsigned short)(lo & 0xffffu)), h2f((unsigned short)(lo >> 16)), h2f((unsigned short)(hi & 0xffffu)), h2f((unsigned short)(hi >> 16))}; }
__device__ __forceinline__ u32x2 f32_to_h4(f32x4 v) { const h16x4 h = {(_Float16)v[0], (_Float16)v[1], (_Float16)v[2], (_Float16)v[3]}; return __builtin_bit_cast(u32x2, h); }
__device__ __forceinline__ const char* unip(const char* p) { const unsigned long long v = (unsigned long long)p; const unsigned lo = (unsigned)__builtin_amdgcn_readfirstlane((int)(unsigned)v), hi = (unsigned)__builtin_amdgcn_readfirstlane((int)(unsigned)(v >> 32)); return (const char*)(((unsigned long long)hi << 32) | lo); }
#define PHASE_IDS() const int lane = lane_now(); const int wave = wave0; const int tid = wave0 * 64 + lane; const int gw = vcu * NWAVES + wave; (void)lane; (void)gw
#define LDS_WAIT() asm volatile("s_waitcnt lgkmcnt(0)" ::: "memory")
#define VM_WAIT() asm volatile("s_waitcnt vmcnt(0)" ::: "memory")

#define XB_TMO      128
#define XB_XCNT(j)  (256  + 64 * (j))
#define XB_XSUB(j)  (1280 + 64 * (j))
#define XB_XGEN(j)  (2304 + 64 * (j))
#define XB_TOP      3328
#define XB_TOPGEN   3392
#define XCD_BAR_WORDS 3456
#define XB_SPIN_CAP (1u << 22)

__device__ __forceinline__ unsigned xb_ld(unsigned* p)              { return __hip_atomic_load(p, __ATOMIC_RELAXED, __HIP_MEMORY_SCOPE_AGENT); }
__device__ __forceinline__ unsigned xb_add(unsigned* p, unsigned v) { return __hip_atomic_fetch_add(p, v, __ATOMIC_RELAXED, __HIP_MEMORY_SCOPE_AGENT); }
__device__ __forceinline__ unsigned xb_xcc_id() { return (unsigned)__builtin_amdgcn_s_getreg((3 << 11) | 20) & 0xFu; }
#define XB_SPIN(cond, bar) do { unsigned _sp = 0; while (cond) { __builtin_amdgcn_s_sleep(1); \
    if ((++_sp & 255u) == 0u) { if (xb_ld(&(bar)[XB_TMO])) break; if (_sp > XB_SPIN_CAP) { atomicAdd(&(bar)[XB_TMO], 1u); break; } } } } while (0)

struct XcdBarrier { unsigned* bar; unsigned x; volatile LAS unsigned* st; };

__device__ __forceinline__ XcdBarrier xcd_barrier_post(unsigned* bar, volatile LAS unsigned* st) {
    XcdBarrier b; b.bar = bar; b.x = 0; b.st = st;
    if (threadIdx.x == 0) (void)xb_add(&bar[XB_XCNT(xb_xcc_id())], 1u);
    return b;
}
__device__ __forceinline__ void xcd_barrier_complete(unsigned* bar, unsigned x, unsigned& nloc, unsigned& nx) {
    const unsigned G = gridDim.x * gridDim.y * gridDim.z;
    unsigned sum, cnt, mine, sp = 0u;
    for (;;) {
        sum = 0u; cnt = 0u; mine = 0u;
#pragma unroll
        for (unsigned j = 0; j < 16; ++j) { const unsigned c = xb_ld(&bar[XB_XCNT(j)]); sum += c; cnt += (c > 0u) ? 1u : 0u; mine = (j == x) ? c : mine; }
        if (sum == G) break;
        __builtin_amdgcn_s_sleep(1);
        if ((++sp & 255u) == 0u) { if (xb_ld(&bar[XB_TMO])) break; if (sp > XB_SPIN_CAP) { atomicAdd(&bar[XB_TMO], 1u); break; } }
    }
    nloc = mine > 0u ? mine : 1u; nx = cnt > 0u ? cnt : 1u;
}
__device__ __forceinline__ void xcd_barrier(const XcdBarrier& b) {
    asm volatile("s_waitcnt vmcnt(0)" ::: "memory");
    __syncthreads();
    if (b.x == 0u && lane_now() == 0) {
        unsigned* bar = b.bar;
        __builtin_amdgcn_s_waitcnt(0);
        unsigned bx_; asm volatile("s_getreg_b32 %0, hwreg(HW_REG_XCC_ID, 0, 4)" : "=s"(bx_));
        unsigned nloc = b.st[0], nx = b.st[1];
        if (nloc == 0u) { xcd_barrier_complete(bar, bx_, nloc, nx); b.st[0] = nloc; b.st[1] = nx; }
        const unsigned old = xb_add(&bar[XB_XSUB(bx_)], 1u);
        const unsigned gen = old / nloc;
        if (old + 1u == (gen + 1u) * nloc) {
            __builtin_amdgcn_fence(__ATOMIC_RELEASE, "agent");
            asm volatile("s_waitcnt vmcnt(0)" ::: "memory");
            const unsigned og = xb_add(&bar[XB_TOP], 1u);
            const unsigned tg = og / nx;
            if (og + 1u == (tg + 1u) * nx) xb_add(&bar[XB_TOPGEN], 1u);
            else XB_SPIN(xb_ld(&bar[XB_TOPGEN]) == tg, bar);
            __builtin_amdgcn_fence(__ATOMIC_ACQUIRE, "agent");
            xb_add(&bar[XB_XGEN(bx_)], 1u);
            asm volatile("s_waitcnt vmcnt(0)" ::: "memory");
        } else {
            XB_SPIN(xb_ld(&bar[XB_XGEN(bx_)]) == gen, bar);
            __builtin_amdgcn_fence(__ATOMIC_ACQUIRE, "agent");
            asm volatile("s_waitcnt vmcnt(0)" ::: "memory");
        }
    }
    __syncthreads();
}

namespace pg8 {
constexpr int BM = 256, BK = 64, HALF = 128, HTB = HALF * BK * 2, STAGE_BYTES = 8 * HTB;
__device__ __forceinline__ int lds_byte(int r, int c) { const int st = (r >> 4) * 2 + (c >> 5), rr = r & 15, cc = c & 31, ob = rr * 64 + cc * 2; return st * 1024 + (ob ^ (((ob >> 9) & 1) << 5)); }
__device__ __forceinline__ void stage_rc(int b, int& R, int& C) { const int st = b / 1024, sb = b % 1024, swz = sb ^ (((sb >> 9) & 1) << 5); R = (st >> 1) * 16 + swz / 64; C = (st & 1) * 32 + (swz % 64) / 2; }
__device__ __forceinline__ int perm32(int rho) { const int n = rho >> 4, i = rho & 15; return 8 * (i >> 2) + 4 * n + (i & 3); }

struct Unit { int pm, pn, g, e, nvalid, pad; const char* A; const char* B; const int* rows; const float* gates; const float* bias0; const float* bias1; };
constexpr int SIDE_BYTES = 3072;

__device__ __forceinline__ unsigned cvt_pk_bf16(float lo, float hi) { unsigned r; asm volatile("v_cvt_pk_bf16_f32 %0, %1, %2" : "=v"(r) : "v"(lo), "v"(hi)); return r; }

typedef int i32x8 __attribute__((ext_vector_type(8)));
typedef int i32x4 __attribute__((ext_vector_type(4)));
__device__ __forceinline__ i32x8 cat8(bf16x8 lo, bf16x8 hi) { const i32x4 a = __builtin_bit_cast(i32x4, lo), b = __builtin_bit_cast(i32x4, hi); return (i32x8){a[0], a[1], a[2], a[3], b[0], b[1], b[2], b[3]}; }
template <class Epi, class Sched, bool GATHER, bool FP8, bool SIDE = false, bool P16 = false>
__device__ __forceinline__ void gemm_phase(const int wid0, LAS unsigned char* lds, const int Kb, const int ldab, const char* Agather, const Sched& S, const Epi& E, LAS unsigned char* side = nullptr) {
    const int lane = lane_now(); const int wid = wid0; const int tid = wid0 * 64 + lane;
    const int wr = wid >> 2, wc = wid & 3, fr = lane & 15, fq = lane >> 4;
    const int nt = Kb / 128;
    constexpr bool PG_PROBE = FP8 && SIDE && ((GATHER && ((PROBE_MASK >> 31) & 1ull)) || (!GATHER && ((PROBE_MASK >> 30) & 1ull)));
    unsigned voffA[2], voffB[2]; int rowA[2]; unsigned colA2[2];
#pragma unroll
    for (int i = 0; i < 2; ++i) { int R, C; stage_rc(tid * 16 + i * 8192, R, C); const int Rb = P16 ? (64 * (R >> 5) + 16 * ((R & 15) >> 2) + 4 * ((R >> 4) & 1) + (R & 3)) : ((R & ~31) + perm32(R & 31));
        voffA[i] = (unsigned)(R * ldab + C * 2); voffB[i] = (unsigned)(Rb * Kb + C * 2); rowA[i] = R; colA2[i] = (unsigned)C * 2u; }
    const size_t kstep = (size_t)(BK * 2);
    const size_t hstepA = (size_t)HALF * ldab, hstepB = P16 ? (size_t)8 * Kb : (size_t)HALF * Kb;
    const unsigned ldsw = (unsigned)wid * 1024u;
    const int aoff = lds_byte(wr * 64 + fr, fq * 8), boff = lds_byte(wc * 32 + fr, fq * 8);
#define PG8_SA(b, h) (((b) * 2 + (h)) * HTB)
#define PG8_SB(b, h) ((4 + (b) * 2 + (h)) * HTB)
#define PG8_GLDS(gp, lp) __builtin_amdgcn_global_load_lds((const unsigned*)(gp), (LAS unsigned*)(lp), 16, 0, 0)
#define PG8_GLDS4(gp, lp) __builtin_amdgcn_global_load_lds((const unsigned*)(gp), (LAS unsigned*)(lp), 4, 0, 0)
#define PG8_STAGE_B(bufoff, gbase) do { const char* _q = (const char*)(gbase); asm volatile("" : "+s"(_q)); _Pragma("unroll") for (int _i = 0; _i < 2; ++_i) PG8_GLDS(_q + voffB[_i], lds + (bufoff) + ldsw + _i * 8192); } while (0)
#define PG8_STAGE_A(bufoff, h, nx, kb) do { if constexpr (GATHER) { const char* _p = Agather + (kb); asm volatile("" : "+s"(_p)); _Pragma("unroll") for (int _i = 0; _i < 2; ++_i) PG8_GLDS(_p + ((nx) ? nvo[h][_i] : cvo[h][_i]), lds + (bufoff) + ldsw + _i * 8192); } \
        else { const char* _p = ((nx) ? nA : cA) + (size_t)(h) * hstepA + (kb); asm volatile("" : "+s"(_p)); _Pragma("unroll") for (int _i = 0; _i < 2; ++_i) PG8_GLDS(_p + voffA[_i], lds + (bufoff) + ldsw + _i * 8192); } } while (0)
#define PG8_LDA(dst, b, h) do { _Pragma("unroll") for (int m = 0; m < 4; ++m) _Pragma("unroll") for (int k = 0; k < 2; ++k) dst[m][k] = *(const LAS bf16x8*)(lds + PG8_SA(b, h) + aoff + m * 2048 + k * 1024); } while (0)
#define PG8_LDB(dst, b, h) do { _Pragma("unroll") for (int n = 0; n < 2; ++n) _Pragma("unroll") for (int k = 0; k < 2; ++k) dst[n][k] = *(const LAS bf16x8*)(lds + PG8_SB(b, h) + boff + n * 2048 + k * 1024); } while (0)
#define PG8_MMA(ai, bj, At, Bt) do { __builtin_amdgcn_s_setprio(1); if constexpr (FP8) { _Pragma("unroll") for (int m = 0; m < 4; ++m) _Pragma("unroll") for (int n = 0; n < 2; ++n) \
        asm volatile("v_mfma_f32_16x16x128_f8f6f4 %0, %1, %2, %0" : "+v"(acc[ai][bj][m][n]) : "v"(cat8(Bt[n][0], Bt[n][1])), "v"(cat8(At[m][0], At[m][1]))); } \
      else { _Pragma("unroll") for (int m = 0; m < 4; ++m) _Pragma("unroll") for (int n = 0; n < 2; ++n) _Pragma("unroll") for (int k = 0; k < 2; ++k) \
        acc[ai][bj][m][n] = __builtin_amdgcn_mfma_f32_16x16x32_bf16(Bt[n][k], At[m][k], acc[ai][bj][m][n], 0, 0, 0); } __builtin_amdgcn_s_setprio(0); } while (0)
#define PG8_WAIT_V(n) asm volatile("s_waitcnt vmcnt(" #n ")" ::: "memory")
#define PG8_WAIT_L(n) asm volatile("s_waitcnt lgkmcnt(" #n ")" ::: "memory")
#define PG8_BAR __builtin_amdgcn_s_barrier()
#define PG8_SCHED __builtin_amdgcn_sched_barrier(0)
#define PG8_LOADVO(dst, par) do { if constexpr (GATHER) { const LAS int* _rw = (const LAS int*)(side + (par) * SIDE_BYTES); _Pragma("unroll") for (int _h = 0; _h < 2; ++_h) _Pragma("unroll") for (int _i = 0; _i < 2; ++_i) { \
        const int _t = _rw[_h * 128 + rowA[_i]]; dst[_h][_i] = (unsigned)_t * (unsigned)ldab + colA2[_i]; } } } while (0)
#define PG8_SIDE_DMA(u, par) do { if constexpr (SIDE) { LAS unsigned char* _sb = side + (par) * SIDE_BYTES; const int _e = (wid & 3) * 64 + lane; \
        if (wid < 4) { const int _ec = (_e < (u).nvalid) ? _e : 0; if constexpr (GATHER) PG8_GLDS4((const char*)((u).rows + _ec), _sb + (wid & 3) * 256); else PG8_GLDS4((const char*)((u).gates + _ec), _sb + 2048 + (wid & 3) * 256); } \
        else { const float* _bp = (_e < 128) ? (u).bias0 + _e : (u).bias1 + (_e - 128); PG8_GLDS4((const char*)_bp, _sb + 1024 + (wid & 3) * 256); } } } while (0)
    Unit cur, nxt; int ui = 0;
    if (!S.next(0, cur)) return;
    f32x4 acc[2][2][4][2];
#pragma unroll
    for (int a = 0; a < 2; ++a)
#pragma unroll
        for (int b = 0; b < 2; ++b)
#pragma unroll
            for (int m = 0; m < 4; ++m)
#pragma unroll
                for (int n = 0; n < 2; ++n) acc[a][b][m][n] = (f32x4){0.f, 0.f, 0.f, 0.f};
    bf16x8 At[4][2], B0[2][2], B1[2][2];
    unsigned cvo[2][2] = {{0u, 0u}, {0u, 0u}}, nvo[2][2] = {{0u, 0u}, {0u, 0u}};
    const char* cA = cur.A; const char* cB = cur.B; const char* nA = cA; const char* nB = cB;
    if constexpr (SIDE) { PG8_SIDE_DMA(cur, 0); PG8_WAIT_V(0); PG8_BAR; }
    PG8_LOADVO(cvo, 0);
    PG8_STAGE_B(PG8_SB(0, 0), cB); PG8_STAGE_A(PG8_SA(0, 0), 0, false, 0); PG8_STAGE_B(PG8_SB(0, 1), cB + hstepB); PG8_STAGE_A(PG8_SA(0, 1), 1, false, 0);
    if (wr == 1) PG8_BAR;
    PG8_WAIT_V(4); PG8_BAR;
    PG8_STAGE_B(PG8_SB(1, 0), cB + kstep); PG8_STAGE_A(PG8_SA(1, 0), 0, false, kstep); PG8_STAGE_B(PG8_SB(1, 1), cB + hstepB + kstep);
    PG8_WAIT_V(6); PG8_BAR;
    for (;;) {
        const bool has_next = S.next(ui + 1, nxt);
        const int npar = (ui + 1) % 3;
        if (has_next) { nA = nxt.A; nB = nxt.B; PG8_SIDE_DMA(nxt, npar); }
        else { nA = cA; nB = cB;
#pragma unroll
            for (int h = 0; h < 2; ++h)
#pragma unroll
                for (int i = 0; i < 2; ++i) nvo[h][i] = cvo[h][i]; }
        unsigned pg_t0_ = 0; if constexpr (PG_PROBE) pg_t0_ = (unsigned)__builtin_amdgcn_s_memrealtime();
#pragma clang loop unroll(disable)
        for (int t = 0; t < nt; t += 2) {
            const bool last = (t == nt - 2);
            if (last && has_next) PG8_LOADVO(nvo, npar);
            const size_t k1 = (size_t)(t + 1) * kstep;
            const size_t k2 = last ? 0 : (size_t)(t + 2) * kstep, k3 = k2 + kstep;
            const char* b2 = last ? nB : cB + (size_t)(t + 2) * kstep; const char* b3 = b2 + kstep;
            PG8_LDB(B0, 0, 0); PG8_SCHED; PG8_LDA(At, 0, 0); PG8_STAGE_A(PG8_SA(1, 1), 1, false, k1);
            PG8_WAIT_L(8); PG8_BAR; PG8_WAIT_L(0); PG8_MMA(0, 0, At, B0); PG8_BAR; PG8_SCHED;
            PG8_LDB(B1, 0, 1); PG8_STAGE_B(PG8_SB(0, 0), b2);
            PG8_BAR; PG8_WAIT_L(0); PG8_MMA(0, 1, At, B1); PG8_BAR;
            PG8_LDA(At, 0, 1); PG8_STAGE_A(PG8_SA(0, 0), 0, last, k2);
            PG8_BAR; PG8_WAIT_L(0); PG8_MMA(1, 0, At, B0); PG8_BAR; PG8_SCHED;
            PG8_STAGE_B(PG8_SB(0, 1), b2 + hstepB);
            PG8_WAIT_V(6); PG8_BAR; PG8_MMA(1, 1, At, B1); PG8_BAR;
            PG8_LDB(B0, 1, 0); PG8_SCHED; PG8_LDA(At, 1, 0); PG8_STAGE_A(PG8_SA(0, 1), 1, last, k2);
            PG8_WAIT_L(8); PG8_BAR; PG8_WAIT_L(0); PG8_MMA(0, 0, At, B0); PG8_BAR; PG8_SCHED;
            PG8_LDB(B1, 1, 1); PG8_STAGE_B(PG8_SB(1, 0), b3);
            PG8_BAR; PG8_WAIT_L(0); PG8_MMA(0, 1, At, B1); PG8_BAR;
            PG8_LDA(At, 1, 1); PG8_STAGE_A(PG8_SA(1, 0), 0, last, k3);
            PG8_BAR; PG8_WAIT_L(0); PG8_MMA(1, 0, At, B0); PG8_BAR; PG8_SCHED;
            PG8_STAGE_B(PG8_SB(1, 1), b3 + hstepB);
            PG8_WAIT_V(6); PG8_BAR; PG8_MMA(1, 1, At, B1); PG8_BAR;
        }
        if constexpr (PG_PROBE) { const unsigned pg_t1_ = (unsigned)__builtin_amdgcn_s_memrealtime(); if (wid == 0 && lane_now() == 0) { volatile LAS unsigned* pm_ = (volatile LAS unsigned*)(lds + LDS_MISC); pm_[3401] = pm_[3401] + (pg_t1_ - pg_t0_); } }
        if constexpr (FP8) asm volatile("s_nop 15\n\ts_nop 15" ::: "memory");
        { int fr2 = fr, fq2 = fq; asm volatile("" : "+v"(fr2), "+v"(fq2));
          E(acc, cur, wr, wc, fr2, fq2, side + (ui % 3) * SIDE_BYTES);
          if ((DUPSEL == 16 && FP8 && !GATHER) || (DUPSEL == 17 && FP8 && GATHER) || (DUPSEL == 18 && !FP8)) { asm volatile("" : "+v"(fr2), "+v"(fq2)); E(acc, cur, wr, wc, fr2, fq2, side + (ui % 3) * SIDE_BYTES); } }
        if (!has_next) break;
#pragma unroll
        for (int a = 0; a < 2; ++a)
#pragma unroll
            for (int b = 0; b < 2; ++b)
#pragma unroll
                for (int m = 0; m < 4; ++m)
#pragma unroll
                    for (int n = 0; n < 2; ++n) acc[a][b][m][n] = (f32x4){0.f, 0.f, 0.f, 0.f};
        cur = nxt; cA = nA; cB = nB; ++ui;
#pragma unroll
        for (int h = 0; h < 2; ++h)
#pragma unroll
            for (int i = 0; i < 2; ++i) cvo[h][i] = nvo[h][i];
    }
    PG8_WAIT_V(0);
    if (wr == 0) PG8_BAR;
    PG8_BAR;
#undef PG8_SA
#undef PG8_SB
#undef PG8_GLDS
#undef PG8_STAGE_A
#undef PG8_STAGE_B
#undef PG8_LDA
#undef PG8_LDB
#undef PG8_MMA
#undef PG8_WAIT_V
#undef PG8_WAIT_L
#undef PG8_BAR
#undef PG8_SCHED
#undef PG8_LOADVO
#undef PG8_SIDE_DMA
#undef PG8_GLDS4
}

struct SchedDense {
    int nM, nN, G, c, g; const char* A; const char* B; size_t a_tstep, b_tstep; int latent_only = 0;
    __device__ __forceinline__ bool next(int i, Unit& u) const {
        const int nwg = nM * nN; const long L = (long)i * G + c; if (L >= nwg) return false;
        int wgid = (int)L; { const int q = nwg / 8, r = nwg % 8, xcd = wgid % 8, off = wgid / 8; wgid = (xcd < r ? xcd * (q + 1) : r * (q + 1) + (xcd - r) * q) + off; }
        const int nig = 8 * nN, gid = wgid / nig, fm = gid * 8, gsz = (nM - fm) < 8 ? (nM - fm) : 8;
        u.pm = fm + ((wgid % nig) % gsz); u.pn = (wgid % nig) / gsz; u.g = g; u.e = 0; u.nvalid = 256; u.pad = 0;
        if (latent_only) u.pm = (u.pm >> 3) * 9 + 1 + (u.pm & 7);
        u.A = A + (size_t)u.pm * a_tstep; u.B = B + (size_t)u.pn * b_tstep; u.rows = nullptr; u.gates = nullptr; u.bias0 = nullptr; u.bias1 = nullptr; return true;
    }
};
struct SchedDual {
    int nM, nN0, nN1, G, c; const char* A0; const char* A1; const char* B0; const char* B1; size_t a_tstep, b_tstep;
    __device__ __forceinline__ bool next(int i, Unit& u) const {
        const int n0 = nM * nN0, n1 = nM * nN1; int L = i * G + c; if (L >= n0 + n1) return false;
        const int g = (L >= n0) ? 1 : 0; if (g) L -= n0; const int nN = g ? nN1 : nN0;
        u.pm = L / nN; u.pn = L % nN; u.g = g; u.e = 0; u.nvalid = 256; u.pad = 0;
        u.A = (g ? A1 : A0) + (size_t)u.pm * a_tstep; u.B = (g ? B1 : B0) + (size_t)u.pn * b_tstep; u.rows = nullptr; u.gates = nullptr; u.bias0 = nullptr; u.bias1 = nullptr; return true;
    }
};
struct SchedMoE {
    const LAS int* bb; const LAS int* cnt; const LAS int* be; int NT, G, c; const char* Acompact; size_t a_tstep; const char* W; size_t w_estep, w_tstep; const int* slot_tok; const float* slot_gate;
    const float* bias; int bias_estride, bias_seg1;
    int bias_pnstep;
    __device__ __forceinline__ bool next(int i, Unit& u) const {
        const int L = i * G + c; const int blk = L / NT, pn = L % NT;
        if (blk >= uni(bb[32])) return false;
        const int e = uni(be[blk]);
        const int rank0 = (blk - uni(bb[e])) * 256; int nv = uni(cnt[e]) - rank0; nv = nv > 256 ? 256 : nv;
        u.pm = blk; u.pn = pn; u.g = 0; u.e = e; u.nvalid = nv; u.pad = 0;
        u.A = unip(Acompact + (size_t)blk * a_tstep); u.B = unip(W + (size_t)e * w_estep + (size_t)pn * w_tstep);
        u.rows = (const int*)unip((const char*)(slot_tok + (size_t)e * CAP + rank0)); u.gates = (const float*)unip((const char*)(slot_gate + (size_t)e * CAP + rank0));
        u.bias0 = (const float*)unip((const char*)(bias + (size_t)e * bias_estride + pn * bias_pnstep)); u.bias1 = u.bias0 + bias_seg1; return true;
    }
};

__device__ __forceinline__ unsigned pk4_fp8(float a, float b, float c, float d) { int w = 0; w = __builtin_amdgcn_cvt_pk_fp8_f32(a, b, w, false); w = __builtin_amdgcn_cvt_pk_fp8_f32(c, d, w, true); return (unsigned)w; }
struct EpiBf16 {
    bf16_t* O; int ldc; float oscale = 1.0f;
    __device__ __forceinline__ void operator()(const f32x4 (&acc)[2][2][4][2], const Unit& u, int wr, int wc, int fr, int fq, LAS unsigned char* = nullptr) const {
        const int row0 = u.pm * BM + wr * 64 + fr, col0 = u.pn * BM + wc * 32 + 8 * fq;
#pragma unroll
        for (int ai = 0; ai < 2; ++ai)
#pragma unroll
            for (int m = 0; m < 4; ++m) { bf16_t* rowp = O + (size_t)(row0 + ai * HALF + m * 16) * ldc + col0;
#pragma unroll
                for (int bj = 0; bj < 2; ++bj) { const f32x4 v0 = acc[ai][bj][m][0] * oscale, v1 = acc[ai][bj][m][1] * oscale;
                    u32x4 w; w.x = cvt_pk_bf16(v0[0], v0[1]); w.y = cvt_pk_bf16(v0[2], v0[3]); w.z = cvt_pk_bf16(v1[0], v1[1]); w.w = cvt_pk_bf16(v1[2], v1[3]);
                    *(u32x4*)(rowp + bj * HALF) = w; } }
    }
};
struct EpiBf16U {
    bf16_t* O; int ldc; float oscale; bf16_t* UT;
    __device__ __forceinline__ void operator()(const f32x4 (&acc)[2][2][4][2], const Unit& u, int wr, int wc, int fr, int fq, LAS unsigned char* = nullptr) const {
        if (u.pn < 4) { EpiBf16 e; e.O = O; e.ldc = ldc; e.oscale = oscale; e(acc, u, wr, wc, fr, fq); return; }
        const int row0 = u.pm * BM + wr * 64 + fr, ch0 = (u.pn - 4) * BM + wc * 32 + 8 * fq;
        const int b = (u.pm * BM) / TPB, t0 = row0 - b * TPB;
#pragma unroll
        for (int ai = 0; ai < 2; ++ai)
#pragma unroll
            for (int m = 0; m < 4; ++m) { const int t = t0 + ai * HALF + m * 16;
#pragma unroll
                for (int bj = 0; bj < 2; ++bj) { const f32x4 v0 = acc[ai][bj][m][0] * oscale, v1 = acc[ai][bj][m][1] * oscale; const int ch = ch0 + bj * HALF;
                    u32x4 w; w.x = cvt_pk_bf16(v0[0], v0[1]); w.y = cvt_pk_bf16(v0[2], v0[3]); w.z = cvt_pk_bf16(v1[0], v1[1]); w.w = cvt_pk_bf16(v1[2], v1[3]);
                    *(u32x4*)(UT + ((((size_t)(ch >> 4) * TPB + t) * 16 + b) * 16 + (ch & 8))) = w; } }
    }
};
struct EpiFp8 {
    unsigned char* O; int ldc; float oscale;
    __device__ __forceinline__ void operator()(const f32x4 (&acc)[2][2][4][2], const Unit& u, int wr, int wc, int fr, int fq, LAS unsigned char* = nullptr) const {
        const int row0 = u.pm * BM + wr * 64 + fr, col0 = u.pn * BM + wc * 32 + 8 * fq;
#pragma unroll
        for (int ai = 0; ai < 2; ++ai)
#pragma unroll
            for (int m = 0; m < 4; ++m) { unsigned char* rowp = O + (size_t)(row0 + ai * HALF + m * 16) * ldc + col0;
#pragma unroll
                for (int bj = 0; bj < 2; ++bj) { const f32x4 v0 = acc[ai][bj][m][0] * oscale, v1 = acc[ai][bj][m][1] * oscale;
                    u32x2 w; w.x = pk4_fp8(v0[0], v0[1], v0[2], v0[3]); w.y = pk4_fp8(v1[0], v1[1], v1[2], v1[3]);
                    *(u32x2*)(rowp + bj * HALF) = w; } }
    }
};
struct EpiFp8P16 {
    unsigned char* O; int ldc; float oscale;
    __device__ __forceinline__ void operator()(const f32x4 (&acc)[2][2][4][2], const Unit& u, int wr, int wc, int fr, int fq, LAS unsigned char* = nullptr) const {
        const int row0 = u.pm * BM + wr * 64 + fr, col0 = u.pn * BM + wc * 64 + 16 * fq;
#pragma unroll
        for (int ai = 0; ai < 2; ++ai)
#pragma unroll
            for (int m = 0; m < 4; ++m) { u32x4 w;
#pragma unroll
                for (int bj = 0; bj < 2; ++bj) { const f32x4 v0 = acc[ai][bj][m][0] * oscale, v1 = acc[ai][bj][m][1] * oscale; w[2 * bj] = pk4_fp8(v0[0], v0[1], v0[2], v0[3]); w[2 * bj + 1] = pk4_fp8(v1[0], v1[1], v1[2], v1[3]); }
                *(u32x4*)(O + (size_t)(row0 + ai * HALF + m * 16) * ldc + col0) = w; }
    }
};
struct EpiGlu {
    const bf16_t* ZG; const float* bias; unsigned char* OL;
    __device__ __forceinline__ void operator()(const f32x4 (&acc)[2][2][4][2], const Unit& u, int wr, int wc, int fr, int fq, LAS unsigned char* = nullptr) const {
        const int row0 = u.pm * BM + wr * 64 + fr, col0 = u.pn * BM + wc * 32 + 8 * fq;
        f32x4 bv[2][2];
#pragma unroll
        for (int bj = 0; bj < 2; ++bj)
#pragma unroll
            for (int n = 0; n < 2; ++n) bv[bj][n] = *(const f32x4*)(bias + col0 + bj * HALF + 4 * n);
        u32x4 zwv[2][4][2];
#pragma unroll
        for (int ai = 0; ai < 2; ++ai)
#pragma unroll
            for (int m = 0; m < 4; ++m)
#pragma unroll
                for (int bj = 0; bj < 2; ++bj) zwv[ai][m][bj] = *(const u32x4*)(ZG + (size_t)(row0 + ai * HALF + m * 16) * 512 + col0 + bj * HALF);
#pragma unroll
        for (int ai = 0; ai < 2; ++ai)
#pragma unroll
            for (int m = 0; m < 4; ++m) { const int row = row0 + ai * HALF + m * 16;
#pragma unroll
                for (int bj = 0; bj < 2; ++bj) { const u32x4 zw = zwv[ai][m][bj];
                    const float z[8] = {bflo(zw.x), bfhi(zw.x), bflo(zw.y), bfhi(zw.y), bflo(zw.z), bfhi(zw.z), bflo(zw.w), bfhi(zw.w)}; float o[8];
#pragma unroll
                    for (int n = 0; n < 2; ++n)
#pragma unroll
                        for (int j = 0; j < 4; ++j) { const float a = acc[ai][bj][m][n][j] + bv[bj][n][j]; o[n * 4 + j] = 16.0f * z[n * 4 + j] * __builtin_amdgcn_rcpf(1.0f + __expf(-a)); }
                    u32x2 w; w.x = pk4_fp8(o[0], o[1], o[2], o[3]); w.y = pk4_fp8(o[4], o[5], o[6], o[7]);
                    *(u32x2*)(OL + (size_t)row * 1024 + 512 + col0 + bj * HALF) = w; } }
    }
};
struct EpiBf16Dual {
    bf16_t* O0; int ldc0; bf16_t* O1; int ldc1;
    __device__ __forceinline__ void operator()(const f32x4 (&acc)[2][2][4][2], const Unit& u, int wr, int wc, int fr, int fq, LAS unsigned char* = nullptr) const {
        EpiBf16 e; e.O = u.g ? O1 : O0; e.ldc = u.g ? ldc1 : ldc0; e(acc, u, wr, wc, fr, fq);
    }
};
constexpr float WSCALE = 64.0f, WSCALE_INV = 1.0f / 64.0f;
struct EpiSwiglu {
    unsigned char* Z; const float* bias;
    __device__ __forceinline__ void operator()(const f32x4 (&acc)[2][2][4][2], const Unit& u, int wr, int wc, int fr, int fq, LAS unsigned char* sd) const {
        const int row0 = u.pm * BM + wr * 64 + fr, c0 = u.pn * 128 + wc * 32 + 8 * fq;
        const LAS float* be = (const LAS float*)(sd + 1024) + wc * 32 + 8 * fq;
        const f32x4 bg0 = *(const LAS f32x4*)(be), bg1 = *(const LAS f32x4*)(be + 4), bl0 = *(const LAS f32x4*)(be + 128), bl1 = *(const LAS f32x4*)(be + 132);
#pragma unroll
        for (int ai = 0; ai < 2; ++ai)
#pragma unroll
            for (int m = 0; m < 4; ++m) {
                float o[8];
#pragma unroll
                for (int n = 0; n < 2; ++n) { const f32x4 ga = acc[ai][0][m][n], la = acc[ai][1][m][n], bg = n ? bg1 : bg0, bl = n ? bl1 : bl0;
#pragma unroll
                    for (int j = 0; j < 4; j += 2) {
                        f32x2 g2 = (f32x2){ga[j], ga[j + 1]} * WSCALE_INV + (f32x2){bg[j], bg[j + 1]}, l2 = (f32x2){la[j], la[j + 1]} * WSCALE_INV + (f32x2){bl[j], bl[j + 1]};
                        g2.x = __builtin_amdgcn_fmed3f(g2.x, -24.0f, 7.0f); g2.y = __builtin_amdgcn_fmed3f(g2.y, -24.0f, 7.0f); l2.x = __builtin_amdgcn_fmed3f(l2.x, -7.0f, 7.0f); l2.y = __builtin_amdgcn_fmed3f(l2.y, -7.0f, 7.0f);
                        const f32x2 t2 = g2 * -2.4554669595930157f; f32x2 a2; a2.x = __builtin_amdgcn_exp2f(t2.x); a2.y = __builtin_amdgcn_exp2f(t2.y); a2 = a2 + 1.0f;
                        const float r = __builtin_amdgcn_rcpf(a2.x * a2.y);
                        const f32x2 o2 = g2 * (l2 + 1.0f) * ((f32x2){a2.y, a2.x} * r);
                        o[n * 4 + j] = o2.x; o[n * 4 + j + 1] = o2.y; } }
                u32x2 w; w.x = pk4_fp8(o[0], o[1], o[2], o[3]); w.y = pk4_fp8(o[4], o[5], o[6], o[7]);
                *(u32x2*)(Z + (size_t)(row0 + ai * HALF + m * 16) * 1024 + c0) = w; }
    }
};
constexpr float Y2SCALE = 32.0f, Y2SCALE_INV = 1.0f / 32.0f;
struct EpiMoeOut {
    unsigned char* Y2; const float* bias;
    __device__ __forceinline__ void operator()(const f32x4 (&acc)[2][2][4][2], const Unit& u, int wr, int wc, int fr, int fq, LAS unsigned char* sd) const {
        const int r0 = wr * 64 + fr, col0 = u.pn * BM + wc * 64 + 16 * fq;
        const LAS float* be = (const LAS float*)(sd + 1024) + wc * 64 + 16 * fq;
        const LAS float* gts = (const LAS float*)(sd + 2048);
        f32x4 bv[2][2];
#pragma unroll
        for (int bj = 0; bj < 2; ++bj)
#pragma unroll
            for (int n = 0; n < 2; ++n) bv[bj][n] = *(const LAS f32x4*)(be + 8 * bj + 4 * n);
#pragma unroll
        for (int ai = 0; ai < 2; ++ai)
#pragma unroll
            for (int m = 0; m < 4; ++m) { const int r = r0 + ai * HALF + m * 16; const float gt = gts[r] * Y2SCALE;
                u32x4 w;
#pragma unroll
                for (int bj = 0; bj < 2; ++bj) { const f32x4 v0 = (acc[ai][bj][m][0] * WSCALE_INV + bv[bj][0]) * gt, v1 = (acc[ai][bj][m][1] * WSCALE_INV + bv[bj][1]) * gt;
                    w[2 * bj] = pk4_fp8(v0[0], v0[1], v0[2], v0[3]); w[2 * bj + 1] = pk4_fp8(v1[0], v1[1], v1[2], v1[3]); }
                *(u32x4*)(Y2 + (size_t)(u.pm * BM + r) * 1024 + col0) = w; }
    }
};
}


namespace att {
constexpr int NW = 8, QBLK = 32, KVBLK = 64, DV = 128;
typedef short s16x4 __attribute__((ext_vector_type(4)));
typedef float f32x16 __attribute__((ext_vector_type(16)));
#define SBAR() __builtin_amdgcn_sched_barrier(0)
__device__ __forceinline__ int crow(int r, int hi) { return (r & 3) + 8 * (r >> 2) + 4 * hi; }
__device__ __forceinline__ unsigned cvtpk(float lo, float hi) { unsigned r; asm volatile("v_cvt_pk_bf16_f32 %0, %1, %2" : "=v"(r) : "v"(lo), "v"(hi)); return r; }
template <int DK> __device__ __forceinline__ int kswz(int row, int colB) { return row * (DK * 2) + (colB ^ ((row & 7) << 4)); }
constexpr float THR = 8.f;

template <int DK, bool WINDOW>
__device__ __forceinline__ void partialSM(f32x16& p0, f32x16& p1, float& m_reg, float& mn, float& alpha, const bool masked, const int mbase) {
  constexpr float SCALE = (DK == 128) ? 0.088388347648318440f : 0.072168783648703220f;
  constexpr float C = SCALE * 1.4426950408889634f;
  if (WINDOW && masked) {
#pragma unroll
    for (int r = 0; r < 16; ++r) { const int d0 = mbase + (r & 3) + 8 * (r >> 2); const int d1 = d0 + 32;
      p0[r] = (d0 < -128 || d0 > 128) ? -1e30f : p0[r]; p1[r] = (d1 < -128 || d1 > 128) ? -1e30f : p1[r]; }
  }
  float pmax = p0[0];
#pragma unroll
  for (int r = 1; r < 16; ++r) pmax = fmaxf(pmax, p0[r]);
#pragma unroll
  for (int r = 0; r < 16; ++r) pmax = fmaxf(pmax, p1[r]);
  { auto rr = __builtin_amdgcn_permlane32_swap(__float_as_uint(pmax), __float_as_uint(pmax), false, false);
    pmax = fmaxf(__uint_as_float(rr[0]), __uint_as_float(rr[1])); }
  if (__builtin_expect(__all(pmax - m_reg <= THR / SCALE), 1)) { mn = m_reg; alpha = 1.f; }
  else { mn = fmaxf(m_reg, pmax); alpha = __builtin_amdgcn_exp2f((m_reg - mn) * C); m_reg = mn; }
  const float mnC = -mn * C;
#pragma unroll
  for (int r = 0; r < 16; ++r) p0[r] = fmaf(p0[r], C, mnC);
#pragma unroll
  for (int r = 0; r < 16; ++r) p1[r] = fmaf(p1[r], C, mnC);
#pragma unroll
  for (int r = 0; r < 16; ++r) p0[r] = __builtin_amdgcn_exp2f(p0[r]);
}
__device__ __forceinline__ void finishSM(f32x16& p0, f32x16& p1, float alpha, float& l_reg, bf16x8& pa0, bf16x8& pa1, bf16x8& pa2, bf16x8& pa3) {
#pragma unroll
  for (int r = 0; r < 16; ++r) p1[r] = __builtin_amdgcn_exp2f(p1[r]);
  float ps = 0;
#pragma unroll
  for (int r = 0; r < 16; ++r) ps += p0[r];
#pragma unroll
  for (int r = 0; r < 16; ++r) ps += p1[r];
  { auto rr = __builtin_amdgcn_permlane32_swap(__float_as_uint(ps), __float_as_uint(ps), false, false);
    ps = __uint_as_float(rr[0]) + __uint_as_float(rr[1]); }
  l_reg = l_reg * alpha + ps;
#define PK4(P, BASE, OUT) do { unsigned a0 = cvtpk(P[BASE + 0], P[BASE + 1]), a1 = cvtpk(P[BASE + 2], P[BASE + 3]);   \
    unsigned b0 = cvtpk(P[BASE + 4], P[BASE + 5]), b1 = cvtpk(P[BASE + 6], P[BASE + 7]);                              \
    auto r0 = __builtin_amdgcn_permlane32_swap(a0, b0, false, false); auto r1 = __builtin_amdgcn_permlane32_swap(a1, b1, false, false); \
    u32x4 w = {r0[0], r1[0], r0[1], r1[1]}; OUT = *reinterpret_cast<bf16x8*>(&w); } while (0)
  PK4(p0, 0, pa0); PK4(p0, 8, pa1); PK4(p1, 0, pa2); PK4(p1, 8, pa3);
#undef PK4
}
template <int DK>
__device__ __forceinline__ void qkt(f32x16& p0, f32x16& p1, const LAS char* Ks, const bf16x8* qr, int r32, int hi) {
  p0 = f32x16{}; p1 = f32x16{};
#pragma unroll
  for (int d0 = 0; d0 < DK / 16; ++d0) { const int cb = (d0 * 16 + hi * 8) * 2;
    const bf16x8 b0 = *reinterpret_cast<const LAS bf16x8*>(Ks + kswz<DK>(r32, cb));
    const bf16x8 b1 = *reinterpret_cast<const LAS bf16x8*>(Ks + kswz<DK>(32 + r32, cb));
    p0 = __builtin_amdgcn_mfma_f32_32x32x16_bf16(b0, qr[d0], p0, 0, 0, 0);
    p1 = __builtin_amdgcn_mfma_f32_32x32x16_bf16(b1, qr[d0], p1, 0, 0, 0); }
}
__device__ __forceinline__ int v_st(int k, int c) { const int kk = (k & ~0xC) | ((k & 4) << 1) | ((k & 8) >> 1); return ((kk >> 3) * 4 + (c >> 5)) * 512 + ((kk & 7) * 32 + (c & 31)) * 2; }
__device__ __forceinline__ int v_rd_base(int lane) { return ((lane & 3) << 3) | (((lane >> 2) & 3) << 6) | (((lane >> 4) & 1) << 5) | (((lane >> 5) & 1) << 8); }
constexpr int v_rd_off(int d0, int ks, int half) { return d0 * 512 + ks * 4096 + half * 2048; }
template <int OFF> __device__ __forceinline__ s16x4 tr_read(int vb) {
  s16x4 r; asm volatile("ds_read_b64_tr_b16 %0, %1 offset:%2" : "=&v"(r) : "v"(vb), "i"(OFF) : "memory"); return r;
}
template <int D0> __device__ __forceinline__ void pv_one(f32x16& od, int vb, bf16x8 pa0, bf16x8 pa1, bf16x8 pa2, bf16x8 pa3) {
  const s16x4 l0 = tr_read<v_rd_off(D0, 0, 0)>(vb), h0 = tr_read<v_rd_off(D0, 0, 1)>(vb), l1 = tr_read<v_rd_off(D0, 1, 0)>(vb), h1 = tr_read<v_rd_off(D0, 1, 1)>(vb);
  const s16x4 l2 = tr_read<v_rd_off(D0, 2, 0)>(vb), h2 = tr_read<v_rd_off(D0, 2, 1)>(vb), l3 = tr_read<v_rd_off(D0, 3, 0)>(vb), h3 = tr_read<v_rd_off(D0, 3, 1)>(vb);
  asm volatile("s_waitcnt lgkmcnt(0)" ::: "memory"); SBAR();
#define PK(L, H) (bf16x8){L[0], L[1], L[2], L[3], H[0], H[1], H[2], H[3]}
  od = __builtin_amdgcn_mfma_f32_32x32x16_bf16(pa0, PK(l0, h0), od, 0, 0, 0);
  od = __builtin_amdgcn_mfma_f32_32x32x16_bf16(pa1, PK(l1, h1), od, 0, 0, 0);
  od = __builtin_amdgcn_mfma_f32_32x32x16_bf16(pa2, PK(l2, h2), od, 0, 0, 0);
  od = __builtin_amdgcn_mfma_f32_32x32x16_bf16(pa3, PK(l3, h3), od, 0, 0, 0);
#undef PK
}
__device__ __forceinline__ void pv_d0(f32x16* o, int vb, bf16x8 pa0, bf16x8 pa1, bf16x8 pa2, bf16x8 pa3) {
  pv_one<0>(o[0], vb, pa0, pa1, pa2, pa3); pv_one<1>(o[1], vb, pa0, pa1, pa2, pa3); pv_one<2>(o[2], vb, pa0, pa1, pa2, pa3); pv_one<3>(o[3], vb, pa0, pa1, pa2, pa3);
}

struct Unit {
  const bf16_t* Q; int ldq;
  const bf16_t* K; int ldk;
  const bf16_t* KR; int ldkr;
  const bf16_t* V; int ldv;
  unsigned char* O; int ldo;
  int NT;
  int kofs;
  int q0;
  float sink; int has_sink;
  const float* rope; int rope_row, rope_col_base;
};

template <int DK, bool WINDOW, int SD, bool SIMPLE>
__device__ __forceinline__ void attn_unit(const Unit& U, LAS char* lds, const int wid0) {
  constexpr int SHM_V = KVBLK * DV * 2, SHM_K = KVBLK * DK * 2;
  constexpr float SCALE = (DK == 128) ? 0.088388347648318440f : 0.072168783648703220f;
  constexpr float C = SCALE * 1.4426950408889634f;
  constexpr int NKC = (DK == 128) ? 2 : 3;
  const int lane = lane_now(); const int wid = wid0; const int tid = wid0 * 64 + lane; const int r32 = lane & 31, hi = lane >> 5;
  LAS char* V_lds = lds; LAS char* K_lds = lds + 2 * SHM_V;
  LAS float* wsf = (LAS float*)(lds + 2 * SHM_V + 2 * SHM_K) + wid * 64; LAS float* li_l = wsf; LAS float* al_l = wsf + 32;
  float m_reg = -1e30f, l_reg = 0; f32x16 o[4] = {}; bf16x8 qr[DK / 16];
  const bf16_t* Qw = U.Q + (long)(wid * QBLK + r32) * U.ldq + hi * 8;
#pragma unroll
  for (int d0 = 0; d0 < DK / 16; ++d0) qr[d0] = *reinterpret_cast<const bf16x8*>(Qw + d0 * 16);
  if (DK == 192 && U.rope != nullptr) {
    const int pos = U.q0 + wid * QBLK + r32; const int ri = pos >> 6, ci = pos & 63;
#pragma unroll
    for (int hf = 0; hf < 2; ++hf) { const float* tp = U.rope + ((hf ? ci : ri) * 16 + hi * 8) * 2;
      bf16x8 x1 = qr[8 + 2 * hf], x2 = qr[9 + 2 * hf];
#pragma unroll
      for (int i = 0; i < 8; ++i) { const float c = tp[2 * i], sn = tp[2 * i + 1]; const float a = bf2f((unsigned short)x1[i]), b = bf2f((unsigned short)x2[i]);
        x1[i] = (short)f2bf(a * c - b * sn); x2[i] = (short)f2bf(b * c + a * sn); }
      qr[8 + 2 * hf] = x1; qr[9 + 2 * hf] = x2; }
  }
  const int sr = tid >> 4, sc = (tid & 15) * 8, vst0 = v_st(sr, sc), vst1 = v_st(32 + sr, sc);
  int krw[NKC], kcs[NKC], kdst[NKC];
#pragma unroll
  for (int i = 0; i < NKC; ++i) { const int id = tid + 512 * i; if (DK == 128) { krw[i] = (i == 0) ? sr : 32 + sr; kcs[i] = sc; } else { krw[i] = id / 24; kcs[i] = (id % 24) * 8; }
    kdst[i] = kswz<DK>(krw[i], kcs[i] * 2); }
  const int vb0 = (int)(uintptr_t)V_lds + v_rd_base(lane);
  struct { bf16x8 vs0, vs1, ks[NKC]; } sr_[SD];
  constexpr int SO = SD - 1;
  const int kofs = U.kofs;
#define KROW(j) (64 * (j) + (((j) >= 4) ? kofs : 0))
#define SLOAD(i, jt) do { const int _k0 = KROW(jt); sr_[i].vs0 = *reinterpret_cast<const bf16x8*>(&U.V[(long)(_k0 + sr) * U.ldv + sc]); sr_[i].vs1 = *reinterpret_cast<const bf16x8*>(&U.V[(long)(_k0 + 32 + sr) * U.ldv + sc]); \
    _Pragma("unroll") for (int _c = 0; _c < NKC; ++_c) { if (DK == 128 || kcs[_c] < 128) sr_[i].ks[_c] = *reinterpret_cast<const bf16x8*>(&U.K[(long)(_k0 + krw[_c]) * U.ldk + kcs[_c]]); \
      else sr_[i].ks[_c] = *reinterpret_cast<const bf16x8*>(&U.KR[(long)(_k0 + krw[_c]) * U.ldkr + (kcs[_c] - 128)]); } } while (0)
#define SWRITE(b, i) do { *(LAS bf16x8*)(V_lds + (b) * SHM_V + vst0) = sr_[i].vs0; *(LAS bf16x8*)(V_lds + (b) * SHM_V + vst1) = sr_[i].vs1; \
    _Pragma("unroll") for (int _c = 0; _c < NKC; ++_c) *(LAS bf16x8*)(K_lds + (b) * SHM_K + kdst[_c]) = sr_[i].ks[_c]; } while (0)
#define SWAIT() asm volatile("s_waitcnt vmcnt(%0)" :: "n"(SD == 2 ? 2 + NKC : 0) : "memory")
#define RESC(a) do { if (__any((a) < 1.f)) { if (hi == 0) al_l[r32] = (a); asm volatile("s_waitcnt lgkmcnt(0)" ::: "memory"); \
    _Pragma("unroll") for (int d = 0; d < 4; ++d) _Pragma("unroll") for (int r = 0; r < 16; ++r) o[d][r] *= al_l[crow(r, hi)]; } } while (0)
  const int qpos = U.q0 + wid * QBLK + r32;
#define MBASE(jt) (kofs + 64 * (jt) - 256 - qpos + 4 * hi)
  bf16x8 pa0, pa1, pa2, pa3; const int NT = U.NT;
  if constexpr (SIMPLE) {
    f32x16 p0, p1; float mn, al;
    SLOAD(0, 0); asm volatile("s_waitcnt vmcnt(0)" ::: "memory"); SWRITE(0, 0); __syncthreads();
    for (int j = 0; j < NT; ++j) {
      const int bsel = j & 1;
      if (j + 1 < NT) SLOAD(0, j + 1);
      SBAR(); qkt<DK>(p0, p1, K_lds + bsel * SHM_K, qr, r32, hi);
      partialSM<DK, WINDOW>(p0, p1, m_reg, mn, al, j >= 4, MBASE(j));
      RESC(al);
      finishSM(p0, p1, al, l_reg, pa0, pa1, pa2, pa3); SBAR();
      pv_d0(o, vb0 + bsel * SHM_V, pa0, pa1, pa2, pa3);
      if (j + 1 < NT) { asm volatile("s_waitcnt vmcnt(0)" ::: "memory"); SWRITE(bsel ^ 1, 0); }
      __syncthreads();
    }
  } else {
  f32x16 pA0, pA1, pB0, pB1; float mnA, mnB, alA, alB;
  SLOAD(0, 0); asm volatile("s_waitcnt vmcnt(0)" ::: "memory"); SWRITE(0, 0); __syncthreads();
  qkt<DK>(pA0, pA1, K_lds, qr, r32, hi); partialSM<DK, WINDOW>(pA0, pA1, m_reg, mnA, alA, false, 0);
  SLOAD(SO, 1); if (SD == 2 && 2 < NT) SLOAD(0, 2);
  SWAIT(); SWRITE(1, SO); __syncthreads();
  for (int j = 1; j + 1 < NT; j += 2) {
    SBAR(); qkt<DK>(pB0, pB1, K_lds + SHM_K, qr, r32, hi);
    finishSM(pA0, pA1, alA, l_reg, pa0, pa1, pa2, pa3); SBAR();
    SLOAD(SO, j + SD); SBAR();
    pv_d0(o, vb0, pa0, pa1, pa2, pa3); partialSM<DK, WINDOW>(pB0, pB1, m_reg, mnB, alB, j >= 4, MBASE(j));
    __syncthreads(); SWAIT(); SWRITE(0, 0);
    RESC(alB); __syncthreads();
    SBAR(); qkt<DK>(pA0, pA1, K_lds, qr, r32, hi);
    finishSM(pB0, pB1, alB, l_reg, pa0, pa1, pa2, pa3); SBAR();
    if (SD == 1 || j + 3 < NT) SLOAD(0, j + 1 + SD); SBAR();
    pv_d0(o, vb0 + SHM_V, pa0, pa1, pa2, pa3); partialSM<DK, WINDOW>(pA0, pA1, m_reg, mnA, alA, j + 1 >= 4, MBASE(j + 1));
    __syncthreads(); SWAIT(); SWRITE(1, SO);
    RESC(alA); __syncthreads();
  }
  SBAR(); qkt<DK>(pB0, pB1, K_lds + SHM_K, qr, r32, hi);
  finishSM(pA0, pA1, alA, l_reg, pa0, pa1, pa2, pa3); SBAR();
  pv_d0(o, vb0, pa0, pa1, pa2, pa3); partialSM<DK, WINDOW>(pB0, pB1, m_reg, mnB, alB, NT - 1 >= 4, MBASE(NT - 1));
  __syncthreads(); RESC(alB);
  finishSM(pB0, pB1, alB, l_reg, pa0, pa1, pa2, pa3); SBAR();
  pv_d0(o, vb0 + SHM_V, pa0, pa1, pa2, pa3);
  }
  if (WINDOW && U.has_sink) l_reg += __builtin_amdgcn_exp2f(U.sink * 1.4426950408889634f - m_reg * C);
  if (hi == 0) li_l[r32] = l_reg; asm volatile("s_waitcnt lgkmcnt(0)" ::: "memory");
  float rli[16];
#pragma unroll
  for (int r = 0; r < 16; ++r) rli[r] = __builtin_amdgcn_rcpf(li_l[crow(r, hi)]);
  __syncthreads();
  { LAS unsigned char* ot = (LAS unsigned char*)V_lds + wid * 4096;
#pragma unroll
    for (int r = 0; r < 16; ++r) { const int orow = crow(r, hi);
#pragma unroll
      for (int d0 = 0; d0 < 4; ++d0) { const float ov = o[d0][r] * rli[r] * 16.0f; ot[orow * 128 + d0 * 32 + r32] = (unsigned char)(__builtin_amdgcn_cvt_pk_fp8_f32(ov, ov, 0, false) & 0xff); } }
    asm volatile("s_waitcnt lgkmcnt(0)" ::: "memory");
    unsigned char* Ow = U.O + (long)(wid * QBLK + (lane >> 1)) * U.ldo + (lane & 1) * 64;
    const LAS unsigned char* os = ot + (lane >> 1) * 128 + (lane & 1) * 64;
#pragma unroll
    for (int q = 0; q < 4; ++q) *(u32x4*)(Ow + q * 16) = *(const LAS u32x4*)(os + q * 16); }
  __syncthreads();
#undef KROW
#undef SLOAD
#undef SWRITE
#undef SWAIT
#undef RESC
#undef MBASE
}
}

struct Args { const float* in[34]; float* out; unsigned char* ws; };

__device__ __forceinline__ void transpose_item(const float* W, int ldw, int K, bf16_t* WT, int k0, int n0, int drow0, LAS float* scr, int lane) {
#pragma unroll 32
    for (int i = 0; i < 32; ++i) { const int kk = 2 * i + (lane >> 5); scr[kk * 33 + (lane & 31)] = W[(size_t)(k0 + kk) * ldw + n0 + (lane & 31)]; }
    LDS_WAIT(); asm volatile("" ::: "memory");
    const int c = lane & 7;
#pragma unroll
    for (int j = 0; j < 4; ++j) { const int n = (lane >> 3) + 8 * j; const LAS float* s = scr + (8 * c) * 33 + n;
        u32x4 o; o.x = pk2(s[0 * 33], s[1 * 33]); o.y = pk2(s[2 * 33], s[3 * 33]); o.z = pk2(s[4 * 33], s[5 * 33]); o.w = pk2(s[6 * 33], s[7 * 33]);
        *(u32x4*)(WT + (size_t)(drow0 + n) * K + k0 + 8 * c) = o; }
    LDS_WAIT(); asm volatile("" ::: "memory");
}

__device__ __forceinline__ void transpose_item_fp8(const float* W, int ldw, int K, unsigned char* WT, int k0, int n0, int drow0, LAS float* scr, int lane) {
#pragma unroll 32
    for (int i = 0; i < 32; ++i) { const int kk = 2 * i + (lane >> 5); scr[kk * 33 + (lane & 31)] = W[(size_t)(k0 + kk) * ldw + n0 + (lane & 31)] * 64.0f; }
    LDS_WAIT(); asm volatile("" ::: "memory");
    const int c = lane & 7;
#pragma unroll
    for (int j = 0; j < 4; ++j) { const int n = (lane >> 3) + 8 * j; const LAS float* s = scr + (8 * c) * 33 + n;
        u32x2 o; o.x = pg8::pk4_fp8(s[0 * 33], s[1 * 33], s[2 * 33], s[3 * 33]); o.y = pg8::pk4_fp8(s[4 * 33], s[5 * 33], s[6 * 33], s[7 * 33]);
        *(u32x2*)(WT + (size_t)(drow0 + n) * K + k0 + 8 * c) = o; }
    LDS_WAIT(); asm volatile("" ::: "memory");
}
struct ConvHalf { const float* src; unsigned char* dst; int ldw; int drow[2]; };
__device__ __forceinline__ ConvHalf conv_half_of(const float* w_exp_in, const float* w_exp_out, unsigned char* WexpIn, unsigned char* WexpOut, int layer, int hidx) {
    const int g = hidx >> 1, hp = hidx & 1; ConvHalf c;
    if (g < 8192) { const int le = layer * 32 + (g >> 8), q = g & 255; const int k0 = (q >> 4) * 64, n0 = (q & 15) * 128 + 64 * hp;
        c.src = w_exp_in + (size_t)le * 1024 * 2048 + (size_t)k0 * 2048 + n0; c.ldw = 2048; c.dst = WexpIn + (size_t)le * 2048 * 1024 + k0;
#pragma unroll
        for (int sb = 0; sb < 2; ++sb) { const int nn = n0 + 32 * sb; c.drow[sb] = (nn < 1024) ? ((nn >> 7) * 256 + (nn & 127)) : (((nn - 1024) >> 7) * 256 + 128 + ((nn - 1024) & 127)); } }
    else { const int g2 = g - 8192; const int le = layer * 32 + (g2 >> 7), q = g2 & 127; const int k0 = (q >> 3) * 64, n0 = (q & 7) * 128 + 64 * hp;
        c.src = w_exp_out + (size_t)le * 1024 * 1024 + (size_t)k0 * 1024 + n0; c.ldw = 1024; c.dst = WexpOut + (size_t)le * 1024 * 1024 + k0; c.drow[0] = n0; c.drow[1] = n0 + 32; }
    return c;
}
#define CONV_LOAD(ch, wv) do { _Pragma("unroll") for (int sb_ = 0; sb_ < 2; ++sb_) _Pragma("unroll") for (int i_ = 0; i_ < 32; ++i_) { const int kk_ = 2 * i_ + (lane >> 5); wv[sb_][i_] = (ch).src[(size_t)kk_ * (ch).ldw + 32 * sb_ + (lane & 31)]; } } while (0)
#define CONV_STORE(ch, wv) do { _Pragma("unroll") for (int sb_ = 0; sb_ < 2; ++sb_) { \
        _Pragma("unroll") for (int i_ = 0; i_ < 32; ++i_) { const int kk_ = 2 * i_ + (lane >> 5); scr[kk_ * 33 + (lane & 31)] = wv[sb_][i_] * 64.0f; } \
        LDS_WAIT(); asm volatile("" ::: "memory"); \
        _Pragma("unroll") for (int j_ = 0; j_ < 4; ++j_) { const int n_ = (lane >> 3) + 8 * j_; const LAS float* sp_ = scr + (8 * (lane & 7)) * 33 + n_; \
            u32x2 o_; o_.x = pg8::pk4_fp8(sp_[0 * 33], sp_[1 * 33], sp_[2 * 33], sp_[3 * 33]); o_.y = pg8::pk4_fp8(sp_[4 * 33], sp_[5 * 33], sp_[6 * 33], sp_[7 * 33]); \
            *(u32x2*)((ch).dst + (size_t)((ch).drow[sb_] + n_) * 1024 + 8 * (lane & 7)) = o_; } \
        LDS_WAIT(); asm volatile("" ::: "memory"); } } while (0)
__device__ __forceinline__ void expert_conv_run(const float* w_exp_in, const float* w_exp_out, unsigned char* WexpIn, unsigned char* WexpOut, int layer, int h0, int nh, LAS float* scr, int lane) {
    float wa[2][32], wb[2][32];
    ConvHalf ca = conv_half_of(w_exp_in, w_exp_out, WexpIn, WexpOut, layer, h0), cb = ca;
    CONV_LOAD(ca, wa);
#pragma clang loop unroll(disable)
    for (int h = 0; h < nh; h += 2) {
        cb = conv_half_of(w_exp_in, w_exp_out, WexpIn, WexpOut, layer, h0 + (h + 1) * 8); CONV_LOAD(cb, wb);
        CONV_STORE(ca, wa);
        if (h + 2 < nh) { ca = conv_half_of(w_exp_in, w_exp_out, WexpIn, WexpOut, layer, h0 + (h + 2) * 8); CONV_LOAD(ca, wa); }
        CONV_STORE(cb, wb);
    }
}
__device__ __forceinline__ bool conv_group(int& r, const float* W, int nmat, int K, int N, bf16_t* WT, int ldrows, LAS float* scr, int lane) {
    const int per = (K / 64) * (N / 32); if (r >= nmat * per) { r -= nmat * per; return false; }
    const int mi = r / per, q = r % per, kb = q / (N / 32), nb = q % (N / 32);
    transpose_item(W + (size_t)mi * K * N, N, K, WT + (size_t)mi * ldrows * K, kb * 64, nb * 32, nb * 32, scr, lane); return true;
}

typedef const Args __attribute__((address_space(4))) CArgs;
#define PHASE_ARGS() CArgs* A_ = (CArgs*)__builtin_amdgcn_kernarg_segment_ptr(); asm volatile("" : "+s"(A_)); unsigned char* const ws = A_->ws; (void)ws; int Gp = G, vcup = vcu, bxp = bx; asm volatile("" : "+s"(Gp), "+s"(vcup), "+s"(bxp)); (void)Gp; (void)vcup; (void)bxp
#define IN(k) (A_->in[k])
#define WSP(T, off) ((T*)(ws + (off)))
__global__ void __launch_bounds__(NTHR, 2) fwd_kernel(Args args) {
    extern __shared__ __attribute__((aligned(16))) unsigned char lds_raw[];
    LAS unsigned char* lds = (LAS unsigned char*)lds_raw;
    const int G = gridDim.x; const int bx = blockIdx.x; const int vcu = (G % 8 == 0) ? (bx % 8) * (G / 8) + bx / 8 : bx;
    volatile LAS unsigned* MISC = (volatile LAS unsigned*)(lds + LDS_MISC);
    const int wave0 = __builtin_amdgcn_readfirstlane((int)threadIdx.x >> 6);
    for (int u = threadIdx.x; u < (LDS_BYTES - LDS_MISC) / 4; u += NTHR) MISC[u] = 0u;
    __syncthreads();
    XcdBarrier bar = xcd_barrier_post((unsigned*)(args.ws + WS_CTL) + CW_BAR, MISC + 0);
    bar.x = (unsigned)wave0;
#define GRID_BAR() do { xcd_barrier(bar); if (DUPSEL == 15) xcd_barrier(bar); } while (0)
#define PROBE_MULT 4u
#define PT_SAMPLE(id) do { if (PROBE_MASK != 0ull) { const unsigned pt_now_ = (unsigned)__builtin_amdgcn_s_memrealtime(); if (wave0 == 0 && lane_now() == 0) { const unsigned pt_last_ = MISC[3400]; if ((PROBE_MASK >> (id)) & 1ull) MISC[3401] = MISC[3401] + (pt_now_ - pt_last_); MISC[3400] = pt_now_; } } } while (0)
#define GRID_BARP(id) do { GRID_BAR(); PT_SAMPLE(id); } while (0)
    const int NGW = G * NWAVES;
    PT_SAMPLE(0);

    {
        PHASE_IDS(); PHASE_ARGS();
        const float* in_c = IN(1); const float* in_cctx = IN(3); const float* w_mod = IN(4); const float* b_mod = IN(5);
        const float* w_mix_out = IN(8); const float* w_exp_in = IN(11); const float* w_exp_out = IN(13);
        const float* w_in_ab = IN(15); const float* w_glu = IN(26); const float* w_in_cd = IN(28); const float* w_uq = IN(31); const float* w_ukv = IN(32);
        float* MOD = WSP(float, WS_MOD); unsigned char* WexpIn = WSP(unsigned char, WS_WEXPIN); unsigned char* WexpOut = WSP(unsigned char, WS_WEXPOUT); unsigned char* Wmix = WSP(unsigned char, WS_WMIX);
        unsigned char* WinAB = WSP(unsigned char, WS_WINAB); unsigned char* WinCD = WSP(unsigned char, WS_WINCD); bf16_t* Wglu = WSP(bf16_t, WS_WGLU); bf16_t* Wuq = WSP(bf16_t, WS_WUQ); bf16_t* Wukv = WSP(bf16_t, WS_WUKV);
        float* T32 = WSP(float, WS_ROPE); float* T16 = T32 + 64 * 32 * 2;
        LAS float* scr = (LAS float*)(lds + LDS_STAGE + wave * 16384);
        constexpr int I_MIX = 16 * 32;
        constexpr int NIT = 4 * I_MIX + 2 * (16 * 48 + 16 * 50 + 8 * 16 + 4 * 24 + 4 * 32);
        for (int rep_ = 0; rep_ < DUPN(1); ++rep_)
        for (int it = gw; it < NIT; it += NGW) {
            int r = it;
            if (r < 4 * I_MIX) { const int mi = r / I_MIX, q = r % I_MIX, kb = q / 32, nb = q % 32;
                transpose_item_fp8(w_mix_out + (size_t)mi * 1024 * 1024, 1024, 1024, Wmix + (size_t)mi * 1024 * 1024, kb * 64, nb * 32, nb * 32, scr, lane); continue; }
            r -= 4 * I_MIX;
            if (r < 2 * 16 * 48) { const int mi = r / (16 * 48), q = r % (16 * 48), kb = q / 48, nb = q % 48;
                transpose_item_fp8(w_in_ab + (size_t)mi * 1024 * 1536, 1536, 1024, WinAB + (size_t)mi * 1536 * 1024, kb * 64, nb * 32, nb * 32, scr, lane); continue; }
            r -= 2 * 16 * 48;
            if (r < 2 * 16 * 50) { const int mi = r / (16 * 50), q = r % (16 * 50), kb = q / 50, nb = q % 50;
                transpose_item_fp8(w_in_cd + (size_t)mi * 1024 * 1600, 1600, 1024, WinCD + (size_t)mi * 1792 * 1024, kb * 64, nb * 32, nb * 32, scr, lane); continue; }
            r -= 2 * 16 * 50;
            if (conv_group(r, w_glu, 2, 512, 512, Wglu, 512, scr, lane)) continue;
            if (conv_group(r, w_uq, 2, 256, 768, Wuq, 768, scr, lane)) continue;
            (void)conv_group(r, w_ukv, 2, 256, 1024, Wukv, 1024, scr, lane);
        }
        PT_SAMPLE(20);
        for (int i = vcu * NTHR + tid; i < 2 * 192 * 1024 / 16; i += G * NTHR) { const int mi = i / (192 * 64), q = i % (192 * 64); *(u32x4*)(WinCD + ((size_t)mi * 1792 + 1600) * 1024 + (size_t)q * 16) = (u32x4){0u, 0u, 0u, 0u}; }
        { const float* w_router = IN(9); bf16_t* WRFo = WSP(bf16_t, WS_WRF);
          for (int i = vcu * NTHR + tid; i < 4 * 2 * 32 * 64 * 8; i += G * NTHR) { const int ii = i & 7, ln = (i >> 3) & 63, sidx = (i >> 9) & 31, nt = (i >> 14) & 1, l = i >> 15;
            const int k = 32 * sidx + 8 * (ln >> 4) + ii, e = nt * 16 + (ln & 15); const float w = w_router[((size_t)l * 1024 + k) * 32 + e]; const unsigned hi = f2bf(w); const unsigned lo = f2bf(w - bflo(hi));
            WRFo[(size_t)l * 65536 + ((size_t)(0 * 2 + nt) * 32 + sidx) * 512 + ln * 8 + ii] = (bf16_t)hi; WRFo[(size_t)l * 65536 + ((size_t)(1 * 2 + nt) * 32 + sidx) * 512 + ln * 8 + ii] = (bf16_t)lo; } }
        for (int i = vcu * NTHR + tid; i < 64 * 32 + 64 * 16; i += G * NTHR) {
            if (i < 64 * 32) { const int idx = i >> 5, j = i & 31; const float ang = (float)idx * expf(-(float)j * (1.0f / 32.0f) * 9.210340371976184f); float sn, cs; sincosf(ang, &sn, &cs); T32[i * 2] = cs; T32[i * 2 + 1] = sn; }
            else { const int q = i - 64 * 32, idx = q >> 4, j = q & 15; const float ang = (float)idx * expf(-(float)j * (1.0f / 16.0f) * 9.210340371976184f); float sn, cs; sincosf(ang, &sn, &cs); T16[q * 2] = cs; T16[q * 2 + 1] = sn; }
        }

        PT_SAMPLE(21);
        {
            const float* lam_re = IN(18); const float* lam_im = IN(19); const float* log_dt = IN(20); const float* b_re = IN(21); const float* b_im = IN(22); const float* c_re = IN(23); const float* c_im = IN(24);
            bf16_t* TFb = WSP(bf16_t, WS_TF); bf16_t* SFb = WSP(bf16_t, WS_SF); bf16_t* WFb = WSP(bf16_t, WS_WF); float* LAM16 = WSP(float, WS_LAM16);
            __syncthreads();
            LAS f32x2* Pw = (LAS f32x2*)(lds + LDS_STAGE);
            LAS f32x2* Bb = Pw + 17 * 64;
            LAS f32x2* Cc = Bb + 64 * 16;
            LAS float* Kt = (LAS float*)(Cc + 64 * 16);
            for (int unit = vcu - (G - 128); unit >= 0 && unit < 128; unit += G) {
                const int dir = (unit >> 5) & 1;
                for (int idx = tid; idx < 17 * 64; idx += NTHR) { const int tau = idx >> 6, n = idx & 63; const float lr = lam_re[unit * 64 + n], lim = lam_im[unit * 64 + n], dt = expf(log_dt[unit]);
                    const float mag = expf((float)tau * dt * lr); float sn, cs; sincosf((float)tau * dt * lim, &sn, &cs); Pw[idx] = (f32x2){mag * cs, mag * sn}; }
                for (int idx = tid; idx < 64 * 16; idx += NTHR) { const int n = idx >> 4; const float lr = lam_re[unit * 64 + n], lim = lam_im[unit * 64 + n], dt = expf(log_dt[unit]);
                    const float mag = expf(dt * lr); float sn, cs; sincosf(dt * lim, &sn, &cs); const float nr = mag * cs - 1.0f, ni = mag * sn; const float den = 1.0f / (lr * lr + lim * lim);
                    const float cbr = (nr * lr + ni * lim) * den, cbi = (ni * lr - nr * lim) * den;
                    const float br = b_re[(size_t)unit * 1024 + idx], bi = b_im[(size_t)unit * 1024 + idx]; Bb[idx] = (f32x2){cbr * br - cbi * bi, cbr * bi + cbi * br};
                    Cc[(idx & 63) * 16 + (idx >> 6)] = (f32x2){c_re[(size_t)unit * 1024 + idx], c_im[(size_t)unit * 1024 + idx]}; }
                __syncthreads();
                { const int tau = tid >> 5, cout = (tid >> 1) & 15, ch = tid & 1; float ka[8];
#pragma unroll
                  for (int j = 0; j < 8; ++j) ka[j] = 0.f;
                  for (int n = 0; n < 64; ++n) { const f32x2 c = Cc[n * 16 + cout], pw = Pw[tau * 64 + n]; const float tr = c.x * pw.x - c.y * pw.y, ti = c.x * pw.y + c.y * pw.x;
                      const LAS f32x4* bp = (const LAS f32x4*)(Bb + n * 16 + ch * 8);
#pragma unroll
                      for (int j = 0; j < 4; ++j) { const f32x4 b2 = bp[j]; ka[2 * j] += tr * b2[0] - ti * b2[1]; ka[2 * j + 1] += tr * b2[2] - ti * b2[3]; } }
#pragma unroll
                  for (int j = 0; j < 8; ++j) Kt[(tau * 16 + cout) * 16 + ch * 8 + j] = ka[j]; }
                __syncthreads();
                for (int pq = tid; pq < 16 * 64; pq += NTHR) { const int f = pq >> 6, l = pq & 63; const int cout = l & 15, kq = l >> 4, sl = kq >> 1;
                    const int tau = dir == 0 ? f - sl : f - 1 + sl; u32x4 w = (u32x4){0u, 0u, 0u, 0u};
                    if (tau >= 0 && tau <= 15) { const LAS f32x4* kp = (const LAS f32x4*)(Kt + (tau * 16 + cout) * 16 + (kq & 1) * 8); const f32x4 a = kp[0], b2 = kp[1];
                        w.x = pk2(a[0], a[1]); w.y = pk2(a[2], a[3]); w.z = pk2(b2[0], b2[1]); w.w = pk2(b2[2], b2[3]); }
                    *(u32x4*)(TFb + (size_t)unit * 8192 + (size_t)pq * 8) = w; }
                for (int pq = tid; pq < 64 * 64; pq += NTHR) { const int fr = pq >> 6, l = pq & 63;
                    { const int mt = fr >> 3, j = fr & 7; const int kp = mt * 16 + (l & 15), n = kp >> 1, ri = kp & 1; const int kidx0 = j * 32 + (l >> 4) * 8, sidx = kidx0 >> 4, cin0 = kidx0 & 15;
                      const int e = dir == 0 ? 15 - sidx : sidx; const f32x2 pw = Pw[e * 64 + n]; const LAS f32x4* bp = (const LAS f32x4*)(Bb + n * 16 + cin0); float o[8];
#pragma unroll
                      for (int q = 0; q < 4; ++q) { const f32x4 b2 = bp[q];
                          o[2 * q] = ri ? (pw.x * b2[1] + pw.y * b2[0]) : (pw.x * b2[0] - pw.y * b2[1]); o[2 * q + 1] = ri ? (pw.x * b2[3] + pw.y * b2[2]) : (pw.x * b2[2] - pw.y * b2[3]); }
                      u32x4 w; w.x = pk2(o[0], o[1]); w.y = pk2(o[2], o[3]); w.z = pk2(o[4], o[5]); w.w = pk2(o[6], o[7]);
                      *(u32x4*)(SFb + (size_t)unit * 32768 + (size_t)pq * 8) = w; }
                    { const int t = fr >> 2, ks = fr & 3; const int cout = l & 15, n0 = (ks * 32 + (l >> 4) * 8) >> 1; const int e = dir == 0 ? t + 1 : 16 - t; float o[8];
#pragma unroll
                      for (int q = 0; q < 4; ++q) { const f32x2 c = Cc[(n0 + q) * 16 + cout], pw = Pw[e * 64 + n0 + q]; o[2 * q] = c.x * pw.x - c.y * pw.y; o[2 * q + 1] = -(c.x * pw.y + c.y * pw.x); }
                      u32x4 w; w.x = pk2(o[0], o[1]); w.y = pk2(o[2], o[3]); w.z = pk2(o[4], o[5]); w.w = pk2(o[6], o[7]);
                      *(u32x4*)(WFb + (size_t)unit * 32768 + (size_t)pq * 8) = w; } }
                if (tid < 128) { const f32x2 pw = Pw[16 * 64 + (tid >> 1)]; LAM16[unit * 128 + tid] = (tid & 1) ? pw.y : pw.x; }
                __syncthreads();
            }
        }
        __syncthreads();
        PT_SAMPLE(22);
        LAS float* sl = (LAS float*)(lds + LDS_STAGE);
        LAS float* red = (LAS float*)(lds + LDS_STAGE + 1024 * 20 * 4);
        for (int i = tid; i < 17 * 1024; i += NTHR) { const int row = i >> 10, k = i & 1023; const float v = (row < 16) ? in_c[row * 1024 + k] : in_cctx[k]; sl[k * 20 + row] = v / (1.0f + __expf(-v)); }
        __syncthreads();
        PT_SAMPLE(23);
        for (int rep_ = 0; rep_ < DUPN(14); ++rep_)
        for (int it = vcu; it < 4 * 96 && vcu < G - 128; it += G - 128) {
            const int l = it / 96, cb = it % 96, c4 = lane & 15, ksub = lane >> 4, kg = wave;
            f32x4 a[17];
#pragma unroll
            for (int r = 0; r < 17; ++r) a[r] = (f32x4){0.f, 0.f, 0.f, 0.f};
            const float* wp = w_mod + ((size_t)l * 1024 + kg * 128 + ksub) * 6144 + cb * 64 + c4 * 4;
            for (int s0_ = 0; s0_ < 32; s0_ += 16) {
                f32x4 wv[16];
#pragma unroll
                for (int q = 0; q < 16; ++q) wv[q] = *(const f32x4*)(wp + (size_t)((s0_ + q) * 4) * 6144);
#pragma unroll
                for (int q = 0; q < 16; ++q) { const f32x4 w = wv[q]; const LAS float* sp = sl + (kg * 128 + (s0_ + q) * 4 + ksub) * 20;
                    const f32x4 s0 = *(const LAS f32x4*)(sp), s1 = *(const LAS f32x4*)(sp + 4), s2 = *(const LAS f32x4*)(sp + 8), s3 = *(const LAS f32x4*)(sp + 12); const float s4 = sp[16];
                    a[0] += s0[0] * w; a[1] += s0[1] * w; a[2] += s0[2] * w; a[3] += s0[3] * w; a[4] += s1[0] * w; a[5] += s1[1] * w; a[6] += s1[2] * w; a[7] += s1[3] * w;
                    a[8] += s2[0] * w; a[9] += s2[1] * w; a[10] += s2[2] * w; a[11] += s2[3] * w; a[12] += s3[0] * w; a[13] += s3[1] * w; a[14] += s3[2] * w; a[15] += s3[3] * w; a[16] += s4 * w; }
            }
#pragma unroll
            for (int r = 0; r < 17; ++r)
#pragma unroll
                for (int j = 0; j < 4; ++j) { float v = a[r][j]; v += shx(v, 16, lane); v += shx(v, 32, lane); a[r][j] = v; }
            if (lane < 16) {
#pragma unroll
                for (int r = 0; r < 17; ++r)
#pragma unroll
                    for (int j = 0; j < 4; ++j) red[(kg * 64 + c4 * 4 + j) * 17 + r] = a[r][j]; }
            __syncthreads();
            for (int o = tid; o < 64 * 17; o += NTHR) { const int c2 = o / 17, r = o % 17; float s = 0.f;
#pragma unroll
                for (int g8 = 0; g8 < 8; ++g8) s += red[(g8 * 64 + c2) * 17 + r];
                MOD[((size_t)l * 17 + r) * 6144 + cb * 64 + c2] = s + b_mod[l * 6144 + cb * 64 + c2]; }
            __syncthreads();
        }
    }
    GRID_BARP(1);
    { PHASE_IDS(); PHASE_ARGS();
    const float* in_x = IN(0); const float* in_ctx = IN(2); const float* MOD = WSP(float, WS_MOD); unsigned char* H = WSP(unsigned char, WS_H8); unsigned short* X16 = WSP(unsigned short, WS_X);
    for (int row = gw; row < M; row += NGW) {
        const int b = row / TPB, t = row % TPB; const bool isctx = t < CTXL;
        const float* src = isctx ? in_ctx + ((size_t)b * CTXL + t) * DM : in_x + ((size_t)b * SEQ + (t - CTXL)) * DM;
        const float* mr = MOD + (size_t)(0 * 17 + (isctx ? 16 : b)) * 6144;
        f32x4 vq[4], shq[4], scq[4];
#pragma unroll
        for (int j = 0; j < 4; ++j) { const int col = 4 * lane + 256 * j; vq[j] = *(const f32x4*)(src + col); shq[j] = *(const f32x4*)(mr + col); scq[j] = *(const f32x4*)(mr + 1024 + col); }
#pragma unroll
        for (int j = 0; j < 4; ++j) { const int col = 4 * lane + 256 * j; const f32x4 v = vq[j];
            const f32x4 sh = shq[j], sc = scq[j]; const f32x4 h = v * (sc + 1.0f) + sh;
            *(unsigned*)(H + (size_t)row * DM + col) = pg8::pk4_fp8(h[0], h[1], h[2], h[3]);
            *(u32x2*)(X16 + (size_t)row * DM + col) = f32_to_h4(v); }
    } }
    GRID_BARP(2);

    for (int layer = 0; layer < DEPTH; ++layer) {
        const bool lastl = (layer == DEPTH - 1);
        const int li = layer >> 1;
        const bool even = (layer & 1) == 0;
#if !defined(NO_MIXER)
        if (even) {
            { PHASE_ARGS(); pg8::SchedDense S; S.nM = NPANEL; S.nN = 6; S.G = Gp; S.c = bxp; S.g = 0; S.A = (const char*)WSP(unsigned char, WS_H8); S.B = (const char*)(WSP(unsigned char, WS_WINAB) + (size_t)li * 1536 * 1024); S.a_tstep = (size_t)256 * 1024; S.b_tstep = (size_t)256 * 1024;
              pg8::EpiBf16U E; E.O = WSP(bf16_t, WS_PROJ); E.ldc = 1536; E.oscale = 1.0f / 64.0f; E.UT = WSP(bf16_t, WS_UT);
            for (int rep_ = 0; rep_ < DUPN(2); ++rep_)
              pg8::gemm_phase<pg8::EpiBf16U, pg8::SchedDense, false, true>(wave0, lds + LDS_STAGE, 1024, 1024, nullptr, S, E); }
            GRID_BARP(3);
            { PHASE_IDS(); PHASE_ARGS();
              bf16_t* PROJ = WSP(bf16_t, WS_PROJ); bf16_t* UT = WSP(bf16_t, WS_UT); const float* T32 = WSP(float, WS_ROPE);
              const float* gq = IN(16) + li * 128; const float* gk = IN(17) + li * 128;
              const int sub = lane & 15, half = sub >> 3, i0 = (sub & 7) * 4;
              const int colp[2] = {(lane >> 4) * 128 + half * 64 + i0, 512 + ((lane >> 4) & 1) * 128 + half * 64 + i0};
              f32x4 g1[2], g2[2];
#pragma unroll
              for (int pass = 0; pass < 2; ++pass) { const float* gg = (pass ? gk : gq) + half * 64 + i0; g1[pass] = *(const f32x4*)gg; g2[pass] = *(const f32x4*)(gg + 32); }
              for (int rb = gw * 3; rb < M; rb += NGW * 3) {
                u32x2 av[3][2], cv[3][2]; f32x4 tb[3][2];
#pragma unroll
                for (int r = 0; r < 3; ++r) { const bf16_t* pr = PROJ + (size_t)(rb + r) * 1536;
#pragma unroll
                    for (int pass = 0; pass < 2; ++pass) { av[r][pass] = *(const u32x2*)(pr + colp[pass]); cv[r][pass] = *(const u32x2*)(pr + colp[pass] + 32); }
                    { const int t_ = (rb + r) % TPB; const int pos_ = t_ < CTXL ? 0 : t_ - CTXL; const float* tp_ = T32 + ((half ? (pos_ & 63) : (pos_ >> 6)) * 32 + i0) * 2; tb[r][0] = *(const f32x4*)tp_; tb[r][1] = *(const f32x4*)(tp_ + 4); } }
#pragma unroll
                for (int r = 0; r < 3; ++r) { const int row = rb + r; const int b = row / TPB, t = row % TPB; const bool isctx = t < CTXL; const int pos = t - CTXL; const int ri = pos >> 6, ci = pos & 63;
                    bf16_t* pr = PROJ + (size_t)row * 1536;
#pragma unroll
                    for (int pass = 0; pass < 2; ++pass) {
                        const u32x2 a = av[r][pass], c2 = cv[r][pass];
                        float x1[4] = {bflo(a.x), bfhi(a.x), bflo(a.y), bfhi(a.y)}, x2[4] = {bflo(c2.x), bfhi(c2.x), bflo(c2.y), bfhi(c2.y)};
                        float ss = 0.f;
#pragma unroll
                        for (int i = 0; i < 4; ++i) ss += x1[i] * x1[i] + x2[i] * x2[i];
                        ss = row16_sum(ss);
                        const float rinv = 1.0f / sqrtf(ss * (1.0f / 128.0f) + 1e-6f);
#pragma unroll
                        for (int i = 0; i < 4; ++i) { x1[i] = x1[i] * rinv * g1[pass][i]; x2[i] = x2[i] * rinv * g2[pass][i]; }
                        if (!isctx) { const float tpv[8] = {tb[r][0][0], tb[r][0][1], tb[r][0][2], tb[r][0][3], tb[r][1][0], tb[r][1][1], tb[r][1][2], tb[r][1][3]};
#pragma unroll
                            for (int i = 0; i < 4; ++i) { const float cs = tpv[2 * i], sn = tpv[2 * i + 1]; const float o1 = x1[i] * cs - x2[i] * sn, o2 = x2[i] * cs + x1[i] * sn; x1[i] = o1; x2[i] = o2; } }
                        if (pass == 0 || lane < 32) { u32x2 w; w.x = pk2(x1[0], x1[1]); w.y = pk2(x1[2], x1[3]); *(u32x2*)(pr + colp[pass]) = w; w.x = pk2(x2[0], x2[1]); w.y = pk2(x2[2], x2[3]); *(u32x2*)(pr + colp[pass] + 32) = w; }
                    }
                }
              } }
            GRID_BARP(4);
            { PHASE_IDS(); PHASE_ARGS();
              const bf16_t* UT = WSP(bf16_t, WS_UT); const bf16_t* SFb = WSP(bf16_t, WS_SF); unsigned short* XS = WSP(unsigned short, WS_XS);
              for (int rep_ = 0; rep_ < DUPN(7); ++rep_)
              for (int unit = vcu; unit < 256; unit += G) {
                const int g = unit >> 3, r8 = unit & 7;
                bf16x8 sa[2][8];
#pragma unroll
                for (int d = 0; d < 2; ++d)
#pragma unroll
                    for (int j = 0; j < 8; ++j) sa[d][j] = *(const bf16x8*)(SFb + ((size_t)((li * 2 + d) * 32 + g) * 64 + wave * 8 + j) * 512 + lane * 8);
                const int b = lane & 15, kq = lane >> 4;
                for (int c = r8 * 18; c < r8 * 18 + 18; ++c) {
                    f32x4 a0 = (f32x4){0.f, 0.f, 0.f, 0.f}, a1 = a0; bf16x8 ub[8];
#pragma unroll
                    for (int j = 0; j < 8; ++j) ub[j] = *(const bf16x8*)(UT + (((size_t)g * TPB + c * 16 + 2 * j + (kq >> 1)) * 16 + b) * 16 + (kq & 1) * 8);
#pragma unroll
                    for (int j = 0; j < 8; ++j) { a0 = __builtin_amdgcn_mfma_f32_16x16x32_bf16(sa[0][j], ub[j], a0, 0, 0, 0); a1 = __builtin_amdgcn_mfma_f32_16x16x32_bf16(sa[1][j], ub[j], a1, 0, 0, 0); }
                    *(u32x2*)(XS + ((size_t)(g * 2 + 0) * 144 + c) * 2048 + b * 128 + wave * 16 + 4 * kq) = f32_to_h4(a0);
                    *(u32x2*)(XS + ((size_t)(g * 2 + 1) * 144 + c) * 2048 + b * 128 + wave * 16 + 4 * kq) = f32_to_h4(a1);
                }
              } }
            { PHASE_ARGS(); bf16_t* PROJ = WSP(bf16_t, WS_PROJ); unsigned char* OL8 = WSP(unsigned char, WS_OL);
              const float* w_exp_in = IN(11); const float* w_exp_out = IN(13); unsigned char* WexpIn = WSP(unsigned char, WS_WEXPIN); unsigned char* WexpOut = WSP(unsigned char, WS_WEXPOUT);
#define EXPERT_CONV() do { __syncthreads(); const int ln_ = lane_now(); LAS float* scr_ = (LAS float*)(lds + LDS_STAGE + wave0 * 16384); \
                expert_conv_run(w_exp_in, w_exp_out, WexpIn, WexpOut, layer, vcu * 96 + wave0, 12, scr_, ln_); __syncthreads(); } while (0)
              for (int rep_ = 0; rep_ < DUPN(3); ++rep_) {
              int it_ = 0; const int slot_ = (rep_ == 0) ? (vcu % 3) : 99;
              for (int u = vcu; u < 576; u += G, ++it_) {
                if (it_ == slot_) EXPERT_CONV();
                att::Unit U; int b, h, row0;
                if (u < 512) { b = u >> 5; h = (u >> 3) & 3; row0 = b * TPB + CTXL + (u & 7) * 256; U.NT = 36; } else { const int uc = u - 512; b = uc >> 2; h = uc & 3; row0 = b * TPB; U.NT = 4; }
                const bf16_t* kb = PROJ + (size_t)b * TPB * 1536;
                U.Q = PROJ + (size_t)row0 * 1536 + h * 128; U.ldq = 1536; U.K = kb + 512 + (h >> 1) * 128; U.ldk = 1536; U.KR = nullptr; U.ldkr = 0; U.V = kb + 768 + (h >> 1) * 128; U.ldv = 1536;
                U.O = OL8 + (size_t)row0 * 1024 + h * 128; U.ldo = 1024; U.kofs = 0; U.q0 = 0; U.sink = 0.f; U.has_sink = 0; U.rope = nullptr; U.rope_row = 0; U.rope_col_base = 0;
                att::attn_unit<128, false, 2, false>(U, (LAS char*)(lds + LDS_STAGE), wave0);
              }
              if (it_ <= slot_ && slot_ != 99) EXPERT_CONV(); } }
            GRID_BARP(5);
            { PHASE_IDS(); PHASE_ARGS();
              const unsigned short* XS = WSP(unsigned short, WS_XS); bf16_t* HIN = WSP(bf16_t, WS_HIN); const float* LAM16 = WSP(float, WS_LAM16);
              const int id = vcu * 256 + (tid & 255);
              for (int rep_ = 0; rep_ < DUPN(8); ++rep_)
              if (wave < 4) {
                const int n = id & 63, b = (id >> 6) & 15, gd = id >> 10, g = gd >> 1, dir = gd & 1;
                const f32x2 lam = *(const f32x2*)(LAM16 + ((li * 2 + dir) * 32 + g) * 128 + 2 * n);
                const unsigned short* xp = XS + (size_t)gd * 144 * 2048 + b * 128 + 2 * n;
                bf16_t* hp = HIN + (size_t)gd * 144 * 2048 + (((2 * n) >> 5) * 64 + (((2 * n) >> 3) & 3) * 16 + b) * 8 + ((2 * n) & 7);
                float hr = 0.f, hi2 = 0.f;
#define S5B_CC(st) (dir == 0 ? (st) : ((st) < 16 ? 15 - (st) : 159 - (st)))
#define S5B_LOAD(buf, s1) do { _Pragma("unroll") for (int q = 0; q < 12; ++q) buf[q] = *(const unsigned*)(xp + (size_t)S5B_CC((s1) + q) * 2048); } while (0)
#define S5B_USE(buf, s1) do { _Pragma("unroll") for (int q = 0; q < 12; ++q) { *(unsigned*)(hp + (size_t)S5B_CC((s1) + q) * 2048) = pk2(hr, hi2); \
                        const float nr = lam.x * hr - lam.y * hi2 + h2f((unsigned short)(buf[q] & 0xffffu)), ni = lam.x * hi2 + lam.y * hr + h2f((unsigned short)(buf[q] >> 16)); hr = nr; hi2 = ni; } } while (0)
                unsigned xa[12], xb[12];
                S5B_LOAD(xa, 0); S5B_LOAD(xb, 12);
                for (int s0 = 0; s0 < 144; s0 += 24) {
                    S5B_USE(xa, s0); if (s0 + 24 < 144) S5B_LOAD(xa, s0 + 24);
                    S5B_USE(xb, s0 + 12); if (s0 + 36 < 144) S5B_LOAD(xb, s0 + 36);
                }
#undef S5B_CC
#undef S5B_LOAD
#undef S5B_USE
              } }
            GRID_BARP(6);
            { PHASE_IDS(); PHASE_ARGS();
              const bf16_t* UT = WSP(bf16_t, WS_UT); const bf16_t* TFb = WSP(bf16_t, WS_TF); const bf16_t* WFb = WSP(bf16_t, WS_WF); const bf16_t* HIN = WSP(bf16_t, WS_HIN);
              const bf16_t* PROJ = WSP(bf16_t, WS_PROJ); bf16_t* ZG = WSP(bf16_t, WS_ZG); const float* s5d = IN(25) + li * 512;
              LAS unsigned char* tfl = lds + LDS_STAGE;
              for (int rep_ = 0; rep_ < DUPN(9); ++rep_)
              for (int unit = vcu; unit < 256; unit += G) {
                const int g = unit >> 3, r8 = unit & 7;
                __syncthreads();
                for (int i = tid; i < 2048; i += NTHR) { const int d = i >> 10, q = i & 1023; *(LAS u32x4*)(tfl + (size_t)i * 16) = *(const u32x4*)(TFb + (size_t)((li * 2 + d) * 32 + g) * 8192 + q * 8); }
                bf16x8 wf[2][2][4];
#pragma unroll
                for (int d = 0; d < 2; ++d)
#pragma unroll
                    for (int tt = 0; tt < 2; ++tt)
#pragma unroll
                        for (int ks = 0; ks < 4; ++ks) wf[d][tt][ks] = *(const bf16x8*)(WFb + ((size_t)((li * 2 + d) * 32 + g) * 64 + (2 * wave + tt) * 4 + ks) * 512 + lane * 8);
                __syncthreads();
                const int b = lane & 15, kq = lane >> 4;
                const f32x4 dsk = *(const f32x4*)(s5d + g * 16 + 4 * kq);
                for (int c = r8 * 18; c < r8 * 18 + 18; ++c) {
                    f32x4 a0 = (f32x4){0.f, 0.f, 0.f, 0.f}, a1 = a0; bf16x8 hbv[2][4], ubv[8]; u32x2 uwv[2];
#pragma unroll
                    for (int d = 0; d < 2; ++d)
#pragma unroll
                        for (int ks = 0; ks < 4; ++ks) hbv[d][ks] = *(const bf16x8*)(HIN + ((size_t)(g * 2 + d) * 144 + c) * 2048 + (ks * 64 + lane) * 8);
#pragma unroll
                    for (int j = 0; j < 8; ++j) ubv[j] = *(const bf16x8*)(UT + (((size_t)g * TPB + c * 16 + 2 * j + (kq >> 1)) * 16 + b) * 16 + (kq & 1) * 8);
#pragma unroll
                    for (int tt = 0; tt < 2; ++tt) uwv[tt] = *(const u32x2*)(UT + (((size_t)g * TPB + c * 16 + 2 * wave + tt) * 16 + b) * 16 + 4 * kq);
#pragma unroll
                    for (int d = 0; d < 2; ++d)
#pragma unroll
                        for (int ks = 0; ks < 4; ++ks) { const bf16x8 hb = hbv[d][ks];
                            a0 = __builtin_amdgcn_mfma_f32_16x16x32_bf16(wf[d][0][ks], hb, a0, 0, 0, 0); a1 = __builtin_amdgcn_mfma_f32_16x16x32_bf16(wf[d][1][ks], hb, a1, 0, 0, 0); }
#pragma unroll
                    for (int j = 0; j < 8; ++j) { const bf16x8 ub = ubv[j];
                        if (j <= wave) { const bf16x8 t0 = *(const LAS bf16x8*)(tfl + ((2 * wave - 2 * j) * 64 + lane) * 16), t1 = *(const LAS bf16x8*)(tfl + ((2 * wave + 1 - 2 * j) * 64 + lane) * 16);
                            a0 = __builtin_amdgcn_mfma_f32_16x16x32_bf16(t0, ub, a0, 0, 0, 0); a1 = __builtin_amdgcn_mfma_f32_16x16x32_bf16(t1, ub, a1, 0, 0, 0); }
                        if (j >= wave) { const bf16x8 t0 = *(const LAS bf16x8*)(tfl + ((16 + 2 * j - 2 * wave + 1) * 64 + lane) * 16), t1 = *(const LAS bf16x8*)(tfl + ((16 + 2 * j - 2 * wave) * 64 + lane) * 16);
                            a0 = __builtin_amdgcn_mfma_f32_16x16x32_bf16(t0, ub, a0, 0, 0, 0); a1 = __builtin_amdgcn_mfma_f32_16x16x32_bf16(t1, ub, a1, 0, 0, 0); } }
#pragma unroll
                    for (int tt = 0; tt < 2; ++tt) { const size_t row = (size_t)b * TPB + c * 16 + 2 * wave + tt; const f32x4 av = tt ? a1 : a0;
                        const u32x2 uw = uwv[tt]; const float uu[4] = {bflo(uw.x), bfhi(uw.x), bflo(uw.y), bfhi(uw.y)}; float z[4];
#pragma unroll
                        for (int i = 0; i < 4; ++i) { const float y = av[i] + dsk[i] * uu[i]; const float a = 0.7978845608028654f * (y + 0.044715f * y * y * y);
                            const float th = 1.0f - 2.0f * __builtin_amdgcn_rcpf(1.0f + __expf(2.0f * a)); z[i] = 0.5f * y * (1.0f + th); }
                        u32x2 w; w.x = pk2(z[0], z[1]); w.y = pk2(z[2], z[3]); *(u32x2*)(ZG + row * 512 + g * 16 + 4 * kq) = w; }
                }
              } }
            GRID_BARP(7);
            { PHASE_ARGS(); pg8::SchedDense S; S.nM = NPANEL; S.nN = 2; S.G = Gp; S.c = bxp; S.g = 0; S.A = (const char*)WSP(bf16_t, WS_ZG); S.B = (const char*)(WSP(bf16_t, WS_WGLU) + (size_t)li * 512 * 512); S.a_tstep = (size_t)256 * 512 * 2; S.b_tstep = (size_t)256 * 512 * 2;
              pg8::EpiGlu E; E.ZG = WSP(bf16_t, WS_ZG); E.bias = IN(27) + li * 512; E.OL = WSP(unsigned char, WS_OL);
            for (int rep_ = 0; rep_ < DUPN(10); ++rep_)
              pg8::gemm_phase<pg8::EpiGlu, pg8::SchedDense, false, false>(wave0, lds + LDS_STAGE, 1024, 1024, nullptr, S, E); }
            GRID_BARP(8);
        } else {
#if !defined(NO_ODD)
            { PHASE_ARGS(); pg8::SchedDense S; S.nM = NPANEL; S.nN = 7; S.G = Gp; S.c = bxp; S.g = 0; S.A = (const char*)WSP(unsigned char, WS_H8); S.B = (const char*)(WSP(unsigned char, WS_WINCD) + (size_t)li * 1792 * 1024); S.a_tstep = (size_t)256 * 1024; S.b_tstep = (size_t)256 * 1024;
              pg8::EpiBf16 E; E.O = WSP(bf16_t, WS_PROJ); E.ldc = 1792; E.oscale = 1.0f / 64.0f;
            for (int rep_ = 0; rep_ < DUPN(2); ++rep_)
              pg8::gemm_phase<pg8::EpiBf16, pg8::SchedDense, false, true>(wave0, lds + LDS_STAGE, 1024, 1024, nullptr, S, E); }
            GRID_BARP(9);
            { PHASE_IDS(); PHASE_ARGS();
              bf16_t* PROJ = WSP(bf16_t, WS_PROJ); const float* T32 = WSP(float, WS_ROPE); const float* T16 = T32 + 64 * 32 * 2;
              const float* gq = IN(29) + li * 256; const float* gkv = IN(30) + li * 256;
              const f32x4 gq4 = *(const f32x4*)(gq + lane * 4), gkv4 = *(const f32x4*)(gkv + lane * 4);
              const int sub = lane & 15, half = sub >> 3, i0 = (sub & 7) * 4;
              const int colp[2] = {576 + (lane >> 4) * 128 + half * 64 + i0, 1088 + ((lane >> 4) & 1) * 128 + half * 64 + i0};
              const int kh = (lane >> 4) & 1, ki = lane & 15, kcol = 512 + kh * 32 + ki;
              for (int rb = gw * 3; rb < M; rb += NGW * 3) {
                u32x2 nv[3][2], av[3][2], cv[3][2]; unsigned short kr[3][2]; f32x4 tb[3][2]; f32x2 tk[3];
#pragma unroll
                for (int r = 0; r < 3; ++r) { const bf16_t* pr = PROJ + (size_t)(rb + r) * 1792;
#pragma unroll
                    for (int pass = 0; pass < 2; ++pass) { nv[r][pass] = *(const u32x2*)(pr + pass * 256 + lane * 4); av[r][pass] = *(const u32x2*)(pr + colp[pass]); cv[r][pass] = *(const u32x2*)(pr + colp[pass] + 32); }
                    kr[r][0] = pr[kcol]; kr[r][1] = pr[kcol + 16];
                    { const int t_ = (rb + r) % TPB; const int pos_ = t_ < CTXL ? 0 : t_ - CTXL; const float* tp_ = T32 + ((half ? (pos_ & 63) : (pos_ >> 6)) * 32 + i0) * 2; tb[r][0] = *(const f32x4*)tp_; tb[r][1] = *(const f32x4*)(tp_ + 4);
                      tk[r] = *(const f32x2*)(T16 + ((kh ? (pos_ & 63) : (pos_ >> 6)) * 16 + ki) * 2); } }
#pragma unroll
                for (int r = 0; r < 3; ++r) { const int row = rb + r; const int t = row % TPB; const bool isctx = t < CTXL; const int pos = t - CTXL; const int ri = pos >> 6, ci = pos & 63;
                    bf16_t* pr = PROJ + (size_t)row * 1792;
#pragma unroll
                    for (int pass = 0; pass < 2; ++pass) { const u32x2 a = nv[r][pass];
                        float x[4] = {bflo(a.x), bfhi(a.x), bflo(a.y), bfhi(a.y)}; const float ss = wave_sum(x[0] * x[0] + x[1] * x[1] + x[2] * x[2] + x[3] * x[3], lane);
                        const float rinv = 1.0f / sqrtf(ss * (1.0f / 256.0f) + 1e-6f); const f32x4 g4 = pass ? gkv4 : gq4;
                        u32x2 w; w.x = pk2(x[0] * rinv * g4[0], x[1] * rinv * g4[1]); w.y = pk2(x[2] * rinv * g4[2], x[3] * rinv * g4[3]); *(u32x2*)(pr + pass * 256 + lane * 4) = w; }
                    if (!isctx) {
                        if (lane < 32) { const float a = bf2f(kr[r][0]), c2 = bf2f(kr[r][1]);
                            const float cs = tk[r][0], sn = tk[r][1];
                            pr[kcol] = (bf16_t)f2bf(a * cs - c2 * sn); pr[kcol + 16] = (bf16_t)f2bf(c2 * cs + a * sn); }
#pragma unroll
                        for (int pass = 0; pass < 2; ++pass) {
                            const u32x2 a = av[r][pass], c2 = cv[r][pass];
                            float x1[4] = {bflo(a.x), bfhi(a.x), bflo(a.y), bfhi(a.y)}, x2[4] = {bflo(c2.x), bfhi(c2.x), bflo(c2.y), bfhi(c2.y)};
                            const float tpv[8] = {tb[r][0][0], tb[r][0][1], tb[r][0][2], tb[r][0][3], tb[r][1][0], tb[r][1][1], tb[r][1][2], tb[r][1][3]};
#pragma unroll
                            for (int i = 0; i < 4; ++i) { const float cs = tpv[2 * i], sn = tpv[2 * i + 1]; const float o1 = x1[i] * cs - x2[i] * sn, o2 = x2[i] * cs + x1[i] * sn; x1[i] = o1; x2[i] = o2; }
                            if (pass == 0 || lane < 32) { u32x2 w; w.x = pk2(x1[0], x1[1]); w.y = pk2(x1[2], x1[3]); *(u32x2*)(pr + colp[pass]) = w; w.x = pk2(x2[0], x2[1]); w.y = pk2(x2[2], x2[3]); *(u32x2*)(pr + colp[pass] + 32) = w; }
                        }
                    }
                }
              } }
            GRID_BARP(10);
            { PHASE_ARGS(); bf16_t* PROJ = WSP(bf16_t, WS_PROJ); pg8::SchedDual S; S.nM = NPANEL; S.nN0 = 3; S.nN1 = 4; S.G = Gp; S.c = vcup; S.A0 = (const char*)PROJ; S.A1 = (const char*)(PROJ + 256);
              S.B0 = (const char*)(WSP(bf16_t, WS_WUQ) + (size_t)li * 768 * 256); S.B1 = (const char*)(WSP(bf16_t, WS_WUKV) + (size_t)li * 1024 * 256); S.a_tstep = (size_t)256 * 1792 * 2; S.b_tstep = (size_t)256 * 256 * 2;
              pg8::EpiBf16Dual E; E.O0 = WSP(bf16_t, WS_QM); E.ldc0 = 768; E.O1 = WSP(bf16_t, WS_KVM); E.ldc1 = 1024;
            for (int rep_ = 0; rep_ < DUPN(11); ++rep_)
              pg8::gemm_phase<pg8::EpiBf16Dual, pg8::SchedDual, false, false>(wave0, lds + LDS_STAGE, 512, 3584, nullptr, S, E); }
            GRID_BARP(11);
            { PHASE_ARGS(); bf16_t* PROJ = WSP(bf16_t, WS_PROJ); unsigned char* OL8 = WSP(unsigned char, WS_OL); bf16_t* QM = WSP(bf16_t, WS_QM); bf16_t* KVM = WSP(bf16_t, WS_KVM); const float* T16 = WSP(float, WS_ROPE) + 64 * 32 * 2; const float* d_sink = IN(33);
              const float* w_exp_in = IN(11); const float* w_exp_out = IN(13); unsigned char* WexpIn = WSP(unsigned char, WS_WEXPIN); unsigned char* WexpOut = WSP(unsigned char, WS_WEXPOUT);
              for (int rep_ = 0; rep_ < DUPN(3); ++rep_) {
              int it_ = 0; const int slot_ = (rep_ == 0) ? (vcu & 3) : 99;
              for (int u = vcu; u < (lastl ? 1024 : 1152); u += G, ++it_) {
                if (it_ == slot_) EXPERT_CONV();
                att::Unit U; int b, h, row0, qb; bool mla, ctxq;
                if (u < 512) { mla = true; ctxq = false; b = u >> 5; h = (u >> 3) & 3; qb = u & 7; }
                else if (u < 1024) { const int v2 = u - 512; mla = false; ctxq = false; b = v2 >> 5; h = (v2 >> 3) & 3; qb = v2 & 7; }
                else { const int v2 = u - 1024; mla = (v2 < 64); ctxq = true; b = (v2 & 63) >> 2; h = v2 & 3; qb = 0; }
                row0 = b * TPB + (ctxq ? 0 : CTXL + qb * 256);
                const int q0 = qb * 256;
                if (mla) {
                    const bf16_t* kvb = KVM + (size_t)b * TPB * 1024;
                    U.Q = QM + (size_t)row0 * 768 + h * 192; U.ldq = 768; U.K = kvb + h * 256; U.ldk = 1024; U.KR = PROJ + (size_t)b * TPB * 1792 + 512; U.ldkr = 1792; U.V = kvb + h * 256 + 128; U.ldv = 1024;
                    U.O = OL8 + (size_t)row0 * 1024 + h * 128; U.ldo = 1024; U.NT = ctxq ? 4 : 36; U.kofs = 0; U.q0 = q0; U.sink = 0.f; U.has_sink = 0; U.rope = ctxq ? nullptr : T16; U.rope_row = 0; U.rope_col_base = 0;
                    att::attn_unit<192, false, 1, true>(U, (LAS char*)(lds + LDS_STAGE), wave0);
                } else {
                    const bf16_t* kb = PROJ + (size_t)b * TPB * 1792;
                    const int kstart = (q0 - 128) < 0 ? 0 : (q0 - 128), kend = (q0 + 384) > SEQ ? SEQ : (q0 + 384);
                    U.Q = PROJ + (size_t)row0 * 1792 + 576 + h * 128; U.ldq = 1792; U.K = kb + 1088 + (h >> 1) * 128; U.ldk = 1792; U.KR = nullptr; U.ldkr = 0; U.V = kb + 1344 + (h >> 1) * 128; U.ldv = 1792;
                    U.O = OL8 + (size_t)row0 * 1024 + 512 + h * 128; U.ldo = 1024; U.NT = ctxq ? 4 : 4 + (kend - kstart) / 64; U.kofs = kstart; U.q0 = q0; U.sink = d_sink[li * 4 + h]; U.has_sink = 1; U.rope = nullptr; U.rope_row = 0; U.rope_col_base = 0;
                    att::attn_unit<128, true, 2, false>(U, (LAS char*)(lds + LDS_STAGE), wave0);
                }
              }
              if (it_ <= slot_ && slot_ != 99) EXPERT_CONV(); } }
            GRID_BARP(12);
#endif
        }
        const bool has_mix = even
#if !defined(NO_ODD)
            || true
#endif
            ;
        if (has_mix) {
            { PHASE_ARGS(); pg8::SchedDense S; S.nM = lastl ? 128 : NPANEL; S.latent_only = lastl ? 1 : 0; S.nN = 4; S.G = Gp; S.c = bxp; S.g = 0; S.A = (const char*)WSP(unsigned char, WS_OL); S.B = (const char*)(WSP(unsigned char, WS_WMIX) + (size_t)layer * 1024 * 1024); S.a_tstep = (size_t)256 * 1024; S.b_tstep = (size_t)256 * 1024;
              pg8::EpiFp8P16 E; E.O = WSP(unsigned char, WS_Y); E.ldc = 1024; E.oscale = 64.0f / (16.0f * 64.0f);
            for (int rep_ = 0; rep_ < DUPN(6); ++rep_)
              pg8::gemm_phase<pg8::EpiFp8P16, pg8::SchedDense, false, true, false, true>(wave0, lds + LDS_STAGE, 1024, 1024, nullptr, S, E); }
            GRID_BARP(13);
        }
#else
        const bool has_mix = false;
#endif
        {
            PHASE_IDS(); PHASE_ARGS();
            const float* ln_g = IN(6); const float* ln_b = IN(7); const float* b_router = IN(10);
            const float* MOD = WSP(float, WS_MOD); const unsigned short* X16 = WSP(unsigned short, WS_X); const float* in_x = IN(0); const float* in_ctx = IN(2); unsigned char* H8 = WSP(unsigned char, WS_H8); const unsigned char* Y = WSP(unsigned char, WS_Y);
            int* slot_tok = WSP(int, WS_SLOTTOK); float* slot_gate = WSP(float, WS_SLOTGATE); int* tok_pos = WSP(int, WS_TOKPOS); unsigned* ctl = WSP(unsigned, WS_CTL);
            const bf16_t* WRF = WSP(bf16_t, WS_WRF) + (size_t)layer * (2 * 2 * 32 * 512);
            LAS bf16_t* HT1 = (LAS bf16_t*)(lds + LDS_STAGE); LAS bf16_t* HT2 = HT1 + 16 * 1032;
            LAS float* PART = (LAS float*)(lds + LDS_STAGE + 2 * 16 * 1032 * 2);
            LAS int* hist = (LAS int*)(lds + LDS_MISC + 64);
            LAS int* basel = (LAS int*)(lds + LDS_MISC + 64 + 128);
            LAS int* ent = (LAS int*)(lds + LDS_MISC + 512);
            if (tid < 32) hist[tid] = 0;
            __syncthreads();
            const float* g1 = ln_g + (size_t)(layer * 2 + 0) * 1024; const float* b1 = ln_b + (size_t)(layer * 2 + 0) * 1024;
            const int rows_per_wg = M / G;
            const int rbase = vcu * rows_per_wg;
            for (int rep_ = 0; rep_ < DUPN(12); ++rep_) {
            if (rep_ > 0) { __syncthreads(); if (tid < 32) hist[tid] = 0; __syncthreads(); }
            const int NG = rows_per_wg / 16;
#define LN1_VALID(gq) (!(lastl && (((rbase + (gq) * 16) % TPB) < CTXL)))
#define LN1_LOAD(gq, vv, yy) do { _Pragma("unroll") for (int rr = 0; rr < 2; ++rr) { const size_t row_ = (size_t)(rbase + (gq) * 16 + 2 * wave + rr); \
                _Pragma("unroll") for (int j = 0; j < 4; ++j) { xh[rr][j] = *(const u32x2*)(X16 + row_ * DM + 4 * lane + 256 * j); } \
                _Pragma("unroll") for (int j = 0; j < 4; ++j) { const int col_ = 4 * lane + 256 * j; if (has_mix) yy[rr][j] = *(const unsigned*)(Y + row_ * DM + col_); } } } while (0)
            { LAS float* gl_ = (LAS float*)(lds + LDS_STAGE + 98304) + 3072; for (int i = tid; i < 512; i += NTHR) { const float* sp_ = (i < 256) ? g1 + 4 * i : b1 + 4 * (i - 256); *(LAS f32x4*)(gl_ + 4 * i) = *(const f32x4*)sp_; } }
            const float brv = b_router[layer * 32 + (lane & 31)];
            bf16x8 wrf[4][4];
#pragma unroll
            for (int s4 = 0; s4 < 4; ++s4) { const int s = 4 * wave + s4;
                wrf[s4][0] = *(const bf16x8*)(WRF + ((size_t)(0 * 2 + 0) * 32 + s) * 512 + lane * 8); wrf[s4][1] = *(const bf16x8*)(WRF + ((size_t)(0 * 2 + 1) * 32 + s) * 512 + lane * 8);
                wrf[s4][2] = *(const bf16x8*)(WRF + ((size_t)(1 * 2 + 0) * 32 + s) * 512 + lane * 8); wrf[s4][3] = *(const bf16x8*)(WRF + ((size_t)(1 * 2 + 1) * 32 + s) * 512 + lane * 8); }
            int grp = 0; while (grp < NG && !LN1_VALID(grp)) ++grp;
            f32x4 v[2][4]; unsigned yv[2][4]; u32x2 xh[2][4];
#pragma unroll
            for (int rr = 0; rr < 2; ++rr)
#pragma unroll
                for (int j = 0; j < 4; ++j) { v[rr][j] = (f32x4){0.f, 0.f, 0.f, 0.f}; yv[rr][j] = 0u; xh[rr][j] = (u32x2){0u, 0u}; }
            if (grp < NG) LN1_LOAD(grp, v, yv);
            LAS float* MODL = (LAS float*)(lds + LDS_STAGE + 98304);
            int mod_kind = -1;
            while (grp < NG) {
                int gnx = grp + 1; while (gnx < NG && !LN1_VALID(gnx)) ++gnx;
                const int r0 = rbase + grp * 16; const int b = r0 / TPB; const bool isctx = (r0 % TPB) < CTXL;
                if (mod_kind != (isctx ? 1 : 0)) { mod_kind = isctx ? 1 : 0;
                    const float* mr = MOD + (size_t)(layer * 17 + (isctx ? 16 : b)) * 6144 + 2048;
                    __syncthreads();
                    for (int i = tid; i < 768; i += NTHR) *(LAS f32x4*)(MODL + 4 * i) = *(const f32x4*)(mr + 4 * i);
                    __syncthreads(); }
                f32x4 gtv[4], shv[4], scv[4];
#pragma unroll
                for (int j = 0; j < 4; ++j) { const int col = 4 * lane + 256 * j; gtv[j] = *(const LAS f32x4*)(MODL + col); shv[j] = *(const LAS f32x4*)(MODL + 1024 + col); scv[j] = *(const LAS f32x4*)(MODL + 2048 + col); }
#pragma unroll
                for (int rr = 0; rr < 2; ++rr)
#pragma unroll
                    for (int j = 0; j < 4; ++j) { v[rr][j] = h4_to_f32(xh[rr][j].x, xh[rr][j].y) * ALPHA;
                        if (has_mix) { const int yw = (int)yv[rr][j]; const f32x4 gt = gtv[j] * (1.0f / 64.0f);
                            const f32x2 ylo = __builtin_amdgcn_cvt_pk_f32_fp8(yw, false), yhi = __builtin_amdgcn_cvt_pk_f32_fp8(yw, true);
                            v[rr][j][0] += gt[0] * ylo[0]; v[rr][j][1] += gt[1] * ylo[1]; v[rr][j][2] += gt[2] * yhi[0]; v[rr][j][3] += gt[3] * yhi[1]; } }
                if (gnx < NG) LN1_LOAD(gnx, v, yv);
#pragma unroll
                for (int rr = 0; rr < 2; ++rr) { const size_t row = (size_t)(r0 + 2 * wave + rr); float s = 0.f;
#pragma unroll
                    for (int j = 0; j < 4; ++j) s += (v[rr][j][0] + v[rr][j][1]) + (v[rr][j][2] + v[rr][j][3]);
                    const float mean = wave_sum(s, lane) * (1.f / DM); float s2 = 0.f;
#pragma unroll
                    for (int j = 0; j < 4; ++j) { v[rr][j] = v[rr][j] - mean; s2 += (v[rr][j][0] * v[rr][j][0] + v[rr][j][1] * v[rr][j][1]) + (v[rr][j][2] * v[rr][j][2] + v[rr][j][3] * v[rr][j][3]); }
                    const float rstd = 1.f / sqrtf(wave_sum(s2, lane) * (1.f / DM) + LN_EPS);
#pragma unroll
                    for (int j = 0; j < 4; ++j) { const int col = 4 * lane + 256 * j; const f32x4 gg = *(const LAS f32x4*)(MODL + 3072 + col), bb = *(const LAS f32x4*)(MODL + 4096 + col);
                        const f32x4 xn = v[rr][j] * rstd * gg + bb;
                        const f32x4 sh = shv[j], sc = scv[j]; const f32x4 hv = xn * (sc + 1.0f) + sh;
                        *(unsigned*)(H8 + row * DM + col) = pg8::pk4_fp8(hv[0], hv[1], hv[2], hv[3]);
                        const unsigned h01 = pk2(hv[0], hv[1]), h23 = pk2(hv[2], hv[3]);
                        const unsigned l01 = pk2(hv[0] - bflo(h01), hv[1] - bfhi(h01)), l23 = pk2(hv[2] - bflo(h23), hv[3] - bfhi(h23));
                        *(LAS u32x2*)(HT1 + (2 * wave + rr) * 1032 + col) = (u32x2){h01, h23}; *(LAS u32x2*)(HT2 + (2 * wave + rr) * 1032 + col) = (u32x2){l01, l23}; } }
                __syncthreads();
                { f32x4 a0 = (f32x4){0.f, 0.f, 0.f, 0.f}, a1 = a0;
#pragma unroll
                  for (int s4 = 0; s4 < 4; ++s4) { const int s = 4 * wave + s4;
                    const bf16x8 h1 = *(const LAS bf16x8*)(HT1 + (lane & 15) * 1032 + 32 * s + 8 * (lane >> 4)), h2 = *(const LAS bf16x8*)(HT2 + (lane & 15) * 1032 + 32 * s + 8 * (lane >> 4));
                    const bf16x8 w10 = wrf[s4][0], w11 = wrf[s4][1], w20 = wrf[s4][2], w21 = wrf[s4][3];
                    a0 = __builtin_amdgcn_mfma_f32_16x16x32_bf16(h1, w10, a0, 0, 0, 0); a0 = __builtin_amdgcn_mfma_f32_16x16x32_bf16(h1, w20, a0, 0, 0, 0); a0 = __builtin_amdgcn_mfma_f32_16x16x32_bf16(h2, w10, a0, 0, 0, 0);
                    a1 = __builtin_amdgcn_mfma_f32_16x16x32_bf16(h1, w11, a1, 0, 0, 0); a1 = __builtin_amdgcn_mfma_f32_16x16x32_bf16(h1, w21, a1, 0, 0, 0); a1 = __builtin_amdgcn_mfma_f32_16x16x32_bf16(h2, w11, a1, 0, 0, 0); }
#pragma unroll
                  for (int i = 0; i < 4; ++i) { PART[wave * 512 + (4 * (lane >> 4) + i) * 32 + (lane & 15)] = a0[i]; PART[wave * 512 + (4 * (lane >> 4) + i) * 32 + 16 + (lane & 15)] = a1[i]; } }
                __syncthreads();
                { const int half = lane >> 5, my_e = lane & 31, rloc = 2 * wave + half;
                  float lg = brv;
#pragma unroll
                  for (int w8 = 0; w8 < 8; ++w8) lg += PART[w8 * 512 + rloc * 32 + my_e];
                  float tv[4]; int te[4];
#pragma unroll
                  for (int k = 0; k < 4; ++k) { float mx = lg;
                    mx = row16_max(mx); mx = fmaxf(mx, shx(mx, 16, lane));
                    const unsigned long long bal = __ballot(lg == mx); const unsigned m32 = (unsigned)(bal >> (32 * half)); const int e = __ffs((int)m32) - 1;
                    tv[k] = mx; te[k] = e; if (my_e == e) lg = -3.0e38f; }
                  const float e1 = __expf(tv[1] - tv[0]), e2 = __expf(tv[2] - tv[0]), e3 = __expf(tv[3] - tv[0]); const float inv = 1.0f / (1.0f + e1 + e2 + e3);
                  if (my_e < 4) { const int e = my_e == 0 ? te[0] : my_e == 1 ? te[1] : my_e == 2 ? te[2] : te[3]; const float gt = (my_e == 0 ? 1.0f : my_e == 1 ? e1 : my_e == 2 ? e2 : e3) * inv;
                    const int lr = __hip_atomic_fetch_add(hist + e, 1, __ATOMIC_RELAXED, __HIP_MEMORY_SCOPE_WORKGROUP);
                    LAS int* en = ent + ((grp * 16 + rloc) * 4 + my_e) * 3; en[0] = e; en[1] = lr; en[2] = __builtin_bit_cast(int, gt); } }
                grp = gnx;
            } }
#undef LN1_VALID
#undef LN1_LOAD
            __syncthreads();
            if (tid < 32) { const int hc = hist[tid]; basel[tid] = hc ? (int)__hip_atomic_fetch_add(ctl + CW_CURSOR + layer * 32 + tid, (unsigned)hc, __ATOMIC_RELAXED, __HIP_MEMORY_SCOPE_AGENT) : 0; }
            __syncthreads();
            for (int i = tid; i < rows_per_wg * 4; i += NTHR) { const int rl = i >> 2; const int row = rbase + rl; const bool isctx = (row % TPB) < CTXL; if (lastl && isctx) continue;
                const LAS int* en = ent + i * 3; const int e = en[0]; const int pos = e * CAP + basel[e] + en[1];
                slot_tok[pos] = row; slot_gate[pos] = __builtin_bit_cast(float, en[2]); tok_pos[row * 4 + (i & 3)] = pos; }
        }
        GRID_BARP(14);
        LAS int* tb_bb = (LAS int*)(lds + LDS_MISC + 64);
        LAS int* tb_cnt = (LAS int*)(lds + LDS_MISC + 64 + 256);
        if (wave0 == 0) { PHASE_ARGS(); unsigned* ctl = WSP(unsigned, WS_CTL); const int ln = lane_now();
            const int c = (ln < 32) ? (int)__hip_atomic_load(ctl + CW_CURSOR + layer * 32 + ln, __ATOMIC_RELAXED, __HIP_MEMORY_SCOPE_AGENT) : 0;
            int incl = (c + 255) >> 8;
#pragma unroll
            for (int o = 1; o < 32; o <<= 1) { const int t = __builtin_amdgcn_ds_bpermute(((ln - o) & 63) << 2, incl); if ((ln & 31) >= o) incl += t; }
            if (ln < 32) { tb_cnt[ln] = c; tb_bb[ln] = incl - ((c + 255) >> 8); if (ln == 31) tb_bb[32] = incl; } }
        __syncthreads();
        LAS int* tb_be = (LAS int*)(lds + LDS_MISC + 512);
        { PHASE_IDS(); const int nblk = tb_bb[32];
#pragma clang loop vectorize(disable) unroll(disable)
          for (int i = tid; i < nblk; i += NTHR) { int e = 0;
#pragma unroll
            for (int j = 1; j < 32; ++j) e += (i >= tb_bb[j]) ? 1 : 0;
            tb_be[i] = e; } }
        __syncthreads();
        LAS unsigned char* side_buf = lds + LDS_MISC + 4096;
        {
            PHASE_ARGS(); pg8::SchedMoE S; S.bb = tb_bb; S.cnt = tb_cnt; S.be = tb_be; S.NT = 8; S.G = Gp; S.c = vcup; S.Acompact = nullptr; S.a_tstep = 0;
            S.bias = IN(12) + (size_t)layer * 32 * 2048; S.bias_estride = 2048; S.bias_pnstep = 128; S.bias_seg1 = 1024;
            const int* slot_tok = WSP(int, WS_SLOTTOK); const float* slot_gate = WSP(float, WS_SLOTGATE);
            S.W = (const char*)(WSP(unsigned char, WS_WEXPIN) + (size_t)layer * 32 * 2048 * 1024); S.w_estep = (size_t)2048 * 1024; S.w_tstep = (size_t)256 * 1024; S.slot_tok = slot_tok; S.slot_gate = slot_gate;
            pg8::EpiSwiglu E; E.Z = WSP(unsigned char, WS_Z); E.bias = IN(12) + (size_t)layer * 32 * 2048;
            for (int rep_ = 0; rep_ < DUPN(4); ++rep_)
            pg8::gemm_phase<pg8::EpiSwiglu, pg8::SchedMoE, true, true, true>(wave0, lds + LDS_STAGE, 1024, 1024, (const char*)WSP(unsigned char, WS_H8), S, E, side_buf);
        }
        GRID_BARP(15);
        {
            PHASE_ARGS(); pg8::SchedMoE S; S.bb = tb_bb; S.cnt = tb_cnt; S.be = tb_be; S.NT = 4; S.G = Gp; S.c = vcup;
            S.bias = IN(14) + (size_t)layer * 32 * 1024; S.bias_estride = 1024; S.bias_pnstep = 256; S.bias_seg1 = 128; S.Acompact = (const char*)WSP(unsigned char, WS_Z); S.a_tstep = (size_t)256 * 1024;
            const int* slot_tok = WSP(int, WS_SLOTTOK); const float* slot_gate = WSP(float, WS_SLOTGATE);
            S.W = (const char*)(WSP(unsigned char, WS_WEXPOUT) + (size_t)layer * 32 * 1024 * 1024); S.w_estep = (size_t)1024 * 1024; S.w_tstep = (size_t)256 * 1024; S.slot_tok = slot_tok; S.slot_gate = slot_gate;
            pg8::EpiMoeOut E; E.Y2 = WSP(unsigned char, WS_Y2); E.bias = IN(14) + (size_t)layer * 32 * 1024;
            for (int rep_ = 0; rep_ < DUPN(5); ++rep_)
            pg8::gemm_phase<pg8::EpiMoeOut, pg8::SchedMoE, false, true, true, true>(wave0, lds + LDS_STAGE, 1024, 1024, nullptr, S, E, side_buf);
        }
        GRID_BARP(16);
        {
            PHASE_IDS(); PHASE_ARGS();
            const float* ln_g = IN(6); const float* ln_b = IN(7); const float* MOD = WSP(float, WS_MOD); unsigned short* X16 = WSP(unsigned short, WS_X); const unsigned char* Y = WSP(unsigned char, WS_Y); const float* in_x = IN(0); const float* in_ctx = IN(2); unsigned char* H = WSP(unsigned char, WS_H8);
            const unsigned char* Y2 = WSP(unsigned char, WS_Y2); const int* tok_pos = WSP(int, WS_TOKPOS); float* outp = A_->out;
            const float* g2 = ln_g + (size_t)(layer * 2 + 1) * 1024; const float* b2 = ln_b + (size_t)(layer * 2 + 1) * 1024;
            const float* g1 = ln_g + (size_t)(layer * 2 + 0) * 1024; const float* b1 = ln_b + (size_t)(layer * 2 + 0) * 1024;
            f32x4 g2v[4], b2v[4], g1v[4], b1v[4];
#pragma unroll
            for (int j = 0; j < 4; ++j) { g2v[j] = *(const f32x4*)(g2 + 4 * lane + 256 * j); b2v[j] = *(const f32x4*)(b2 + 4 * lane + 256 * j); g1v[j] = *(const f32x4*)(g1 + 4 * lane + 256 * j); b1v[j] = *(const f32x4*)(b1 + 4 * lane + 256 * j); }
            for (int rep_ = 0; rep_ < DUPN(13); ++rep_) {
            u32x4 tpn[2];
#pragma unroll
            for (int rr = 0; rr < 2; ++rr) tpn[rr] = (gw < M / 2) ? *(const u32x4*)(tok_pos + (size_t)(2 * gw + rr) * 4) : (u32x4){0u, 0u, 0u, 0u};
            for (int rp = gw; rp < M / 2; rp += NGW) {
                const int row0 = 2 * rp; const int b = row0 / TPB, t = row0 % TPB; const bool isctx = t < CTXL;
                const u32x4 tpc[2] = {tpn[0], tpn[1]};
                if (rp + NGW < M / 2) {
#pragma unroll
                    for (int rr = 0; rr < 2; ++rr) tpn[rr] = *(const u32x4*)(tok_pos + (size_t)(2 * (rp + NGW) + rr) * 4); }
                if (lastl && isctx) continue;
                const float* mr = MOD + (size_t)(layer * 17 + (isctx ? 16 : b)) * 6144;
                int zr[2][4];
#pragma unroll
                for (int rr = 0; rr < 2; ++rr) { const u32x4 tp = tpc[rr];
#pragma unroll
                    for (int k = 0; k < 4; ++k) { const int pos = (int)tp[k]; const int e = pos / CAP, rk = pos % CAP; zr[rr][k] = tb_bb[e] * 256 + rk; } }
                const float* mn = MOD + (size_t)((layer + 1 < DEPTH ? layer + 1 : layer) * 17 + (isctx ? 16 : b)) * 6144;
                f32x4 gtv[4], shv[4], scv[4];
#pragma unroll
                for (int j = 0; j < 4; ++j) { const int col = 4 * lane + 256 * j; gtv[j] = *(const f32x4*)(mr + 5120 + col) * pg8::Y2SCALE_INV; shv[j] = *(const f32x4*)(mn + col); scv[j] = *(const f32x4*)(mn + 1024 + col); }
                f32x4 v[2][4], gt1v[4]; unsigned yw[2][4][4], y1w[2][4]; u32x2 xh[2][4];
#pragma unroll
                for (int j = 0; j < 4; ++j) gt1v[j] = *(const f32x4*)(mr + 2048 + 4 * lane + 256 * j) * (1.0f / 64.0f);
#pragma unroll
                for (int rr = 0; rr < 2; ++rr) { const size_t row_ = (size_t)(row0 + rr);
#pragma unroll
                    for (int j = 0; j < 4; ++j) xh[rr][j] = *(const u32x2*)(X16 + row_ * DM + 4 * lane + 256 * j);
#pragma unroll
                    for (int j = 0; j < 4; ++j) { const int col = 4 * lane + 256 * j; y1w[rr][j] = *(const unsigned*)(Y + row_ * DM + col);
#pragma unroll
                        for (int k = 0; k < 4; ++k) yw[rr][j][k] = *(const unsigned*)(Y2 + (size_t)zr[rr][k] * 1024 + col); } }
#pragma unroll
                for (int rr = 0; rr < 2; ++rr) { float s = 0.f;
#pragma unroll
                    for (int j = 0; j < 4; ++j) { const int yw1 = (int)y1w[rr][j]; const f32x2 ylo = __builtin_amdgcn_cvt_pk_f32_fp8(yw1, false), yhi = __builtin_amdgcn_cvt_pk_f32_fp8(yw1, true); const f32x4 gt = gt1v[j];
                        v[rr][j] = h4_to_f32(xh[rr][j].x, xh[rr][j].y) * ALPHA; v[rr][j][0] += gt[0] * ylo[0]; v[rr][j][1] += gt[1] * ylo[1]; v[rr][j][2] += gt[2] * yhi[0]; v[rr][j][3] += gt[3] * yhi[1];
                        s += (v[rr][j][0] + v[rr][j][1]) + (v[rr][j][2] + v[rr][j][3]); }
                    const float mean = wave_sum(s, lane) * (1.f / DM); float s2 = 0.f;
#pragma unroll
                    for (int j = 0; j < 4; ++j) { v[rr][j] = v[rr][j] - mean; s2 += (v[rr][j][0] * v[rr][j][0] + v[rr][j][1] * v[rr][j][1]) + (v[rr][j][2] * v[rr][j][2] + v[rr][j][3] * v[rr][j][3]); }
                    const float rstd = 1.f / sqrtf(wave_sum(s2, lane) * (1.f / DM) + LN_EPS);
#pragma unroll
                    for (int j = 0; j < 4; ++j) v[rr][j] = v[rr][j] * rstd * g1v[j] + b1v[j]; }
#pragma unroll
                for (int rr = 0; rr < 2; ++rr) { const int row = row0 + rr; float s = 0.f;
#pragma unroll
                    for (int j = 0; j < 4; ++j) { const int col = 4 * lane + 256 * j; f32x4 y = (f32x4){0.f, 0.f, 0.f, 0.f};
#pragma unroll
                        for (int k = 0; k < 4; ++k) { const int w = (int)yw[rr][j][k]; const f32x2 lo = __builtin_amdgcn_cvt_pk_f32_fp8(w, false), hi = __builtin_amdgcn_cvt_pk_f32_fp8(w, true); y[0] += lo[0]; y[1] += lo[1]; y[2] += hi[0]; y[3] += hi[1]; }
                        const f32x4 gt = gtv[j];
                        v[rr][j] = v[rr][j] * ALPHA + gt * y; s += (v[rr][j][0] + v[rr][j][1]) + (v[rr][j][2] + v[rr][j][3]); }
                    const float mean = wave_sum(s, lane) * (1.f / DM); float s2 = 0.f;
#pragma unroll
                    for (int j = 0; j < 4; ++j) { v[rr][j] = v[rr][j] - mean; s2 += (v[rr][j][0] * v[rr][j][0] + v[rr][j][1] * v[rr][j][1]) + (v[rr][j][2] * v[rr][j][2] + v[rr][j][3] * v[rr][j][3]); }
                    const float rstd = 1.f / sqrtf(wave_sum(s2, lane) * (1.f / DM) + LN_EPS);
#pragma unroll
                    for (int j = 0; j < 4; ++j) { const int col = 4 * lane + 256 * j; const f32x4 gg = g2v[j], bb = b2v[j];
                        const f32x4 xn = v[rr][j] * rstd * gg + bb;
                        if (lastl) { *(f32x4*)(outp + ((size_t)b * SEQ + (t + rr - CTXL)) * DM + col) = xn; }
                        else { *(u32x2*)(X16 + (size_t)row * DM + col) = f32_to_h4(xn);
                            const f32x4 sh = shv[j], sc = scv[j]; const f32x4 h = xn * (sc + 1.0f) + sh;
                            *(unsigned*)(H + (size_t)row * DM + col) = pg8::pk4_fp8(h[0], h[1], h[2], h[3]); } } }
            } }
        }
        if (!lastl) GRID_BARP(17);
    }
    if (PROBE_MASK != 0ull) {
        PT_SAMPLE(17);
        __syncthreads();
        const unsigned pt_target_ = MISC[3401] * PROBE_MULT; const unsigned pt_t0_ = (unsigned)__builtin_amdgcn_s_memrealtime();
        while ((unsigned)__builtin_amdgcn_s_memrealtime() - pt_t0_ < pt_target_) __builtin_amdgcn_s_sleep(32);
    }
}

extern "C" void kernel_launch(void* const* d_in, const int* in_sizes, int n_in, void* d_out, int out_size, void* d_ws, size_t ws_size, hipStream_t stream) {
    static int grid = 0;
    if (grid == 0) {
        if (n_in != 34 || ws_size < WS_END) { fprintf(stderr, "kernel_launch: unexpected n_in %d / ws %zu (need %zu)\n", n_in, ws_size, (size_t)WS_END); grid = -1; return; }
        int dev = 0, cus = 0, per_cu = 0;
        if (hipGetDevice(&dev) != hipSuccess || hipDeviceGetAttribute(&cus, hipDeviceAttributeMultiprocessorCount, dev) != hipSuccess) { grid = -1; return; }
        if (hipFuncSetAttribute((const void*)fwd_kernel, hipFuncAttributeMaxDynamicSharedMemorySize, LDS_BYTES) != hipSuccess) { fprintf(stderr, "kernel_launch: hipFuncSetAttribute failed\n"); grid = -1; return; }
        if (hipOccupancyMaxActiveBlocksPerMultiprocessor(&per_cu, (const void*)fwd_kernel, NTHR, LDS_BYTES) != hipSuccess || per_cu < 1) { fprintf(stderr, "kernel_launch: occupancy query says %d\n", per_cu); }
        (void)hipGetLastError();
        if (cus < 256) { fprintf(stderr, "kernel_launch: built for a 256-CU device (one resident workgroup per CU), found %d CUs\n", cus); grid = -1; return; }
        grid = 256;
    }
    if (grid < 0) return;
    (void)hipMemsetAsync((char*)d_ws + WS_CTL, 0, CTL_BYTES, stream);
    Args a{};
    for (int i = 0; i < 34; ++i) a.in[i] = (const float*)d_in[i];
    a.out = (float*)d_out; a.ws = (unsigned char*)d_ws;
    hipLaunchKernelGGL(fwd_kernel, dim3(grid), dim3(NTHR), LDS_BYTES, stream, a);
    const hipError_t le = hipPeekAtLastError();
    if (le != hipSuccess) fprintf(stderr, "kernel_launch: launch failed: %s\n", hipGetErrorName(le));
}
```

```cpp
#include <hip/hip_runtime.h>
#include <stdint.h>
#include <stdio.h>
#ifndef DUPSEL
#define DUPSEL 0
#endif
#define DUPN(k) ((DUPSEL == (k)) ? 2 : 1)
#define PROBE_MASK 0ull

#define LAS __attribute__((address_space(3)))
#define GAS __attribute__((address_space(1)))
typedef unsigned short bf16_t;
typedef short bf16x8 __attribute__((ext_vector_type(8)));
typedef float f32x4 __attribute__((ext_vector_type(4)));
typedef float f32x2 __attribute__((ext_vector_type(2)));
typedef unsigned u32x4 __attribute__((ext_vector_type(4)));
typedef unsigned u32x2 __attribute__((ext_vector_type(2)));

constexpr int DM = 1024, NB = 16, SEQ = 2048, CTXL = 256, TPB = SEQ + CTXL  ;
constexpr int M = NB * TPB;
constexpr int NPANEL = M / 256;
constexpr int DEPTH = 4, NEXP = 32, TOPK = 4, DFF = 1024;
constexpr int CAP = M;
constexpr int NPAD = M * TOPK + NEXP * 256;
constexpr float ALPHA = 1.681792830507429f;
constexpr float LN_EPS = 1e-5f;
constexpr int NWAVES = 8, NTHR = 512;

constexpr size_t MiB = 1ull << 20;
constexpr size_t WS_CTL = 0, CTL_BYTES = 1 * MiB;
constexpr size_t WS_MOD = 1 * MiB;
constexpr size_t WS_X = 4 * MiB;
constexpr size_t WS_H = WS_X + 144 * MiB;
constexpr size_t WS_Y = WS_H + 72 * MiB;
constexpr size_t WS_OL = WS_Y + 72 * MiB;
constexpr size_t WS_PROJ = WS_OL + 72 * MiB;
constexpr size_t WS_Z = WS_PROJ + 126 * MiB;
constexpr size_t WS_Y2 = WS_Z + 304 * MiB;
constexpr size_t WS_SLOTTOK = WS_Y2 + 304 * MiB;
constexpr size_t WS_SLOTGATE = WS_SLOTTOK + 5 * MiB;
constexpr size_t WS_TOKPOS = WS_SLOTGATE + 5 * MiB;
constexpr size_t WS_WEXPIN = WS_TOKPOS + 1 * MiB;
constexpr size_t WS_WEXPOUT = WS_WEXPIN + 512 * MiB;
constexpr size_t WS_WMIX = WS_WEXPOUT + 256 * MiB;
constexpr size_t WS_WINAB = WS_WMIX + 8 * MiB;
constexpr size_t WS_WINCD = WS_WINAB + 6 * MiB;
constexpr size_t WS_WGLU = WS_WINCD + 7 * MiB;
constexpr size_t WS_WUQ = WS_WGLU + 1 * MiB;
constexpr size_t WS_WUKV = WS_WUQ + 1 * MiB;
constexpr size_t WS_ROPE = WS_WUKV + 1 * MiB;
constexpr size_t WS_QM = WS_ROPE + 1 * MiB;
constexpr size_t WS_KVM = WS_QM + 54 * MiB;
constexpr size_t WS_UT = WS_KVM + 72 * MiB;
constexpr size_t WS_XS = WS_UT + 36 * MiB;
constexpr size_t WS_HIN = WS_XS + 72 * MiB;
constexpr size_t WS_ZG = WS_HIN + 36 * MiB;
constexpr size_t WS_TF = WS_ZG + 36 * MiB;
constexpr size_t WS_SF = WS_TF + 2 * MiB;
constexpr size_t WS_WF = WS_SF + 8 * MiB;
constexpr size_t WS_LAM16 = WS_WF + 8 * MiB;
constexpr size_t WS_X1 = WS_LAM16 + 1 * MiB;
constexpr size_t WS_H8 = WS_X1 + 144 * MiB;
constexpr size_t WS_WRF = WS_H8 + 36 * MiB;
constexpr size_t WS_END = WS_WRF + 1 * MiB;

constexpr int CW_BAR = 4096;
constexpr int CW_CURSOR = 8192;

constexpr int LDS_STAGE = 0, LDS_MISC = 133120, LDS_BYTES = 147456;

__device__ __forceinline__ int lane_now() { int l; asm volatile("v_mbcnt_lo_u32_b32 %0, -1, 0\n\tv_mbcnt_hi_u32_b32 %0, -1, %0" : "=v"(l)); return l; }
__device__ __forceinline__ unsigned f2bf(float f) { unsigned u = __builtin_bit_cast(unsigned, f); return (u + 0x7fffu + ((u >> 16) & 1u)) >> 16; }
__device__ __forceinline__ unsigned pk2(float lo, float hi) { unsigned r; asm("v_cvt_pk_bf16_f32 %0, %1, %2" : "=v"(r) : "v"(lo), "v"(hi)); return r; }
__device__ __forceinline__ float bf2f(unsigned short b) { return __builtin_bit_cast(float, ((unsigned)b) << 16); }
__device__ __forceinline__ float bflo(unsigned w) { return __builtin_bit_cast(float, w << 16); }
__device__ __forceinline__ float bfhi(unsigned w) { return __builtin_bit_cast(float, w & 0xffff0000u); }
__device__ __forceinline__ float shx(float v, int o, int lane) { return __builtin_bit_cast(float, __builtin_amdgcn_ds_bpermute((lane ^ o) << 2, __builtin_bit_cast(int, v))); }
__device__ __forceinline__ float row16_sum(float v) {
    v += __builtin_bit_cast(float, __builtin_amdgcn_update_dpp(0, __builtin_bit_cast(int, v), 0xB1, 0xF, 0xF, true));
    v += __builtin_bit_cast(float, __builtin_amdgcn_update_dpp(0, __builtin_bit_cast(int, v), 0x4E, 0xF, 0xF, true));
    v += __builtin_bit_cast(float, __builtin_amdgcn_update_dpp(0, __builtin_bit_cast(int, v), 0x141, 0xF, 0xF, true));
    v += __builtin_bit_cast(float, __builtin_amdgcn_update_dpp(0, __builtin_bit_cast(int, v), 0x140, 0xF, 0xF, true));
    return v;
}
__device__ __forceinline__ float row16_max(float v) {
    v = fmaxf(v, __builtin_bit_cast(float, __builtin_amdgcn_update_dpp(__builtin_bit_cast(int, v), __builtin_bit_cast(int, v), 0xB1, 0xF, 0xF, false)));
    v = fmaxf(v, __builtin_bit_cast(float, __builtin_amdgcn_update_dpp(__builtin_bit_cast(int, v), __builtin_bit_cast(int, v), 0x4E, 0xF, 0xF, false)));
    v = fmaxf(v, __builtin_bit_cast(float, __builtin_amdgcn_update_dpp(__builtin_bit_cast(int, v), __builtin_bit_cast(int, v), 0x141, 0xF, 0xF, false)));
    v = fmaxf(v, __builtin_bit_cast(float, __builtin_amdgcn_update_dpp(__builtin_bit_cast(int, v), __builtin_bit_cast(int, v), 0x140, 0xF, 0xF, false)));
    return v;
}
__device__ __forceinline__ float wave_sum(float v, int lane) {
    (void)lane;
    v += __builtin_bit_cast(float, __builtin_amdgcn_update_dpp(0, __builtin_bit_cast(int, v), 0xB1, 0xF, 0xF, true));
    v += __builtin_bit_cast(float, __builtin_amdgcn_update_dpp(0, __builtin_bit_cast(int, v), 0x4E, 0xF, 0xF, true));
    v += __builtin_bit_cast(float, __builtin_amdgcn_update_dpp(0, __builtin_bit_cast(int, v), 0x141, 0xF, 0xF, true));
    v += __builtin_bit_cast(float, __builtin_amdgcn_update_dpp(0, __builtin_bit_cast(int, v), 0x140, 0xF, 0xF, true));
    const int vi = __builtin_bit_cast(int, v);
    return (__builtin_bit_cast(float, __builtin_amdgcn_readlane(vi, 0)) + __builtin_bit_cast(float, __builtin_amdgcn_readlane(vi, 16))) +
           (__builtin_bit_cast(float, __builtin_amdgcn_readlane(vi, 32)) + __builtin_bit_cast(float, __builtin_amdgcn_readlane(vi, 48)));
}
__device__ __forceinline__ int uni(int v) { return __builtin_amdgcn_readfirstlane(v); }
typedef _Float16 h16x4 __attribute__((ext_vector_type(4)));
__device__ __forceinline__ float h2f(unsigned short b) { return (float)__builtin_bit_cast(_Float16, b); }
__device__ __forceinline__ f32x4 h4_to_f32(unsigned lo, unsigned hi) { return (f32x4){h2f((unsigned short)(lo & 0xffffu)), h2f((unsigned short)(lo >> 16)), h2f((unsigned short)(hi & 0xffffu)), h2f((unsigned short)(hi >> 16))}; }
__device__ __forceinline__ u32x2 f32_to_h4(f32x4 v) { const h16x4 h = {(_Float16)v[0], (_Float16)v[1], (_Float16)v[2], (_Float16)v[3]}; return __builtin_bit_cast(u32x2, h); }
__device__ __forceinline__ const char* unip(const char* p) { const unsigned long long v = (unsigned long long)p; const unsigned lo = (unsigned)__builtin_amdgcn_readfirstlane((int)(unsigned)v), hi = (unsigned)__builtin_amdgcn_readfirstlane((int)(unsigned)(v >> 32)); return (const char*)(((unsigned long long)hi << 32) | lo); }
#define PHASE_IDS() const int lane = lane_now(); const int wave = wave0; const int tid = wave0 * 64 + lane; const int gw = vcu * NWAVES + wave; (void)lane; (void)gw
#define LDS_WAIT() asm volatile("s_waitcnt lgkmcnt(0)" ::: "memory")
#define VM_WAIT() asm volatile("s_waitcnt vmcnt(0)" ::: "memory")

#define XB_TMO      128
#define XB_XCNT(j)  (256  + 64 * (j))
#define XB_XSUB(j)  (1280 + 64 * (j))
#define XB_XGEN(j)  (2304 + 64 * (j))
#define XB_TOP      3328
#define XB_TOPGEN   3392
#define XCD_BAR_WORDS 3456
#define XB_SPIN_CAP (1u << 22)

__device__ __forceinline__ unsigned xb_ld(unsigned* p)              { return __hip_atomic_load(p, __ATOMIC_RELAXED, __HIP_MEMORY_SCOPE_AGENT); }
__device__ __forceinline__ unsigned xb_add(unsigned* p, unsigned v) { return __hip_atomic_fetch_add(p, v, __ATOMIC_RELAXED, __HIP_MEMORY_SCOPE_AGENT); }
__device__ __forceinline__ unsigned xb_xcc_id() { return (unsigned)__builtin_amdgcn_s_getreg((3 << 11) | 20) & 0xFu; }
#define XB_SPIN(cond, bar) do { unsigned _sp = 0; while (cond) { __builtin_amdgcn_s_sleep(1); \
    if ((++_sp & 255u) == 0u) { if (xb_ld(&(bar)[XB_TMO])) break; if (_sp > XB_SPIN_CAP) { atomicAdd(&(bar)[XB_TMO], 1u); break; } } } } while (0)

struct XcdBarrier { unsigned* bar; unsigned x; volatile LAS unsigned* st; };

__device__ __forceinline__ XcdBarrier xcd_barrier_post(unsigned* bar, volatile LAS unsigned* st) {
    XcdBarrier b; b.bar = bar; b.x = 0; b.st = st;
    if (threadIdx.x == 0) (void)xb_add(&bar[XB_XCNT(xb_xcc_id())], 1u);
    return b;
}
__device__ __forceinline__ void xcd_barrier_complete(unsigned* bar, unsigned x, unsigned& nloc, unsigned& nx) {
    const unsigned G = gridDim.x * gridDim.y * gridDim.z;
    unsigned sum, cnt, mine, sp = 0u;
    for (;;) {
        sum = 0u; cnt = 0u; mine = 0u;
#pragma unroll
        for (unsigned j = 0; j < 16; ++j) { const unsigned c = xb_ld(&bar[XB_XCNT(j)]); sum += c; cnt += (c > 0u) ? 1u : 0u; mine = (j == x) ? c : mine; }
        if (sum == G) break;
        __builtin_amdgcn_s_sleep(1);
        if ((++sp & 255u) == 0u) { if (xb_ld(&bar[XB_TMO])) break; if (sp > XB_SPIN_CAP) { atomicAdd(&bar[XB_TMO], 1u); break; } }
    }
    nloc = mine > 0u ? mine : 1u; nx = cnt > 0u ? cnt : 1u;
}
__device__ __forceinline__ void xcd_barrier(const XcdBarrier& b) {
    asm volatile("s_waitcnt vmcnt(0)" ::: "memory");
    __syncthreads();
    if (b.x == 0u && lane_now() == 0) {
        unsigned* bar = b.bar;
        __builtin_amdgcn_s_waitcnt(0);
        unsigned bx_; asm volatile("s_getreg_b32 %0, hwreg(HW_REG_XCC_ID, 0, 4)" : "=s"(bx_));
        unsigned nloc = b.st[0], nx = b.st[1];
        if (nloc == 0u) { xcd_barrier_complete(bar, bx_, nloc, nx); b.st[0] = nloc; b.st[1] = nx; }
        const unsigned old = xb_add(&bar[XB_XSUB(bx_)], 1u);
        const unsigned gen = old / nloc;
        if (old + 1u == (gen + 1u) * nloc) {
            __builtin_amdgcn_fence(__ATOMIC_RELEASE, "agent");
            asm volatile("s_waitcnt vmcnt(0)" ::: "memory");
            const unsigned og = xb_add(&bar[XB_TOP], 1u);
            const unsigned tg = og / nx;
            if (og + 1u == (tg + 1u) * nx) xb_add(&bar[XB_TOPGEN], 1u);
            else XB_SPIN(xb_ld(&bar[XB_TOPGEN]) == tg, bar);
            __builtin_amdgcn_fence(__ATOMIC_ACQUIRE, "agent");
            xb_add(&bar[XB_XGEN(bx_)], 1u);
            asm volatile("s_waitcnt vmcnt(0)" ::: "memory");
        } else {
            XB_SPIN(xb_ld(&bar[XB_XGEN(bx_)]) == gen, bar);
            __builtin_amdgcn_fence(__ATOMIC_ACQUIRE, "agent");
            asm volatile("s_waitcnt vmcnt(0)" ::: "memory");
        }
    }
    __syncthreads();
}

namespace pg8 {
constexpr int BM = 256, BK = 64, HALF = 128, HTB = HALF * BK * 2, STAGE_BYTES = 8 * HTB;
__device__ __forceinline__ int lds_byte(int r, int c) { const int st = (r >> 4) * 2 + (c >> 5), rr = r & 15, cc = c & 31, ob = rr * 64 + cc * 2; return st * 1024 + (ob ^ (((ob >> 9) & 1) << 5)); }
__device__ __forceinline__ void stage_rc(int b, int& R, int& C) { const int st = b / 1024, sb = b % 1024, swz = sb ^ (((sb >> 9) & 1) << 5); R = (st >> 1) * 16 + swz / 64; C = (st & 1) * 32 + (swz % 64) / 2; }
__device__ __forceinline__ int perm32(int rho) { const int n = rho >> 4, i = rho & 15; return 8 * (i >> 2) + 4 * n + (i & 3); }

struct Unit { int pm, pn, g, e, nvalid, pad; const char* A; const char* B; const int* rows; const float* gates; const float* bias0; const float* bias1; };
constexpr int SIDE_BYTES = 3072;

__device__ __forceinline__ unsigned cvt_pk_bf16(float lo, float hi) { unsigned r; asm volatile("v_cvt_pk_bf16_f32 %0, %1, %2" : "=v"(r) : "v"(lo), "v"(hi)); return r; }

typedef int i32x8 __attribute__((ext_vector_type(8)));
typedef int i32x4 __attribute__((ext_vector_type(4)));
__device__ __forceinline__ i32x8 cat8(bf16x8 lo, bf16x8 hi) { const i32x4 a = __builtin_bit_cast(i32x4, lo), b = __builtin_bit_cast(i32x4, hi); return (i32x8){a[0], a[1], a[2], a[3], b[0], b[1], b[2], b[3]}; }
template <class Epi, class Sched, bool GATHER, bool FP8, bool SIDE = false, bool P16 = false>
__device__ __forceinline__ void gemm_phase(const int wid0, LAS unsigned char* lds, const int Kb, const int ldab, const char* Agather, const Sched& S, const Epi& E, LAS unsigned char* side = nullptr) {
    const int lane = lane_now(); const int wid = wid0; const int tid = wid0 * 64 + lane;
    const int wr = wid >> 2, wc = wid & 3, fr = lane & 15, fq = lane >> 4;
    const int nt = Kb / 128;
    constexpr bool PG_PROBE = FP8 && SIDE && ((GATHER && ((PROBE_MASK >> 31) & 1ull)) || (!GATHER && ((PROBE_MASK >> 30) & 1ull)));
    unsigned voffA[2], voffB[2]; int rowA[2]; unsigned colA2[2];
#pragma unroll
    for (int i = 0; i < 2; ++i) { int R, C; stage_rc(tid * 16 + i * 8192, R, C); const int Rb = P16 ? (64 * (R >> 5) + 16 * ((R & 15) >> 2) + 4 * ((R >> 4) & 1) + (R & 3)) : ((R & ~31) + perm32(R & 31));
        voffA[i] = (unsigned)(R * ldab + C * 2); voffB[i] = (unsigned)(Rb * Kb + C * 2); rowA[i] = R; colA2[i] = (unsigned)C * 2u; }
    const size_t kstep = (size_t)(BK * 2);
    const size_t hstepA = (size_t)HALF * ldab, hstepB = P16 ? (size_t)8 * Kb : (size_t)HALF * Kb;
    const unsigned ldsw = (unsigned)wid * 1024u;
    const int aoff = lds_byte(wr * 64 + fr, fq * 8), boff = lds_byte(wc * 32 + fr, fq * 8);
#define PG8_SA(b, h) (((b) * 2 + (h)) * HTB)
#define PG8_SB(b, h) ((4 + (b) * 2 + (h)) * HTB)
#define PG8_GLDS(gp, lp) __builtin_amdgcn_global_load_lds((const unsigned*)(gp), (LAS unsigned*)(lp), 16, 0, 0)
#define PG8_GLDS4(gp, lp) __builtin_amdgcn_global_load_lds((const unsigned*)(gp), (LAS unsigned*)(lp), 4, 0, 0)
#define PG8_STAGE_B(bufoff, gbase) do { const char* _q = (const char*)(gbase); asm volatile("" : "+s"(_q)); _Pragma("unroll") for (int _i = 0; _i < 2; ++_i) PG8_GLDS(_q + voffB[_i], lds + (bufoff) + ldsw + _i * 8192); } while (0)
#define PG8_STAGE_A(bufoff, h, nx, kb) do { if constexpr (GATHER) { const char* _p = Agather + (kb); asm volatile("" : "+s"(_p)); _Pragma("unroll") for (int _i = 0; _i < 2; ++_i) PG8_GLDS(_p + ((nx) ? nvo[h][_i] : cvo[h][_i]), lds + (bufoff) + ldsw + _i * 8192); } \
        else { const char* _p = ((nx) ? nA : cA) + (size_t)(h) * hstepA + (kb); asm volatile("" : "+s"(_p)); _Pragma("unroll") for (int _i = 0; _i < 2; ++_i) PG8_GLDS(_p + voffA[_i], lds + (bufoff) + ldsw + _i * 8192); } } while (0)
#define PG8_LDA(dst, b, h) do { _Pragma("unroll") for (int m = 0; m < 4; ++m) _Pragma("unroll") for (int k = 0; k < 2; ++k) dst[m][k] = *(const LAS bf16x8*)(lds + PG8_SA(b, h) + aoff + m * 2048 + k * 1024); } while (0)
#define PG8_LDB(dst, b, h) do { _Pragma("unroll") for (int n = 0; n < 2; ++n) _Pragma("unroll") for (int k = 0; k < 2; ++k) dst[n][k] = *(const LAS bf16x8*)(lds + PG8_SB(b, h) + boff + n * 2048 + k * 1024); } while (0)
#define PG8_MMA(ai, bj, At, Bt) do { __builtin_amdgcn_s_setprio(1); if constexpr (FP8) { _Pragma("unroll") for (int m = 0; m < 4; ++m) _Pragma("unroll") for (int n = 0; n < 2; ++n) \
        asm volatile("v_mfma_f32_16x16x128_f8f6f4 %0, %1, %2, %0" : "+v"(acc[ai][bj][m][n]) : "v"(cat8(Bt[n][0], Bt[n][1])), "v"(cat8(At[m][0], At[m][1]))); } \
      else { _Pragma("unroll") for (int m = 0; m < 4; ++m) _Pragma("unroll") for (int n = 0; n < 2; ++n) _Pragma("unroll") for (int k = 0; k < 2; ++k) \
        acc[ai][bj][m][n] = __builtin_amdgcn_mfma_f32_16x16x32_bf16(Bt[n][k], At[m][k], acc[ai][bj][m][n], 0, 0, 0); } __builtin_amdgcn_s_setprio(0); } while (0)
#define PG8_WAIT_V(n) asm volatile("s_waitcnt vmcnt(" #n ")" ::: "memory")
#define PG8_WAIT_L(n) asm volatile("s_waitcnt lgkmcnt(" #n ")" ::: "memory")
#define PG8_BAR __builtin_amdgcn_s_barrier()
#define PG8_SCHED __builtin_amdgcn_sched_barrier(0)
#define PG8_LOADVO(dst, par) do { if constexpr (GATHER) { const LAS int* _rw = (const LAS int*)(side + (par) * SIDE_BYTES); _Pragma("unroll") for (int _h = 0; _h < 2; ++_h) _Pragma("unroll") for (int _i = 0; _i < 2; ++_i) { \
        const int _t = _rw[_h * 128 + rowA[_i]]; dst[_h][_i] = (unsigned)_t * (unsigned)ldab + colA2[_i]; } } } while (0)
#define PG8_SIDE_DMA(u, par) do { if constexpr (SIDE) { LAS unsigned char* _sb = side + (par) * SIDE_BYTES; const int _e = (wid & 3) * 64 + lane; \
        if (wid < 4) { const int _ec = (_e < (u).nvalid) ? _e : 0; if constexpr (GATHER) PG8_GLDS4((const char*)((u).rows + _ec), _sb + (wid & 3) * 256); else PG8_GLDS4((const char*)((u).gates + _ec), _sb + 2048 + (wid & 3) * 256); } \
        else { const float* _bp = (_e < 128) ? (u).bias0 + _e : (u).bias1 + (_e - 128); PG8_GLDS4((const char*)_bp, _sb + 1024 + (wid & 3) * 256); } } } while (0)
    Unit cur, nxt; int ui = 0;
    if (!S.next(0, cur)) return;
    f32x4 acc[2][2][4][2];
#pragma unroll
    for (int a = 0; a < 2; ++a)
#pragma unroll
        for (int b = 0; b < 2; ++b)
#pragma unroll
            for (int m = 0; m < 4; ++m)
#pragma unroll
                for (int n = 0; n < 2; ++n) acc[a][b][m][n] = (f32x4){0.f, 0.f, 0.f, 0.f};
    bf16x8 At[4][2], B0[2][2], B1[2][2];
    unsigned cvo[2][2] = {{0u, 0u}, {0u, 0u}}, nvo[2][2] = {{0u, 0u}, {0u, 0u}};
    const char* cA = cur.A; const char* cB = cur.B; const char* nA = cA; const char* nB = cB;
    if constexpr (SIDE) { PG8_SIDE_DMA(cur, 0); PG8_WAIT_V(0); PG8_BAR; }
    PG8_LOADVO(cvo, 0);
    PG8_STAGE_B(PG8_SB(0, 0), cB); PG8_STAGE_A(PG8_SA(0, 0), 0, false, 0); PG8_STAGE_B(PG8_SB(0, 1), cB + hstepB); PG8_STAGE_A(PG8_SA(0, 1), 1, false, 0);
    if (wr == 1) PG8_BAR;
    PG8_WAIT_V(4); PG8_BAR;
    PG8_STAGE_B(PG8_SB(1, 0), cB + kstep); PG8_STAGE_A(PG8_SA(1, 0), 0, false, kstep); PG8_STAGE_B(PG8_SB(1, 1), cB + hstepB + kstep);
    PG8_WAIT_V(6); PG8_BAR;
    for (;;) {
        const bool has_next = S.next(ui + 1, nxt);
        const int npar = (ui + 1) % 3;
        if (has_next) { nA = nxt.A; nB = nxt.B; PG8_SIDE_DMA(nxt, npar); }
        else { nA = cA; nB = cB;
#pragma unroll
            for (int h = 0; h < 2; ++h)
#pragma unroll
                for (int i = 0; i < 2; ++i) nvo[h][i] = cvo[h][i]; }
        unsigned pg_t0_ = 0; if constexpr (PG_PROBE) pg_t0_ = (unsigned)__builtin_amdgcn_s_memrealtime();
#pragma clang loop unroll(disable)
        for (int t = 0; t < nt; t += 2) {
            const bool last = (t == nt - 2);
            if (last && has_next) PG8_LOADVO(nvo, npar);
            const size_t k1 = (size_t)(t + 1) * kstep;
            const size_t k2 = last ? 0 : (size_t)(t + 2) * kstep, k3 = k2 + kstep;
            const char* b2 = last ? nB : cB + (size_t)(t + 2) * kstep; const char* b3 = b2 + kstep;
            PG8_LDB(B0, 0, 0); PG8_SCHED; PG8_LDA(At, 0, 0); PG8_STAGE_A(PG8_SA(1, 1), 1, false, k1);
            PG8_WAIT_L(8); PG8_BAR; PG8_WAIT_L(0); PG8_MMA(0, 0, At, B0); PG8_BAR; PG8_SCHED;
            PG8_LDB(B1, 0, 1); PG8_STAGE_B(PG8_SB(0, 0), b2);
            PG8_BAR; PG8_WAIT_L(0); PG8_MMA(0, 1, At, B1); PG8_BAR;
            PG8_LDA(At, 0, 1); PG8_STAGE_A(PG8_SA(0, 0), 0, last, k2);
            PG8_BAR; PG8_WAIT_L(0); PG8_MMA(1, 0, At, B0); PG8_BAR; PG8_SCHED;
            PG8_STAGE_B(PG8_SB(0, 1), b2 + hstepB);
            PG8_WAIT_V(6); PG8_BAR; PG8_MMA(1, 1, At, B1); PG8_BAR;
            PG8_LDB(B0, 1, 0); PG8_SCHED; PG8_LDA(At, 1, 0); PG8_STAGE_A(PG8_SA(0, 1), 1, last, k2);
            PG8_WAIT_L(8); PG8_BAR; PG8_WAIT_L(0); PG8_MMA(0, 0, At, B0); PG8_BAR; PG8_SCHED;
            PG8_LDB(B1, 1, 1); PG8_STAGE_B(PG8_SB(1, 0), b3);
            PG8_BAR; PG8_WAIT_L(0); PG8_MMA(0, 1, At, B1); PG8_BAR;
            PG8_LDA(At, 1, 1); PG8_STAGE_A(PG8_SA(1, 0), 0, last, k3);
            PG8_BAR; PG8_WAIT_L(0); PG8_MMA(1, 0, At, B0); PG8_BAR; PG8_SCHED;
            PG8_STAGE_B(PG8_SB(1, 1), b3 + hstepB);
            PG8_WAIT_V(6); PG8_BAR; PG8_MMA(1, 1, At, B1); PG8_BAR;
        }
        if constexpr (PG_PROBE) { const unsigned pg_t1_ = (unsigned)__builtin_amdgcn_s_memrealtime(); if (wid == 0 && lane_now() == 0) { volatile LAS unsigned* pm_ = (volatile LAS unsigned*)(lds + LDS_MISC); pm_[3401] = pm_[3401] + (pg_t1_ - pg_t0_); } }
        if constexpr (FP8) asm volatile("s_nop 15\n\ts_nop 15" ::: "memory");
        { int fr2 = fr, fq2 = fq; asm volatile("" : "+v"(fr2), "+v"(fq2));
          E(acc, cur, wr, wc, fr2, fq2, side + (ui % 3) * SIDE_BYTES);
          if ((DUPSEL == 16 && FP8 && !GATHER) || (DUPSEL == 17 && FP8 && GATHER) || (DUPSEL == 18 && !FP8)) { asm volatile("" : "+v"(fr2), "+v"(fq2)); E(acc, cur, wr, wc, fr2, fq2, side + (ui % 3) * SIDE_BYTES); } }
        if (!has_next) break;
#pragma unroll
        for (int a = 0; a < 2; ++a)
#pragma unroll
            for (int b = 0; b < 2; ++b)
#pragma unroll
                for (int m = 0; m < 4; ++m)
#pragma unroll
                    for (int n = 0; n < 2; ++n) acc[a][b][m][n] = (f32x4){0.f, 0.f, 0.f, 0.f};
        cur = nxt; cA = nA; cB = nB; ++ui;
#pragma unroll
        for (int h = 0; h < 2; ++h)
#pragma unroll
            for (int i = 0; i < 2; ++i) cvo[h][i] = nvo[h][i];
    }
    PG8_WAIT_V(0);
    if (wr == 0) PG8_BAR;
    PG8_BAR;
#undef PG8_SA
#undef PG8_SB
#undef PG8_GLDS
#undef PG8_STAGE_A
#undef PG8_STAGE_B
#undef PG8_LDA
#undef PG8_LDB
#undef PG8_MMA
#undef PG8_WAIT_V
#undef PG8_WAIT_L
#undef PG8_BAR
#undef PG8_SCHED
#undef PG8_LOADVO
#undef PG8_SIDE_DMA
#undef PG8_GLDS4
}

struct SchedDense {
    int nM, nN, G, c, g; const char* A; const char* B; size_t a_tstep, b_tstep; int latent_only = 0;
    __device__ __forceinline__ bool next(int i, Unit& u) const {
        const int nwg = nM * nN; const long L = (long)i * G + c; if (L >= nwg) return false;
        int wgid = (int)L; { const int q = nwg / 8, r = nwg % 8, xcd = wgid % 8, off = wgid / 8; wgid = (xcd < r ? xcd * (q + 1) : r * (q + 1) + (xcd - r) * q) + off; }
        const int nig = 8 * nN, gid = wgid / nig, fm = gid * 8, gsz = (nM - fm) < 8 ? (nM - fm) : 8;
        u.pm = fm + ((wgid % nig) % gsz); u.pn = (wgid % nig) / gsz; u.g = g; u.e = 0; u.nvalid = 256; u.pad = 0;
        if (latent_only) u.pm = (u.pm >> 3) * 9 + 1 + (u.pm & 7);
        u.A = A + (size_t)u.pm * a_tstep; u.B = B + (size_t)u.pn * b_tstep; u.rows = nullptr; u.gates = nullptr; u.bias0 = nullptr; u.bias1 = nullptr; return true;
    }
};
struct SchedDual {
    int nM, nN0, nN1, G, c; const char* A0; const char* A1; const char* B0; const char* B1; size_t a_tstep, b_tstep;
    __device__ __forceinline__ bool next(int i, Unit& u) const {
        const int n0 = nM * nN0, n1 = nM * nN1; int L = i * G + c; if (L >= n0 + n1) return false;
        const int g = (L >= n0) ? 1 : 0; if (g) L -= n0; const int nN = g ? nN1 : nN0;
        u.pm = L / nN; u.pn = L % nN; u.g = g; u.e = 0; u.nvalid = 256; u.pad = 0;
        u.A = (g ? A1 : A0) + (size_t)u.pm * a_tstep; u.B = (g ? B1 : B0) + (size_t)u.pn * b_tstep; u.rows = nullptr; u.gates = nullptr; u.bias0 = nullptr; u.bias1 = nullptr; return true;
    }
};
struct SchedMoE {
    const LAS int* bb; const LAS int* cnt; const LAS int* be; int NT, G, c; const char* Acompact; size_t a_tstep; const char* W; size_t w_estep, w_tstep; const int* slot_tok; const float* slot_gate;
    const float* bias; int bias_estride, bias_seg1;
    int bias_pnstep;
    __device__ __forceinline__ bool next(int i, Unit& u) const {
        const int L = i * G + c; const int blk = L / NT, pn = L % NT;
        if (blk >= uni(bb[32])) return false;
        const int e = uni(be[blk]);
        const int rank0 = (blk - uni(bb[e])) * 256; int nv = uni(cnt[e]) - rank0; nv = nv > 256 ? 256 : nv;
        u.pm = blk; u.pn = pn; u.g = 0; u.e = e; u.nvalid = nv; u.pad = 0;
        u.A = unip(Acompact + (size_t)blk * a_tstep); u.B = unip(W + (size_t)e * w_estep + (size_t)pn * w_tstep);
        u.rows = (const int*)unip((const char*)(slot_tok + (size_t)e * CAP + rank0)); u.gates = (const float*)unip((const char*)(slot_gate + (size_t)e * CAP + rank0));
        u.bias0 = (const float*)unip((const char*)(bias + (size_t)e * bias_estride + pn * bias_pnstep)); u.bias1 = u.bias0 + bias_seg1; return true;
    }
};

__device__ __forceinline__ unsigned pk4_fp8(float a, float b, float c, float d) { int w = 0; w = __builtin_amdgcn_cvt_pk_fp8_f32(a, b, w, false); w = __builtin_amdgcn_cvt_pk_fp8_f32(c, d, w, true); return (unsigned)w; }
struct EpiBf16 {
    bf16_t* O; int ldc; float oscale = 1.0f;
    __device__ __forceinline__ void operator()(const f32x4 (&acc)[2][2][4][2], const Unit& u, int wr, int wc, int fr, int fq, LAS unsigned char* = nullptr) const {
        const int row0 = u.pm * BM + wr * 64 + fr, col0 = u.pn * BM + wc * 32 + 8 * fq;
#pragma unroll
        for (int ai = 0; ai < 2; ++ai)
#pragma unroll
            for (int m = 0; m < 4; ++m) { bf16_t* rowp = O + (size_t)(row0 + ai * HALF + m * 16) * ldc + col0;
#pragma unroll
                for (int bj = 0; bj < 2; ++bj) { const f32x4 v0 = acc[ai][bj][m][0] * oscale, v1 = acc[ai][bj][m][1] * oscale;
                    u32x4 w; w.x = cvt_pk_bf16(v0[0], v0[1]); w.y = cvt_pk_bf16(v0[2], v0[3]); w.z = cvt_pk_bf16(v1[0], v1[1]); w.w = cvt_pk_bf16(v1[2], v1[3]);
                    *(u32x4*)(rowp + bj * HALF) = w; } }
    }
};
struct EpiBf16U {
    bf16_t* O; int ldc; float oscale; bf16_t* UT;
    __device__ __forceinline__ void operator()(const f32x4 (&acc)[2][2][4][2], const Unit& u, int wr, int wc, int fr, int fq, LAS unsigned char* = nullptr) const {
        if (u.pn < 4) { EpiBf16 e; e.O = O; e.ldc = ldc; e.oscale = oscale; e(acc, u, wr, wc, fr, fq); return; }
        const int row0 = u.pm * BM + wr * 64 + fr, ch0 = (u.pn - 4) * BM + wc * 32 + 8 * fq;
        const int b = (u.pm * BM) / TPB, t0 = row0 - b * TPB;
#pragma unroll
        for (int ai = 0; ai < 2; ++ai)
#pragma unroll
            for (int m = 0; m < 4; ++m) { const int t = t0 + ai * HALF + m * 16;
#pragma unroll
                for (int bj = 0; bj < 2; ++bj) { const f32x4 v0 = acc[ai][bj][m][0] * oscale, v1 = acc[ai][bj][m][1] * oscale; const int ch = ch0 + bj * HALF;
                    u32x4 w; w.x = cvt_pk_bf16(v0[0], v0[1]); w.y = cvt_pk_bf16(v0[2], v0[3]); w.z = cvt_pk_bf16(v1[0], v1[1]); w.w = cvt_pk_bf16(v1[2], v1[3]);
                    *(u32x4*)(UT + ((((size_t)(ch >> 4) * TPB + t) * 16 + b) * 16 + (ch & 8))) = w; } }
    }
};
struct EpiFp8 {
    unsigned char* O; int ldc; float oscale;
    __device__ __forceinline__ void operator()(const f32x4 (&acc)[2][2][4][2], const Unit& u, int wr, int wc, int fr, int fq, LAS unsigned char* = nullptr) const {
        const int row0 = u.pm * BM + wr * 64 + fr, col0 = u.pn * BM + wc * 32 + 8 * fq;
#pragma unroll
        for (int ai = 0; ai < 2; ++ai)
#pragma unroll
            for (int m = 0; m < 4; ++m) { unsigned char* rowp = O + (size_t)(row0 + ai * HALF + m * 16) * ldc + col0;
#pragma unroll
                for (int bj = 0; bj < 2; ++bj) { const f32x4 v0 = acc[ai][bj][m][0] * oscale, v1 = acc[ai][bj][m][1] * oscale;
                    u32x2 w; w.x = pk4_fp8(v0[0], v0[1], v0[2], v0[3]); w.y = pk4_fp8(v1[0], v1[1], v1[2], v1[3]);
                    *(u32x2*)(rowp + bj * HALF) = w; } }
    }
};
struct EpiFp8P16 {
    unsigned char* O; int ldc; float oscale;
    __device__ __forceinline__ void operator()(const f32x4 (&acc)[2][2][4][2], const Unit& u, int wr, int wc, int fr, int fq, LAS unsigned char* = nullptr) const {
        const int row0 = u.pm * BM + wr * 64 + fr, col0 = u.pn * BM + wc * 64 + 16 * fq;
#pragma unroll
        for (int ai = 0; ai < 2; ++ai)
#pragma unroll
            for (int m = 0; m < 4; ++m) { u32x4 w;
#pragma unroll
                for (int bj = 0; bj < 2; ++bj) { const f32x4 v0 = acc[ai][bj][m][0] * oscale, v1 = acc[ai][bj][m][1] * oscale; w[2 * bj] = pk4_fp8(v0[0], v0[1], v0[2], v0[3]); w[2 * bj + 1] = pk4_fp8(v1[0], v1[1], v1[2], v1[3]); }
                *(u32x4*)(O + (size_t)(row0 + ai * HALF + m * 16) * ldc + col0) = w; }
    }
};
struct EpiGlu {
    const bf16_t* ZG; const float* bias; unsigned char* OL;
    __device__ __forceinline__ void operator()(const f32x4 (&acc)[2][2][4][2], const Unit& u, int wr, int wc, int fr, int fq, LAS unsigned char* = nullptr) const {
        const int row0 = u.pm * BM + wr * 64 + fr, col0 = u.pn * BM + wc * 32 + 8 * fq;
        f32x4 bv[2][2];
#pragma unroll
        for (int bj = 0; bj < 2; ++bj)
#pragma unroll
            for (int n = 0; n < 2; ++n) bv[bj][n] = *(const f32x4*)(bias + col0 + bj * HALF + 4 * n);
        u32x4 zwv[2][4][2];
#pragma unroll
        for (int ai = 0; ai < 2; ++ai)
#pragma unroll
            for (int m = 0; m < 4; ++m)
#pragma unroll
                for (int bj = 0; bj < 2; ++bj) zwv[ai][m][bj] = *(const u32x4*)(ZG + (size_t)(row0 + ai * HALF + m * 16) * 512 + col0 + bj * HALF);
#pragma unroll
        for (int ai = 0; ai < 2; ++ai)
#pragma unroll
            for (int m = 0; m < 4; ++m) { const int row = row0 + ai * HALF + m * 16;
#pragma unroll
                for (int bj = 0; bj < 2; ++bj) { const u32x4 zw = zwv[ai][m][bj];
                    const float z[8] = {bflo(zw.x), bfhi(zw.x), bflo(zw.y), bfhi(zw.y), bflo(zw.z), bfhi(zw.z), bflo(zw.w), bfhi(zw.w)}; float o[8];
#pragma unroll
                    for (int n = 0; n < 2; ++n)
#pragma unroll
                        for (int j = 0; j < 4; ++j) { const float a = acc[ai][bj][m][n][j] + bv[bj][n][j]; o[n * 4 + j] = 16.0f * z[n * 4 + j] * __builtin_amdgcn_rcpf(1.0f + __expf(-a)); }
                    u32x2 w; w.x = pk4_fp8(o[0], o[1], o[2], o[3]); w.y = pk4_fp8(o[4], o[5], o[6], o[7]);
                    *(u32x2*)(OL + (size_t)row * 1024 + 512 + col0 + bj * HALF) = w; } }
    }
};
struct EpiBf16Dual {
    bf16_t* O0; int ldc0; bf16_t* O1; int ldc1;
    __device__ __forceinline__ void operator()(const f32x4 (&acc)[2][2][4][2], const Unit& u, int wr, int wc, int fr, int fq, LAS unsigned char* = nullptr) const {
        EpiBf16 e; e.O = u.g ? O1 : O0; e.ldc = u.g ? ldc1 : ldc0; e(acc, u, wr, wc, fr, fq);
    }
};
constexpr float WSCALE = 64.0f, WSCALE_INV = 1.0f / 64.0f;
struct EpiSwiglu {
    unsigned char* Z; const float* bias;
    __device__ __forceinline__ void operator()(const f32x4 (&acc)[2][2][4][2], const Unit& u, int wr, int wc, int fr, int fq, LAS unsigned char* sd) const {
        const int row0 = u.pm * BM + wr * 64 + fr, c0 = u.pn * 128 + wc * 32 + 8 * fq;
        const LAS float* be = (const LAS float*)(sd + 1024) + wc * 32 + 8 * fq;
        const f32x4 bg0 = *(const LAS f32x4*)(be), bg1 = *(const LAS f32x4*)(be + 4), bl0 = *(const LAS f32x4*)(be + 128), bl1 = *(const LAS f32x4*)(be + 132);
#pragma unroll
        for (int ai = 0; ai < 2; ++ai)
#pragma unroll
            for (int m = 0; m < 4; ++m) {
                float o[8];
#pragma unroll
                for (int n = 0; n < 2; ++n) { const f32x4 ga = acc[ai][0][m][n], la = acc[ai][1][m][n], bg = n ? bg1 : bg0, bl = n ? bl1 : bl0;
#pragma unroll
                    for (int j = 0; j < 4; j += 2) {
                        f32x2 g2 = (f32x2){ga[j], ga[j + 1]} * WSCALE_INV + (f32x2){bg[j], bg[j + 1]}, l2 = (f32x2){la[j], la[j + 1]} * WSCALE_INV + (f32x2){bl[j], bl[j + 1]};
                        g2.x = __builtin_amdgcn_fmed3f(g2.x, -24.0f, 7.0f); g2.y = __builtin_amdgcn_fmed3f(g2.y, -24.0f, 7.0f); l2.x = __builtin_amdgcn_fmed3f(l2.x, -7.0f, 7.0f); l2.y = __builtin_amdgcn_fmed3f(l2.y, -7.0f, 7.0f);
                        const f32x2 t2 = g2 * -2.4554669595930157f; f32x2 a2; a2.x = __builtin_amdgcn_exp2f(t2.x); a2.y = __builtin_amdgcn_exp2f(t2.y); a2 = a2 + 1.0f;
                        const float r = __builtin_amdgcn_rcpf(a2.x * a2.y);
                        const f32x2 o2 = g2 * (l2 + 1.0f) * ((f32x2){a2.y, a2.x} * r);
                        o[n * 4 + j] = o2.x; o[n * 4 + j + 1] = o2.y; } }
                u32x2 w; w.x = pk4_fp8(o[0], o[1], o[2], o[3]); w.y = pk4_fp8(o[4], o[5], o[6], o[7]);
                *(u32x2*)(Z + (size_t)(row0 + ai * HALF + m * 16) * 1024 + c0) = w; }
    }
};
constexpr float Y2SCALE = 32.0f, Y2SCALE_INV = 1.0f / 32.0f;
struct EpiMoeOut {
    unsigned char* Y2; const float* bias;
    __device__ __forceinline__ void operator()(const f32x4 (&acc)[2][2][4][2], const Unit& u, int wr, int wc, int fr, int fq, LAS unsigned char* sd) const {
        const int r0 = wr * 64 + fr, col0 = u.pn * BM + wc * 64 + 16 * fq;
        const LAS float* be = (const LAS float*)(sd + 1024) + wc * 64 + 16 * fq;
        const LAS float* gts = (const LAS float*)(sd + 2048);
        f32x4 bv[2][2];
#pragma unroll
        for (int bj = 0; bj < 2; ++bj)
#pragma unroll
            for (int n = 0; n < 2; ++n) bv[bj][n] = *(const LAS f32x4*)(be + 8 * bj + 4 * n);
#pragma unroll
        for (int ai = 0; ai < 2; ++ai)
#pragma unroll
            for (int m = 0; m < 4; ++m) { const int r = r0 + ai * HALF + m * 16; const float gt = gts[r] * Y2SCALE;
                u32x4 w;
#pragma unroll
                for (int bj = 0; bj < 2; ++bj) { const f32x4 v0 = (acc[ai][bj][m][0] * WSCALE_INV + bv[bj][0]) * gt, v1 = (acc[ai][bj][m][1] * WSCALE_INV + bv[bj][1]) * gt;
                    w[2 * bj] = pk4_fp8(v0[0], v0[1], v0[2], v0[3]); w[2 * bj + 1] = pk4_fp8(v1[0], v1[1], v1[2], v1[3]); }
                *(u32x4*)(Y2 + (size_t)(u.pm * BM + r) * 1024 + col0) = w; }
    }
};
}


namespace att {
constexpr int NW = 8, QBLK = 32, KVBLK = 64, DV = 128;
typedef short s16x4 __attribute__((ext_vector_type(4)));
typedef float f32x16 __attribute__((ext_vector_type(16)));
#define SBAR() __builtin_amdgcn_sched_barrier(0)
__device__ __forceinline__ int crow(int r, int hi) { return (r & 3) + 8 * (r >> 2) + 4 * hi; }
__device__ __forceinline__ unsigned cvtpk(float lo, float hi) { unsigned r; asm volatile("v_cvt_pk_bf16_f32 %0, %1, %2" : "=v"(r) : "v"(lo), "v"(hi)); return r; }
template <int DK> __device__ __forceinline__ int kswz(int row, int colB) { return row * (DK * 2) + (colB ^ ((row & 7) << 4)); }
constexpr float THR = 8.f;

template <int DK, bool WINDOW>
__device__ __forceinline__ void partialSM(f32x16& p0, f32x16& p1, float& m_reg, float& mn, float& alpha, const bool masked, const int mbase) {
  constexpr float SCALE = (DK == 128) ? 0.088388347648318440f : 0.072168783648703220f;
  constexpr float C = SCALE * 1.4426950408889634f;
  if (WINDOW && masked) {
#pragma unroll
    for (int r = 0; r < 16; ++r) { const int d0 = mbase + (r & 3) + 8 * (r >> 2); const int d1 = d0 + 32;
      p0[r] = (d0 < -128 || d0 > 128) ? -1e30f : p0[r]; p1[r] = (d1 < -128 || d1 > 128) ? -1e30f : p1[r]; }
  }
  float pmax = p0[0];
#pragma unroll
  for (int r = 1; r < 16; ++r) pmax = fmaxf(pmax, p0[r]);
#pragma unroll
  for (int r = 0; r < 16; ++r) pmax = fmaxf(pmax, p1[r]);
  { auto rr = __builtin_amdgcn_permlane32_swap(__float_as_uint(pmax), __float_as_uint(pmax), false, false);
    pmax = fmaxf(__uint_as_float(rr[0]), __uint_as_float(rr[1])); }
  if (__builtin_expect(__all(pmax - m_reg <= THR / SCALE), 1)) { mn = m_reg; alpha = 1.f; }
  else { mn = fmaxf(m_reg, pmax); alpha = __builtin_amdgcn_exp2f((m_reg - mn) * C); m_reg = mn; }
  const float mnC = -mn * C;
#pragma unroll
  for (int r = 0; r < 16; ++r) p0[r] = fmaf(p0[r], C, mnC);
#pragma unroll
  for (int r = 0; r < 16; ++r) p1[r] = fmaf(p1[r], C, mnC);
#pragma unroll
  for (int r = 0; r < 16; ++r) p0[r] = __builtin_amdgcn_exp2f(p0[r]);
}
__device__ __forceinline__ void finishSM(f32x16& p0, f32x16& p1, float alpha, float& l_reg, bf16x8& pa0, bf16x8& pa1, bf16x8& pa2, bf16x8& pa3) {
#pragma unroll
  for (int r = 0; r < 16; ++r) p1[r] = __builtin_amdgcn_exp2f(p1[r]);
  float ps = 0;
#pragma unroll
  for (int r = 0; r < 16; ++r) ps += p0[r];
#pragma unroll
  for (int r = 0; r < 16; ++r) ps += p1[r];
  { auto rr = __builtin_amdgcn_permlane32_swap(__float_as_uint(ps), __float_as_uint(ps), false, false);
    ps = __uint_as_float(rr[0]) + __uint_as_float(rr[1]); }
  l_reg = l_reg * alpha + ps;
#define PK4(P, BASE, OUT) do { unsigned a0 = cvtpk(P[BASE + 0], P[BASE + 1]), a1 = cvtpk(P[BASE + 2], P[BASE + 3]);   \
    unsigned b0 = cvtpk(P[BASE + 4], P[BASE + 5]), b1 = cvtpk(P[BASE + 6], P[BASE + 7]);                              \
    auto r0 = __builtin_amdgcn_permlane32_swap(a0, b0, false, false); auto r1 = __builtin_amdgcn_permlane32_swap(a1, b1, false, false); \
    u32x4 w = {r0[0], r1[0], r0[1], r1[1]}; OUT = *reinterpret_cast<bf16x8*>(&w); } while (0)
  PK4(p0, 0, pa0); PK4(p0, 8, pa1); PK4(p1, 0, pa2); PK4(p1, 8, pa3);
#undef PK4
}
template <int DK>
__device__ __forceinline__ void qkt(f32x16& p0, f32x16& p1, const LAS char* Ks, const bf16x8* qr, int r32, int hi) {
  p0 = f32x16{}; p1 = f32x16{};
#pragma unroll
  for (int d0 = 0; d0 < DK / 16; ++d0) { const int cb = (d0 * 16 + hi * 8) * 2;
    const bf16x8 b0 = *reinterpret_cast<const LAS bf16x8*>(Ks + kswz<DK>(r32, cb));
    const bf16x8 b1 = *reinterpret_cast<const LAS bf16x8*>(Ks + kswz<DK>(32 + r32, cb));
    p0 = __builtin_amdgcn_mfma_f32_32x32x16_bf16(b0, qr[d0], p0, 0, 0, 0);
    p1 = __builtin_amdgcn_mfma_f32_32x32x16_bf16(b1, qr[d0], p1, 0, 0, 0); }
}
__device__ __forceinline__ int v_st(int k, int c) { const int kk = (k & ~0xC) | ((k & 4) << 1) | ((k & 8) >> 1); return ((kk >> 3) * 4 + (c >> 5)) * 512 + ((kk & 7) * 32 + (c & 31)) * 2; }
__device__ __forceinline__ int v_rd_base(int lane) { return ((lane & 3) << 3) | (((lane >> 2) & 3) << 6) | (((lane >> 4) & 1) << 5) | (((lane >> 5) & 1) << 8); }
constexpr int v_rd_off(int d0, int ks, int half) { return d0 * 512 + ks * 4096 + half * 2048; }
template <int OFF> __device__ __forceinline__ s16x4 tr_read(int vb) {
  s16x4 r; asm volatile("ds_read_b64_tr_b16 %0, %1 offset:%2" : "=&v"(r) : "v"(vb), "i"(OFF) : "memory"); return r;
}
template <int D0> __device__ __forceinline__ void pv_one(f32x16& od, int vb, bf16x8 pa0, bf16x8 pa1, bf16x8 pa2, bf16x8 pa3) {
  const s16x4 l0 = tr_read<v_rd_off(D0, 0, 0)>(vb), h0 = tr_read<v_rd_off(D0, 0, 1)>(vb), l1 = tr_read<v_rd_off(D0, 1, 0)>(vb), h1 = tr_read<v_rd_off(D0, 1, 1)>(vb);
  const s16x4 l2 = tr_read<v_rd_off(D0, 2, 0)>(vb), h2 = tr_read<v_rd_off(D0, 2, 1)>(vb), l3 = tr_read<v_rd_off(D0, 3, 0)>(vb), h3 = tr_read<v_rd_off(D0, 3, 1)>(vb);
  asm volatile("s_waitcnt lgkmcnt(0)" ::: "memory"); SBAR();
#define PK(L, H) (bf16x8){L[0], L[1], L[2], L[3], H[0], H[1], H[2], H[3]}
  od = __builtin_amdgcn_mfma_f32_32x32x16_bf16(pa0, PK(l0, h0), od, 0, 0, 0);
  od = __builtin_amdgcn_mfma_f32_32x32x16_bf16(pa1, PK(l1, h1), od, 0, 0, 0);
  od = __builtin_amdgcn_mfma_f32_32x32x16_bf16(pa2, PK(l2, h2), od, 0, 0, 0);
  od = __builtin_amdgcn_mfma_f32_32x32x16_bf16(pa3, PK(l3, h3), od, 0, 0, 0);
#undef PK
}
__device__ __forceinline__ void pv_d0(f32x16* o, int vb, bf16x8 pa0, bf16x8 pa1, bf16x8 pa2, bf16x8 pa3) {
  pv_one<0>(o[0], vb, pa0, pa1, pa2, pa3); pv_one<1>(o[1], vb, pa0, pa1, pa2, pa3); pv_one<2>(o[2], vb, pa0, pa1, pa2, pa3); pv_one<3>(o[3], vb, pa0, pa1, pa2, pa3);
}

struct Unit {
  const bf16_t* Q; int ldq;
  const bf16_t* K; int ldk;
  const bf16_t* KR; int ldkr;
  const bf16_t* V; int ldv;
  unsigned char* O; int ldo;
  int NT;
  int kofs;
  int q0;
  float sink; int has_sink;
  const float* rope; int rope_row, rope_col_base;
};

template <int DK, bool WINDOW, int SD, bool SIMPLE>
__device__ __forceinline__ void attn_unit(const Unit& U, LAS char* lds, const int wid0) {
  constexpr int SHM_V = KVBLK * DV * 2, SHM_K = KVBLK * DK * 2;
  constexpr float SCALE = (DK == 128) ? 0.088388347648318440f : 0.072168783648703220f;
  constexpr float C = SCALE * 1.4426950408889634f;
  constexpr int NKC = (DK == 128) ? 2 : 3;
  const int lane = lane_now(); const int wid = wid0; const int tid = wid0 * 64 + lane; const int r32 = lane & 31, hi = lane >> 5;
  LAS char* V_lds = lds; LAS char* K_lds = lds + 2 * SHM_V;
  LAS float* wsf = (LAS float*)(lds + 2 * SHM_V + 2 * SHM_K) + wid * 64; LAS float* li_l = wsf; LAS float* al_l = wsf + 32;
  float m_reg = -1e30f, l_reg = 0; f32x16 o[4] = {}; bf16x8 qr[DK / 16];
  const bf16_t* Qw = U.Q + (long)(wid * QBLK + r32) * U.ldq + hi * 8;
#pragma unroll
  for (int d0 = 0; d0 < DK / 16; ++d0) qr[d0] = *reinterpret_cast<const bf16x8*>(Qw + d0 * 16);
  if (DK == 192 && U.rope != nullptr) {
    const int pos = U.q0 + wid * QBLK + r32; const int ri = pos >> 6, ci = pos & 63;
#pragma unroll
    for (int hf = 0; hf < 2; ++hf) { const float* tp = U.rope + ((hf ? ci : ri) * 16 + hi * 8) * 2;
      bf16x8 x1 = qr[8 + 2 * hf], x2 = qr[9 + 2 * hf];
#pragma unroll
      for (int i = 0; i < 8; ++i) { const float c = tp[2 * i], sn = tp[2 * i + 1]; const float a = bf2f((unsigned short)x1[i]), b = bf2f((unsigned short)x2[i]);
        x1[i] = (short)f2bf(a * c - b * sn); x2[i] = (short)f2bf(b * c + a * sn); }
      qr[8 + 2 * hf] = x1; qr[9 + 2 * hf] = x2; }
  }
  const int sr = tid >> 4, sc = (tid & 15) * 8, vst0 = v_st(sr, sc), vst1 = v_st(32 + sr, sc);
  int krw[NKC], kcs[NKC], kdst[NKC];
#pragma unroll
  for (int i = 0; i < NKC; ++i) { const int id = tid + 512 * i; if (DK == 128) { krw[i] = (i == 0) ? sr : 32 + sr; kcs[i] = sc; } else { krw[i] = id / 24; kcs[i] = (id % 24) * 8; }
    kdst[i] = kswz<DK>(krw[i], kcs[i] * 2); }
  const int vb0 = (int)(uintptr_t)V_lds + v_rd_base(lane);
  struct { bf16x8 vs0, vs1, ks[NKC]; } sr_[SD];
  constexpr int SO = SD - 1;
  const int kofs = U.kofs;
#define KROW(j) (64 * (j) + (((j) >= 4) ? kofs : 0))
#define SLOAD(i, jt) do { const int _k0 = KROW(jt); sr_[i].vs0 = *reinterpret_cast<const bf16x8*>(&U.V[(long)(_k0 + sr) * U.ldv + sc]); sr_[i].vs1 = *reinterpret_cast<const bf16x8*>(&U.V[(long)(_k0 + 32 + sr) * U.ldv + sc]); \
    _Pragma("unroll") for (int _c = 0; _c < NKC; ++_c) { if (DK == 128 || kcs[_c] < 128) sr_[i].ks[_c] = *reinterpret_cast<const bf16x8*>(&U.K[(long)(_k0 + krw[_c]) * U.ldk + kcs[_c]]); \
      else sr_[i].ks[_c] = *reinterpret_cast<const bf16x8*>(&U.KR[(long)(_k0 + krw[_c]) * U.ldkr + (kcs[_c] - 128)]); } } while (0)
#define SWRITE(b, i) do { *(LAS bf16x8*)(V_lds + (b) * SHM_V + vst0) = sr_[i].vs0; *(LAS bf16x8*)(V_lds + (b) * SHM_V + vst1) = sr_[i].vs1; \
    _Pragma("unroll") for (int _c = 0; _c < NKC; ++_c) *(LAS bf16x8*)(K_lds + (b) * SHM_K + kdst[_c]) = sr_[i].ks[_c]; } while (0)
#define SWAIT() asm volatile("s_waitcnt vmcnt(%0)" :: "n"(SD == 2 ? 2 + NKC : 0) : "memory")
#define RESC(a) do { if (__any((a) < 1.f)) { if (hi == 0) al_l[r32] = (a); asm volatile("s_waitcnt lgkmcnt(0)" ::: "memory"); \
    _Pragma("unroll") for (int d = 0; d < 4; ++d) _Pragma("unroll") for (int r = 0; r < 16; ++r) o[d][r] *= al_l[crow(r, hi)]; } } while (0)
  const int qpos = U.q0 + wid * QBLK + r32;
#define MBASE(jt) (kofs + 64 * (jt) - 256 - qpos + 4 * hi)
  bf16x8 pa0, pa1, pa2, pa3; const int NT = U.NT;
  if constexpr (SIMPLE) {
    f32x16 p0, p1; float mn, al;
    SLOAD(0, 0); asm volatile("s_waitcnt vmcnt(0)" ::: "memory"); SWRITE(0, 0); __syncthreads();
    for (int j = 0; j < NT; ++j) {
      const int bsel = j & 1;
      if (j + 1 < NT) SLOAD(0, j + 1);
      SBAR(); qkt<DK>(p0, p1, K_lds + bsel * SHM_K, qr, r32, hi);
      partialSM<DK, WINDOW>(p0, p1, m_reg, mn, al, j >= 4, MBASE(j));
      RESC(al);
      finishSM(p0, p1, al, l_reg, pa0, pa1, pa2, pa3); SBAR();
      pv_d0(o, vb0 + bsel * SHM_V, pa0, pa1, pa2, pa3);
      if (j + 1 < NT) { asm volatile("s_waitcnt vmcnt(0)" ::: "memory"); SWRITE(bsel ^ 1, 0); }
      __syncthreads();
    }
  } else {
  f32x16 pA0, pA1, pB0, pB1; float mnA, mnB, alA, alB;
  SLOAD(0, 0); asm volatile("s_waitcnt vmcnt(0)" ::: "memory"); SWRITE(0, 0); __syncthreads();
  qkt<DK>(pA0, pA1, K_lds, qr, r32, hi); partialSM<DK, WINDOW>(pA0, pA1, m_reg, mnA, alA, false, 0);
  SLOAD(SO, 1); if (SD == 2 && 2 < NT) SLOAD(0, 2);
  SWAIT(); SWRITE(1, SO); __syncthreads();
  for (int j = 1; j + 1 < NT; j += 2) {
    SBAR(); qkt<DK>(pB0, pB1, K_lds + SHM_K, qr, r32, hi);
    finishSM(pA0, pA1, alA, l_reg, pa0, pa1, pa2, pa3); SBAR();
    SLOAD(SO, j + SD); SBAR();
    pv_d0(o, vb0, pa0, pa1, pa2, pa3); partialSM<DK, WINDOW>(pB0, pB1, m_reg, mnB, alB, j >= 4, MBASE(j));
    __syncthreads(); SWAIT(); SWRITE(0, 0);
    RESC(alB); __syncthreads();
    SBAR(); qkt<DK>(pA0, pA1, K_lds, qr, r32, hi);
    finishSM(pB0, pB1, alB, l_reg, pa0, pa1, pa2, pa3); SBAR();
    if (SD == 1 || j + 3 < NT) SLOAD(0, j + 1 + SD); SBAR();
    pv_d0(o, vb0 + SHM_V, pa0, pa1, pa2, pa3); partialSM<DK, WINDOW>(pA0, pA1, m_reg, mnA, alA, j + 1 >= 4, MBASE(j + 1));
    __syncthreads(); SWAIT(); SWRITE(1, SO);
    RESC(alA); __syncthreads();
  }
  SBAR(); qkt<DK>(pB0, pB1, K_lds + SHM_K, qr, r32, hi);
  finishSM(pA0, pA1, alA, l_reg, pa0, pa1, pa2, pa3); SBAR();
  pv_d0(o, vb0, pa0, pa1, pa2, pa3); partialSM<DK, WINDOW>(pB0, pB1, m_reg, mnB, alB, NT - 1 >= 4, MBASE(NT - 1));
  __syncthreads(); RESC(alB);
  finishSM(pB0, pB1, alB, l_reg, pa0, pa1, pa2, pa3); SBAR();
  pv_d0(o, vb0 + SHM_V, pa0, pa1, pa2, pa3);
  }
  if (WINDOW && U.has_sink) l_reg += __builtin_amdgcn_exp2f(U.sink * 1.4426950408889634f - m_reg * C);
  if (hi == 0) li_l[r32] = l_reg; asm volatile("s_waitcnt lgkmcnt(0)" ::: "memory");
  float rli[16];
#pragma unroll
  for (int r = 0; r < 16; ++r) rli[r] = __builtin_amdgcn_rcpf(li_l[crow(r, hi)]);
  __syncthreads();
  { LAS unsigned char* ot = (LAS unsigned char*)V_lds + wid * 4096;
#pragma unroll
    for (int r = 0; r < 16; ++r) { const int orow = crow(r, hi);
#pragma unroll
      for (int d0 = 0; d0 < 4; ++d0) { const float ov = o[d0][r] * rli[r] * 16.0f; ot[orow * 128 + d0 * 32 + r32] = (unsigned char)(__builtin_amdgcn_cvt_pk_fp8_f32(ov, ov, 0, false) & 0xff); } }
    asm volatile("s_waitcnt lgkmcnt(0)" ::: "memory");
    unsigned char* Ow = U.O + (long)(wid * QBLK + (lane >> 1)) * U.ldo + (lane & 1) * 64;
    const LAS unsigned char* os = ot + (lane >> 1) * 128 + (lane & 1) * 64;
#pragma unroll
    for (int q = 0; q < 4; ++q) *(u32x4*)(Ow + q * 16) = *(const LAS u32x4*)(os + q * 16); }
  __syncthreads();
#undef KROW
#undef SLOAD
#undef SWRITE
#undef SWAIT
#undef RESC
#undef MBASE
}
}

struct Args { const float* in[34]; float* out; unsigned char* ws; };

__device__ __forceinline__ void transpose_item(const float* W, int ldw, int K, bf16_t* WT, int k0, int n0, int drow0, LAS float* scr, int lane) {
#pragma unroll 32
    for (int i = 0; i < 32; ++i) { const int kk = 2 * i + (lane >> 5); scr[kk * 33 + (lane & 31)] = W[(size_t)(k0 + kk) * ldw + n0 + (lane & 31)]; }
    LDS_WAIT(); asm volatile("" ::: "memory");
    const int c = lane & 7;
#pragma unroll
    for (int j = 0; j < 4; ++j) { const int n = (lane >> 3) + 8 * j; const LAS float* s = scr + (8 * c) * 33 + n;
        u32x4 o; o.x = pk2(s[0 * 33], s[1 * 33]); o.y = pk2(s[2 * 33], s[3 * 33]); o.z = pk2(s[4 * 33], s[5 * 33]); o.w = pk2(s[6 * 33], s[7 * 33]);
        *(u32x4*)(WT + (size_t)(drow0 + n) * K + k0 + 8 * c) = o; }
    LDS_WAIT(); asm volatile("" ::: "memory");
}

__device__ __forceinline__ void transpose_item_fp8(const float* W, int ldw, int K, unsigned char* WT, int k0, int n0, int drow0, LAS float* scr, int lane) {
#pragma unroll 32
    for (int i = 0; i < 32; ++i) { const int kk = 2 * i + (lane >> 5); scr[kk * 33 + (lane & 31)] = W[(size_t)(k0 + kk) * ldw + n0 + (lane & 31)] * 64.0f; }
    LDS_WAIT(); asm volatile("" ::: "memory");
    const int c = lane & 7;
#pragma unroll
    for (int j = 0; j < 4; ++j) { const int n = (lane >> 3) + 8 * j; const LAS float* s = scr + (8 * c) * 33 + n;
        u32x2 o; o.x = pg8::pk4_fp8(s[0 * 33], s[1 * 33], s[2 * 33], s[3 * 33]); o.y = pg8::pk4_fp8(s[4 * 33], s[5 * 33], s[6 * 33], s[7 * 33]);
        *(u32x2*)(WT + (size_t)(drow0 + n) * K + k0 + 8 * c) = o; }
    LDS_WAIT(); asm volatile("" ::: "memory");
}
struct ConvHalf { const float* src; unsigned char* dst; int ldw; int drow[2]; };
__device__ __forceinline__ ConvHalf conv_half_of(const float* w_exp_in, const float* w_exp_out, unsigned char* WexpIn, unsigned char* WexpOut, int layer, int hidx) {
    const int g = hidx >> 1, hp = hidx & 1; ConvHalf c;
    if (g < 8192) { const int le = layer * 32 + (g >> 8), q = g & 255; const int k0 = (q >> 4) * 64, n0 = (q & 15) * 128 + 64 * hp;
        c.src = w_exp_in + (size_t)le * 1024 * 2048 + (size_t)k0 * 2048 + n0; c.ldw = 2048; c.dst = WexpIn + (size_t)le * 2048 * 1024 + k0;
#pragma unroll
        for (int sb = 0; sb < 2; ++sb) { const int nn = n0 + 32 * sb; c.drow[sb] = (nn < 1024) ? ((nn >> 7) * 256 + (nn & 127)) : (((nn - 1024) >> 7) * 256 + 128 + ((nn - 1024) & 127)); } }
    else { const int g2 = g - 8192; const int le = layer * 32 + (g2 >> 7), q = g2 & 127; const int k0 = (q >> 3) * 64, n0 = (q & 7) * 128 + 64 * hp;
        c.src = w_exp_out + (size_t)le * 1024 * 1024 + (size_t)k0 * 1024 + n0; c.ldw = 1024; c.dst = WexpOut + (size_t)le * 1024 * 1024 + k0; c.drow[0] = n0; c.drow[1] = n0 + 32; }
    return c;
}
#define CONV_LOAD(ch, wv) do { _Pragma("unroll") for (int sb_ = 0; sb_ < 2; ++sb_) _Pragma("unroll") for (int i_ = 0; i_ < 32; ++i_) { const int kk_ = 2 * i_ + (lane >> 5); wv[sb_][i_] = (ch).src[(size_t)kk_ * (ch).ldw + 32 * sb_ + (lane & 31)]; } } while (0)
#define CONV_STORE(ch, wv) do { _Pragma("unroll") for (int sb_ = 0; sb_ < 2; ++sb_) { \
        _Pragma("unroll") for (int i_ = 0; i_ < 32; ++i_) { const int kk_ = 2 * i_ + (lane >> 5); scr[kk_ * 33 + (lane & 31)] = wv[sb_][i_] * 64.0f; } \
        LDS_WAIT(); asm volatile("" ::: "memory"); \
        _Pragma("unroll") for (int j_ = 0; j_ < 4; ++j_) { const int n_ = (lane >> 3) + 8 * j_; const LAS float* sp_ = scr + (8 * (lane & 7)) * 33 + n_; \
            u32x2 o_; o_.x = pg8::pk4_fp8(sp_[0 * 33], sp_[1 * 33], sp_[2 * 33], sp_[3 * 33]); o_.y = pg8::pk4_fp8(sp_[4 * 33], sp_[5 * 33], sp_[6 * 33], sp_[7 * 33]); \
            *(u32x2*)((ch).dst + (size_t)((ch).drow[sb_] + n_) * 1024 + 8 * (lane & 7)) = o_; } \
        LDS_WAIT(); asm volatile("" ::: "memory"); } } while (0)
__device__ __forceinline__ void expert_conv_run(const float* w_exp_in, const float* w_exp_out, unsigned char* WexpIn, unsigned char* WexpOut, int layer, int h0, int nh, LAS float* scr, int lane) {
    float wa[2][32], wb[2][32];
    ConvHalf ca = conv_half_of(w_exp_in, w_exp_out, WexpIn, WexpOut, layer, h0), cb = ca;
    CONV_LOAD(ca, wa);
#pragma clang loop unroll(disable)
    for (int h = 0; h < nh; h += 2) {
        cb = conv_half_of(w_exp_in, w_exp_out, WexpIn, WexpOut, layer, h0 + (h + 1) * 8); CONV_LOAD(cb, wb);
        CONV_STORE(ca, wa);
        if (h + 2 < nh) { ca = conv_half_of(w_exp_in, w_exp_out, WexpIn, WexpOut, layer, h0 + (h + 2) * 8); CONV_LOAD(ca, wa); }
        CONV_STORE(cb, wb);
    }
}
__device__ __forceinline__ bool conv_group(int& r, const float* W, int nmat, int K, int N, bf16_t* WT, int ldrows, LAS float* scr, int lane) {
    const int per = (K / 64) * (N / 32); if (r >= nmat * per) { r -= nmat * per; return false; }
    const int mi = r / per, q = r % per, kb = q / (N / 32), nb = q % (N / 32);
    transpose_item(W + (size_t)mi * K * N, N, K, WT + (size_t)mi * ldrows * K, kb * 64, nb * 32, nb * 32, scr, lane); return true;
}

typedef const Args __attribute__((address_space(4))) CArgs;
#define PHASE_ARGS() CArgs* A_ = (CArgs*)__builtin_amdgcn_kernarg_segment_ptr(); asm volatile("" : "+s"(A_)); unsigned char* const ws = A_->ws; (void)ws; int Gp = G, vcup = vcu, bxp = bx; asm volatile("" : "+s"(Gp), "+s"(vcup), "+s"(bxp)); (void)Gp; (void)vcup; (void)bxp
#define IN(k) (A_->in[k])
#define WSP(T, off) ((T*)(ws + (off)))
__global__ void __launch_bounds__(NTHR, 2) fwd_kernel(Args args) {
    extern __shared__ __attribute__((aligned(16))) unsigned char lds_raw[];
    LAS unsigned char* lds = (LAS unsigned char*)lds_raw;
    const int G = gridDim.x; const int bx = blockIdx.x; const int vcu = (G % 8 == 0) ? (bx % 8) * (G / 8) + bx / 8 : bx;
    volatile LAS unsigned* MISC = (volatile LAS unsigned*)(lds + LDS_MISC);
    const int wave0 = __builtin_amdgcn_readfirstlane((int)threadIdx.x >> 6);
    for (int u = threadIdx.x; u < (LDS_BYTES - LDS_MISC) / 4; u += NTHR) MISC[u] = 0u;
    __syncthreads();
    XcdBarrier bar = xcd_barrier_post((unsigned*)(args.ws + WS_CTL) + CW_BAR, MISC + 0);
    bar.x = (unsigned)wave0;
#define GRID_BAR() do { xcd_barrier(bar); if (DUPSEL == 15) xcd_barrier(bar); } while (0)
#define PROBE_MULT 4u
#define PT_SAMPLE(id) do { if (PROBE_MASK != 0ull) { const unsigned pt_now_ = (unsigned)__builtin_amdgcn_s_memrealtime(); if (wave0 == 0 && lane_now() == 0) { const unsigned pt_last_ = MISC[3400]; if ((PROBE_MASK >> (id)) & 1ull) MISC[3401] = MISC[3401] + (pt_now_ - pt_last_); MISC[3400] = pt_now_; } } } while (0)
#define GRID_BARP(id) do { GRID_BAR(); PT_SAMPLE(id); } while (0)
    const int NGW = G * NWAVES;
    PT_SAMPLE(0);

    {
        PHASE_IDS(); PHASE_ARGS();
        const float* in_c = IN(1); const float* in_cctx = IN(3); const float* w_mod = IN(4); const float* b_mod = IN(5);
        const float* w_mix_out = IN(8); const float* w_exp_in = IN(11); const float* w_exp_out = IN(13);
        const float* w_in_ab = IN(15); const float* w_glu = IN(26); const float* w_in_cd = IN(28); const float* w_uq = IN(31); const float* w_ukv = IN(32);
        float* MOD = WSP(float, WS_MOD); unsigned char* WexpIn = WSP(unsigned char, WS_WEXPIN); unsigned char* WexpOut = WSP(unsigned char, WS_WEXPOUT); unsigned char* Wmix = WSP(unsigned char, WS_WMIX);
        unsigned char* WinAB = WSP(unsigned char, WS_WINAB); unsigned char* WinCD = WSP(unsigned char, WS_WINCD); bf16_t* Wglu = WSP(bf16_t, WS_WGLU); bf16_t* Wuq = WSP(bf16_t, WS_WUQ); bf16_t* Wukv = WSP(bf16_t, WS_WUKV);
        float* T32 = WSP(float, WS_ROPE); float* T16 = T32 + 64 * 32 * 2;
        LAS float* scr = (LAS float*)(lds + LDS_STAGE + wave * 16384);
        constexpr int I_MIX = 16 * 32;
        constexpr int NIT = 4 * I_MIX + 2 * (16 * 48 + 16 * 50 + 8 * 16 + 4 * 24 + 4 * 32);
        for (int rep_ = 0; rep_ < DUPN(1); ++rep_)
        for (int it = gw; it < NIT; it += NGW) {
            int r = it;
            if (r < 4 * I_MIX) { const int mi = r / I_MIX, q = r % I_MIX, kb = q / 32, nb = q % 32;
                transpose_item_fp8(w_mix_out + (size_t)mi * 1024 * 1024, 1024, 1024, Wmix + (size_t)mi * 1024 * 1024, kb * 64, nb * 32, nb * 32, scr, lane); continue; }
            r -= 4 * I_MIX;
            if (r < 2 * 16 * 48) { const int mi = r / (16 * 48), q = r % (16 * 48), kb = q / 48, nb = q % 48;
                transpose_item_fp8(w_in_ab + (size_t)mi * 1024 * 1536, 1536, 1024, WinAB + (size_t)mi * 1536 * 1024, kb * 64, nb * 32, nb * 32, scr, lane); continue; }
            r -= 2 * 16 * 48;
            if (r < 2 * 16 * 50) { const int mi = r / (16 * 50), q = r % (16 * 50), kb = q / 50, nb = q % 50;
                transpose_item_fp8(w_in_cd + (size_t)mi * 1024 * 1600, 1600, 1024, WinCD + (size_t)mi * 1792 * 1024, kb * 64, nb * 32, nb * 32, scr, lane); continue; }
            r -= 2 * 16 * 50;
            if (conv_group(r, w_glu, 2, 512, 512, Wglu, 512, scr, lane)) continue;
            if (conv_group(r, w_uq, 2, 256, 768, Wuq, 768, scr, lane)) continue;
            (void)conv_group(r, w_ukv, 2, 256, 1024, Wukv, 1024, scr, lane);
        }
        PT_SAMPLE(20);
        for (int i = vcu * NTHR + tid; i < 2 * 192 * 1024 / 16; i += G * NTHR) { const int mi = i / (192 * 64), q = i % (192 * 64); *(u32x4*)(WinCD + ((size_t)mi * 1792 + 1600) * 1024 + (size_t)q * 16) = (u32x4){0u, 0u, 0u, 0u}; }
        { const float* w_router = IN(9); bf16_t* WRFo = WSP(bf16_t, WS_WRF);
          for (int i = vcu * NTHR + tid; i < 4 * 2 * 32 * 64 * 8; i += G * NTHR) { const int ii = i & 7, ln = (i >> 3) & 63, sidx = (i >> 9) & 31, nt = (i >> 14) & 1, l = i >> 15;
            const int k = 32 * sidx + 8 * (ln >> 4) + ii, e = nt * 16 + (ln & 15); const float w = w_router[((size_t)l * 1024 + k) * 32 + e]; const unsigned hi = f2bf(w); const unsigned lo = f2bf(w - bflo(hi));
            WRFo[(size_t)l * 65536 + ((size_t)(0 * 2 + nt) * 32 + sidx) * 512 + ln * 8 + ii] = (bf16_t)hi; WRFo[(size_t)l * 65536 + ((size_t)(1 * 2 + nt) * 32 + sidx) * 512 + ln * 8 + ii] = (bf16_t)lo; } }
        for (int i = vcu * NTHR + tid; i < 64 * 32 + 64 * 16; i += G * NTHR) {
            if (i < 64 * 32) { const int idx = i >> 5, j = i & 31; const float ang = (float)idx * expf(-(float)j * (1.0f / 32.0f) * 9.210340371976184f); float sn, cs; sincosf(ang, &sn, &cs); T32[i * 2] = cs; T32[i * 2 + 1] = sn; }
            else { const int q = i - 64 * 32, idx = q >> 4, j = q & 15; const float ang = (float)idx * expf(-(float)j * (1.0f / 16.0f) * 9.210340371976184f); float sn, cs; sincosf(ang, &sn, &cs); T16[q * 2] = cs; T16[q * 2 + 1] = sn; }
        }

        PT_SAMPLE(21);
        {
            const float* lam_re = IN(18); const float* lam_im = IN(19); const float* log_dt = IN(20); const float* b_re = IN(21); const float* b_im = IN(22); const float* c_re = IN(23); const float* c_im = IN(24);
            bf16_t* TFb = WSP(bf16_t, WS_TF); bf16_t* SFb = WSP(bf16_t, WS_SF); bf16_t* WFb = WSP(bf16_t, WS_WF); float* LAM16 = WSP(float, WS_LAM16);
            __syncthreads();
            LAS f32x2* Pw = (LAS f32x2*)(lds + LDS_STAGE);
            LAS f32x2* Bb = Pw + 17 * 64;
            LAS f32x2* Cc = Bb + 64 * 16;
            LAS float* Kt = (LAS float*)(Cc + 64 * 16);
            for (int unit = vcu - (G - 128); unit >= 0 && unit < 128; unit += G) {
                const int dir = (unit >> 5) & 1;
                for (int idx = tid; idx < 17 * 64; idx += NTHR) { const int tau = idx >> 6, n = idx & 63; const float lr = lam_re[unit * 64 + n], lim = lam_im[unit * 64 + n], dt = expf(log_dt[unit]);
                    const float mag = expf((float)tau * dt * lr); float sn, cs; sincosf((float)tau * dt * lim, &sn, &cs); Pw[idx] = (f32x2){mag * cs, mag * sn}; }
                for (int idx = tid; idx < 64 * 16; idx += NTHR) { const int n = idx >> 4; const float lr = lam_re[unit * 64 + n], lim = lam_im[unit * 64 + n], dt = expf(log_dt[unit]);
                    const float mag = expf(dt * lr); float sn, cs; sincosf(dt * lim, &sn, &cs); const float nr = mag * cs - 1.0f, ni = mag * sn; const float den = 1.0f / (lr * lr + lim * lim);
                    const float cbr = (nr * lr + ni * lim) * den, cbi = (ni * lr - nr * lim) * den;
                    const float br = b_re[(size_t)unit * 1024 + idx], bi = b_im[(size_t)unit * 1024 + idx]; Bb[idx] = (f32x2){cbr * br - cbi * bi, cbr * bi + cbi * br};
                    Cc[(idx & 63) * 16 + (idx >> 6)] = (f32x2){c_re[(size_t)unit * 1024 + idx], c_im[(size_t)unit * 1024 + idx]}; }
                __syncthreads();
                { const int tau = tid >> 5, cout = (tid >> 1) & 15, ch = tid & 1; float ka[8];
#pragma unroll
                  for (int j = 0; j < 8; ++j) ka[j] = 0.f;
                  for (int n = 0; n < 64; ++n) { const f32x2 c = Cc[n * 16 + cout], pw = Pw[tau * 64 + n]; const float tr = c.x * pw.x - c.y * pw.y, ti = c.x * pw.y + c.y * pw.x;
                      const LAS f32x4* bp = (const LAS f32x4*)(Bb + n * 16 + ch * 8);
#pragma unroll
                      for (int j = 0; j < 4; ++j) { const f32x4 b2 = bp[j]; ka[2 * j] += tr * b2[0] - ti * b2[1]; ka[2 * j + 1] += tr * b2[2] - ti * b2[3]; } }
#pragma unroll
                  for (int j = 0; j < 8; ++j) Kt[(tau * 16 + cout) * 16 + ch * 8 + j] = ka[j]; }
                __syncthreads();
                for (int pq = tid; pq < 16 * 64; pq += NTHR) { const int f = pq >> 6, l = pq & 63; const int cout = l & 15, kq = l >> 4, sl = kq >> 1;
                    const int tau = dir == 0 ? f - sl : f - 1 + sl; u32x4 w = (u32x4){0u, 0u, 0u, 0u};
                    if (tau >= 0 && tau <= 15) { const LAS f32x4* kp = (const LAS f32x4*)(Kt + (tau * 16 + cout) * 16 + (kq & 1) * 8); const f32x4 a = kp[0], b2 = kp[1];
                        w.x = pk2(a[0], a[1]); w.y = pk2(a[2], a[3]); w.z = pk2(b2[0], b2[1]); w.w = pk2(b2[2], b2[3]); }
                    *(u32x4*)(TFb + (size_t)unit * 8192 + (size_t)pq * 8) = w; }
                for (int pq = tid; pq < 64 * 64; pq += NTHR) { const int fr = pq >> 6, l = pq & 63;
                    { const int mt = fr >> 3, j = fr & 7; const int kp = mt * 16 + (l & 15), n = kp >> 1, ri = kp & 1; const int kidx0 = j * 32 + (l >> 4) * 8, sidx = kidx0 >> 4, cin0 = kidx0 & 15;
                      const int e = dir == 0 ? 15 - sidx : sidx; const f32x2 pw = Pw[e * 64 + n]; const LAS f32x4* bp = (const LAS f32x4*)(Bb + n * 16 + cin0); float o[8];
#pragma unroll
                      for (int q = 0; q < 4; ++q) { const f32x4 b2 = bp[q];
                          o[2 * q] = ri ? (pw.x * b2[1] + pw.y * b2[0]) : (pw.x * b2[0] - pw.y * b2[1]); o[2 * q + 1] = ri ? (pw.x * b2[3] + pw.y * b2[2]) : (pw.x * b2[2] - pw.y * b2[3]); }
                      u32x4 w; w.x = pk2(o[0], o[1]); w.y = pk2(o[2], o[3]); w.z = pk2(o[4], o[5]); w.w = pk2(o[6], o[7]);
                      *(u32x4*)(SFb + (size_t)unit * 32768 + (size_t)pq * 8) = w; }
                    { const int t = fr >> 2, ks = fr & 3; const int cout = l & 15, n0 = (ks * 32 + (l >> 4) * 8) >> 1; const int e = dir == 0 ? t + 1 : 16 - t; float o[8];
#pragma unroll
                      for (int q = 0; q < 4; ++q) { const f32x2 c = Cc[(n0 + q) * 16 + cout], pw = Pw[e * 64 + n0 + q]; o[2 * q] = c.x * pw.x - c.y * pw.y; o[2 * q + 1] = -(c.x * pw.y + c.y * pw.x); }
                      u32x4 w; w.x = pk2(o[0], o[1]); w.y = pk2(o[2], o[3]); w.z = pk2(o[4], o[5]); w.w = pk2(o[6], o[7]);
                      *(u32x4*)(WFb + (size_t)unit * 32768 + (size_t)pq * 8) = w; } }
                if (tid < 128) { const f32x2 pw = Pw[16 * 64 + (tid >> 1)]; LAM16[unit * 128 + tid] = (tid & 1) ? pw.y : pw.x; }
                __syncthreads();
            }
        }
        __syncthreads();
        PT_SAMPLE(22);
        LAS float* sl = (LAS float*)(lds + LDS_STAGE);
        LAS float* red = (LAS float*)(lds + LDS_STAGE + 1024 * 20 * 4);
        for (int i = tid; i < 17 * 1024; i += NTHR) { const int row = i >> 10, k = i & 1023; const float v = (row < 16) ? in_c[row * 1024 + k] : in_cctx[k]; sl[k * 20 + row] = v / (1.0f + __expf(-v)); }
        __syncthreads();
        PT_SAMPLE(23);
        for (int rep_ = 0; rep_ < DUPN(14); ++rep_)
        for (int it = vcu; it < 4 * 96 && vcu < G - 128; it += G - 128) {
            const int l = it / 96, cb = it % 96, c4 = lane & 15, ksub = lane >> 4, kg = wave;
            f32x4 a[17];
#pragma unroll
            for (int r = 0; r < 17; ++r) a[r] = (f32x4){0.f, 0.f, 0.f, 0.f};
            const float* wp = w_mod + ((size_t)l * 1024 + kg * 128 + ksub) * 6144 + cb * 64 + c4 * 4;
            for (int s0_ = 0; s0_ < 32; s0_ += 16) {
                f32x4 wv[16];
#pragma unroll
                for (int q = 0; q < 16; ++q) wv[q] = *(const f32x4*)(wp + (size_t)((s0_ + q) * 4) * 6144);
#pragma unroll
                for (int q = 0; q < 16; ++q) { const f32x4 w = wv[q]; const LAS float* sp = sl + (kg * 128 + (s0_ + q) * 4 + ksub) * 20;
                    const f32x4 s0 = *(const LAS f32x4*)(sp), s1 = *(const LAS f32x4*)(sp + 4), s2 = *(const LAS f32x4*)(sp + 8), s3 = *(const LAS f32x4*)(sp + 12); const float s4 = sp[16];
                    a[0] += s0[0] * w; a[1] += s0[1] * w; a[2] += s0[2] * w; a[3] += s0[3] * w; a[4] += s1[0] * w; a[5] += s1[1] * w; a[6] += s1[2] * w; a[7] += s1[3] * w;
                    a[8] += s2[0] * w; a[9] += s2[1] * w; a[10] += s2[2] * w; a[11] += s2[3] * w; a[12] += s3[0] * w; a[13] += s3[1] * w; a[14] += s3[2] * w; a[15] += s3[3] * w; a[16] += s4 * w; }
            }
#pragma unroll
            for (int r = 0; r < 17; ++r)
#pragma unroll
                for (int j = 0; j < 4; ++j) { float v = a[r][j]; v += shx(v, 16, lane); v += shx(v, 32, lane); a[r][j] = v; }
            if (lane < 16) {
#pragma unroll
                for (int r = 0; r < 17; ++r)
#pragma unroll
                    for (int j = 0; j < 4; ++j) red[(kg * 64 + c4 * 4 + j) * 17 + r] = a[r][j]; }
            __syncthreads();
            for (int o = tid; o < 64 * 17; o += NTHR) { const int c2 = o / 17, r = o % 17; float s = 0.f;
#pragma unroll
                for (int g8 = 0; g8 < 8; ++g8) s += red[(g8 * 64 + c2) * 17 + r];
                MOD[((size_t)l * 17 + r) * 6144 + cb * 64 + c2] = s + b_mod[l * 6144 + cb * 64 + c2]; }
            __syncthreads();
        }
    }
    GRID_BARP(1);
    { PHASE_IDS(); PHASE_ARGS();
    const float* in_x = IN(0); const float* in_ctx = IN(2); const float* MOD = WSP(float, WS_MOD); unsigned char* H = WSP(unsigned char, WS_H8); unsigned short* X16 = WSP(unsigned short, WS_X);
    for (int row = gw; row < M; row += NGW) {
        const int b = row / TPB, t = row % TPB; const bool isctx = t < CTXL;
        const float* src = isctx ? in_ctx + ((size_t)b * CTXL + t) * DM : in_x + ((size_t)b * SEQ + (t - CTXL)) * DM;
        const float* mr = MOD + (size_t)(0 * 17 + (isctx ? 16 : b)) * 6144;
        f32x4 vq[4], shq[4], scq[4];
#pragma unroll
        for (int j = 0; j < 4; ++j) { const int col = 4 * lane + 256 * j; vq[j] = *(const f32x4*)(src + col); shq[j] = *(const f32x4*)(mr + col); scq[j] = *(const f32x4*)(mr + 1024 + col); }
#pragma unroll
        for (int j = 0; j < 4; ++j) { const int col = 4 * lane + 256 * j; const f32x4 v = vq[j];
            const f32x4 sh = shq[j], sc = scq[j]; const f32x4 h = v * (sc + 1.0f) + sh;
            *(unsigned*)(H + (size_t)row * DM + col) = pg8::pk4_fp8(h[0], h[1], h[2], h[3]);
            *(u32x2*)(X16 + (size_t)row * DM + col) = f32_to_h4(v); }
    } }
    GRID_BARP(2);

    for (int layer = 0; layer < DEPTH; ++layer) {
        const bool lastl = (layer == DEPTH - 1);
        const int li = layer >> 1;
        const bool even = (layer & 1) == 0;
#if !defined(NO_MIXER)
        if (even) {
            { PHASE_ARGS(); pg8::SchedDense S; S.nM = NPANEL; S.nN = 6; S.G = Gp; S.c = bxp; S.g = 0; S.A = (const char*)WSP(unsigned char, WS_H8); S.B = (const char*)(WSP(unsigned char, WS_WINAB) + (size_t)li * 1536 * 1024); S.a_tstep = (size_t)256 * 1024; S.b_tstep = (size_t)256 * 1024;
              pg8::EpiBf16U E; E.O = WSP(bf16_t, WS_PROJ); E.ldc = 1536; E.oscale = 1.0f / 64.0f; E.UT = WSP(bf16_t, WS_UT);
            for (int rep_ = 0; rep_ < DUPN(2); ++rep_)
              pg8::gemm_phase<pg8::EpiBf16U, pg8::SchedDense, false, true>(wave0, lds + LDS_STAGE, 1024, 1024, nullptr, S, E); }
            GRID_BARP(3);
            { PHASE_IDS(); PHASE_ARGS();
              bf16_t* PROJ = WSP(bf16_t, WS_PROJ); bf16_t* UT = WSP(bf16_t, WS_UT); const float* T32 = WSP(float, WS_ROPE);
              const float* gq = IN(16) + li * 128; const float* gk = IN(17) + li * 128;
              const int sub = lane & 15, half = sub >> 3, i0 = (sub & 7) * 4;
              const int colp[2] = {(lane >> 4) * 128 + half * 64 + i0, 512 + ((lane >> 4) & 1) * 128 + half * 64 + i0};
              f32x4 g1[2], g2[2];
#pragma unroll
              for (int pass = 0; pass < 2; ++pass) { const float* gg = (pass ? gk : gq) + half * 64 + i0; g1[pass] = *(const f32x4*)gg; g2[pass] = *(const f32x4*)(gg + 32); }
              for (int rb = gw * 3; rb < M; rb += NGW * 3) {
                u32x2 av[3][2], cv[3][2]; f32x4 tb[3][2];
#pragma unroll
                for (int r = 0; r < 3; ++r) { const bf16_t* pr = PROJ + (size_t)(rb + r) * 1536;
#pragma unroll
                    for (int pass = 0; pass < 2; ++pass) { av[r][pass] = *(const u32x2*)(pr + colp[pass]); cv[r][pass] = *(const u32x2*)(pr + colp[pass] + 32); }
                    { const int t_ = (rb + r) % TPB; const int pos_ = t_ < CTXL ? 0 : t_ - CTXL; const float* tp_ = T32 + ((half ? (pos_ & 63) : (pos_ >> 6)) * 32 + i0) * 2; tb[r][0] = *(const f32x4*)tp_; tb[r][1] = *(const f32x4*)(tp_ + 4); } }
#pragma unroll
                for (int r = 0; r < 3; ++r) { const int row = rb + r; const int b = row / TPB, t = row % TPB; const bool isctx = t < CTXL; const int pos = t - CTXL; const int ri = pos >> 6, ci = pos & 63;
                    bf16_t* pr = PROJ + (size_t)row * 1536;
#pragma unroll
                    for (int pass = 0; pass < 2; ++pass) {
                        const u32x2 a = av[r][pass], c2 = cv[r][pass];
                        float x1[4] = {bflo(a.x), bfhi(a.x), bflo(a.y), bfhi(a.y)}, x2[4] = {bflo(c2.x), bfhi(c2.x), bflo(c2.y), bfhi(c2.y)};
                        float ss = 0.f;
#pragma unroll
                        for (int i = 0; i < 4; ++i) ss += x1[i] * x1[i] + x2[i] * x2[i];
                        ss = row16_sum(ss);
                        const float rinv = 1.0f / sqrtf(ss * (1.0f / 128.0f) + 1e-6f);
#pragma unroll
                        for (int i = 0; i < 4; ++i) { x1[i] = x1[i] * rinv * g1[pass][i]; x2[i] = x2[i] * rinv * g2[pass][i]; }
                        if (!isctx) { const float tpv[8] = {tb[r][0][0], tb[r][0][1], tb[r][0][2], tb[r][0][3], tb[r][1][0], tb[r][1][1], tb[r][1][2], tb[r][1][3]};
#pragma unroll
                            for (int i = 0; i < 4; ++i) { const float cs = tpv[2 * i], sn = tpv[2 * i + 1]; const float o1 = x1[i] * cs - x2[i] * sn, o2 = x2[i] * cs + x1[i] * sn; x1[i] = o1; x2[i] = o2; } }
                        if (pass == 0 || lane < 32) { u32x2 w; w.x = pk2(x1[0], x1[1]); w.y = pk2(x1[2], x1[3]); *(u32x2*)(pr + colp[pass]) = w; w.x = pk2(x2[0], x2[1]); w.y = pk2(x2[2], x2[3]); *(u32x2*)(pr + colp[pass] + 32) = w; }
                    }
                }
              } }
            GRID_BARP(4);
            { PHASE_IDS(); PHASE_ARGS();
              const bf16_t* UT = WSP(bf16_t, WS_UT); const bf16_t* SFb = WSP(bf16_t, WS_SF); unsigned short* XS = WSP(unsigned short, WS_XS);
              for (int rep_ = 0; rep_ < DUPN(7); ++rep_)
              for (int unit = vcu; unit < 256; unit += G) {
                const int g = unit >> 3, r8 = unit & 7;
                bf16x8 sa[2][8];
#pragma unroll
                for (int d = 0; d < 2; ++d)
#pragma unroll
                    for (int j = 0; j < 8; ++j) sa[d][j] = *(const bf16x8*)(SFb + ((size_t)((li * 2 + d) * 32 + g) * 64 + wave * 8 + j) * 512 + lane * 8);
                const int b = lane & 15, kq = lane >> 4;
                for (int c = r8 * 18; c < r8 * 18 + 18; ++c) {
                    f32x4 a0 = (f32x4){0.f, 0.f, 0.f, 0.f}, a1 = a0; bf16x8 ub[8];
#pragma unroll
                    for (int j = 0; j < 8; ++j) ub[j] = *(const bf16x8*)(UT + (((size_t)g * TPB + c * 16 + 2 * j + (kq >> 1)) * 16 + b) * 16 + (kq & 1) * 8);
#pragma unroll
                    for (int j = 0; j < 8; ++j) { a0 = __builtin_amdgcn_mfma_f32_16x16x32_bf16(sa[0][j], ub[j], a0, 0, 0, 0); a1 = __builtin_amdgcn_mfma_f32_16x16x32_bf16(sa[1][j], ub[j], a1, 0, 0, 0); }
                    *(u32x2*)(XS + ((size_t)(g * 2 + 0) * 144 + c) * 2048 + b * 128 + wave * 16 + 4 * kq) = f32_to_h4(a0);
                    *(u32x2*)(XS + ((size_t)(g * 2 + 1) * 144 + c) * 2048 + b * 128 + wave * 16 + 4 * kq) = f32_to_h4(a1);
                }
              } }
            { PHASE_ARGS(); bf16_t* PROJ = WSP(bf16_t, WS_PROJ); unsigned char* OL8 = WSP(unsigned char, WS_OL);
              const float* w_exp_in = IN(11); const float* w_exp_out = IN(13); unsigned char* WexpIn = WSP(unsigned char, WS_WEXPIN); unsigned char* WexpOut = WSP(unsigned char, WS_WEXPOUT);
#define EXPERT_CONV() do { __syncthreads(); const int ln_ = lane_now(); LAS float* scr_ = (LAS float*)(lds + LDS_STAGE + wave0 * 16384); \
                expert_conv_run(w_exp_in, w_exp_out, WexpIn, WexpOut, layer, vcu * 96 + wave0, 12, scr_, ln_); __syncthreads(); } while (0)
              for (int rep_ = 0; rep_ < DUPN(3); ++rep_) {
              int it_ = 0; const int slot_ = (rep_ == 0) ? (vcu % 3) : 99;
              for (int u = vcu; u < 576; u += G, ++it_) {
                if (it_ == slot_) EXPERT_CONV();
                att::Unit U; int b, h, row0;
                if (u < 512) { b = u >> 5; h = (u >> 3) & 3; row0 = b * TPB + CTXL + (u & 7) * 256; U.NT = 36; } else { const int uc = u - 512; b = uc >> 2; h = uc & 3; row0 = b * TPB; U.NT = 4; }
                const bf16_t* kb = PROJ + (size_t)b * TPB * 1536;
                U.Q = PROJ + (size_t)row0 * 1536 + h * 128; U.ldq = 1536; U.K = kb + 512 + (h >> 1) * 128; U.ldk = 1536; U.KR = nullptr; U.ldkr = 0; U.V = kb + 768 + (h >> 1) * 128; U.ldv = 1536;
                U.O = OL8 + (size_t)row0 * 1024 + h * 128; U.ldo = 1024; U.kofs = 0; U.q0 = 0; U.sink = 0.f; U.has_sink = 0; U.rope = nullptr; U.rope_row = 0; U.rope_col_base = 0;
                att::attn_unit<128, false, 2, false>(U, (LAS char*)(lds + LDS_STAGE), wave0);
              }
              if (it_ <= slot_ && slot_ != 99) EXPERT_CONV(); } }
            GRID_BARP(5);
            { PHASE_IDS(); PHASE_ARGS();
              const unsigned short* XS = WSP(unsigned short, WS_XS); bf16_t* HIN = WSP(bf16_t, WS_HIN); const float* LAM16 = WSP(float, WS_LAM16);
              const int id = vcu * 256 + (tid & 255);
              for (int rep_ = 0; rep_ < DUPN(8); ++rep_)
              if (wave < 4) {
                const int n = id & 63, b = (id >> 6) & 15, gd = id >> 10, g = gd >> 1, dir = gd & 1;
                const f32x2 lam = *(const f32x2*)(LAM16 + ((li * 2 + dir) * 32 + g) * 128 + 2 * n);
                const unsigned short* xp = XS + (size_t)gd * 144 * 2048 + b * 128 + 2 * n;
                bf16_t* hp = HIN + (size_t)gd * 144 * 2048 + (((2 * n) >> 5) * 64 + (((2 * n) >> 3) & 3) * 16 + b) * 8 + ((2 * n) & 7);
                float hr = 0.f, hi2 = 0.f;
#define S5B_CC(st) (dir == 0 ? (st) : ((st) < 16 ? 15 - (st) : 159 - (st)))
#define S5B_LOAD(buf, s1) do { _Pragma("unroll") for (int q = 0; q < 12; ++q) buf[q] = *(const unsigned*)(xp + (size_t)S5B_CC((s1) + q) * 2048); } while (0)
#define S5B_USE(buf, s1) do { _Pragma("unroll") for (int q = 0; q < 12; ++q) { *(unsigned*)(hp + (size_t)S5B_CC((s1) + q) * 2048) = pk2(hr, hi2); \
                        const float nr = lam.x * hr - lam.y * hi2 + h2f((unsigned short)(buf[q] & 0xffffu)), ni = lam.x * hi2 + lam.y * hr + h2f((unsigned short)(buf[q] >> 16)); hr = nr; hi2 = ni; } } while (0)
                unsigned xa[12], xb[12];
                S5B_LOAD(xa, 0); S5B_LOAD(xb, 12);
                for (int s0 = 0; s0 < 144; s0 += 24) {
                    S5B_USE(xa, s0); if (s0 + 24 < 144) S5B_LOAD(xa, s0 + 24);
                    S5B_USE(xb, s0 + 12); if (s0 + 36 < 144) S5B_LOAD(xb, s0 + 36);
                }
#undef S5B_CC
#undef S5B_LOAD
#undef S5B_USE
              } }
            GRID_BARP(6);
            { PHASE_IDS(); PHASE_ARGS();
              const bf16_t* UT = WSP(bf16_t, WS_UT); const bf16_t* TFb = WSP(bf16_t, WS_TF); const bf16_t* WFb = WSP(bf16_t, WS_WF); const bf16_t* HIN = WSP(bf16_t, WS_HIN);
              const bf16_t* PROJ = WSP(bf16_t, WS_PROJ); bf16_t* ZG = WSP(bf16_t, WS_ZG); const float* s5d = IN(25) + li * 512;
              LAS unsigned char* tfl = lds + LDS_STAGE;
              for (int rep_ = 0; rep_ < DUPN(9); ++rep_)
              for (int unit = vcu; unit < 256; unit += G) {
                const int g = unit >> 3, r8 = unit & 7;
                __syncthreads();
                for (int i = tid; i < 2048; i += NTHR) { const int d = i >> 10, q = i & 1023; *(LAS u32x4*)(tfl + (size_t)i * 16) = *(const u32x4*)(TFb + (size_t)((li * 2 + d) * 32 + g) * 8192 + q * 8); }
                bf16x8 wf[2][2][4];
#pragma unroll
                for (int d = 0; d < 2; ++d)
#pragma unroll
                    for (int tt = 0; tt < 2; ++tt)
#pragma unroll
                        for (int ks = 0; ks < 4; ++ks) wf[d][tt][ks] = *(const bf16x8*)(WFb + ((size_t)((li * 2 + d) * 32 + g) * 64 + (2 * wave + tt) * 4 + ks) * 512 + lane * 8);
                __syncthreads();
                const int b = lane & 15, kq = lane >> 4;
                const f32x4 dsk = *(const f32x4*)(s5d + g * 16 + 4 * kq);
                for (int c = r8 * 18; c < r8 * 18 + 18; ++c) {
                    f32x4 a0 = (f32x4){0.f, 0.f, 0.f, 0.f}, a1 = a0; bf16x8 hbv[2][4], ubv[8]; u32x2 uwv[2];
#pragma unroll
                    for (int d = 0; d < 2; ++d)
#pragma unroll
                        for (int ks = 0; ks < 4; ++ks) hbv[d][ks] = *(const bf16x8*)(HIN + ((size_t)(g * 2 + d) * 144 + c) * 2048 + (ks * 64 + lane) * 8);
#pragma unroll
                    for (int j = 0; j < 8; ++j) ubv[j] = *(const bf16x8*)(UT + (((size_t)g * TPB + c * 16 + 2 * j + (kq >> 1)) * 16 + b) * 16 + (kq & 1) * 8);
#pragma unroll
                    for (int tt = 0; tt < 2; ++tt) uwv[tt] = *(const u32x2*)(UT + (((size_t)g * TPB + c * 16 + 2 * wave + tt) * 16 + b) * 16 + 4 * kq);
#pragma unroll
                    for (int d = 0; d < 2; ++d)
#pragma unroll
                        for (int ks = 0; ks < 4; ++ks) { const bf16x8 hb = hbv[d][ks];
                            a0 = __builtin_amdgcn_mfma_f32_16x16x32_bf16(wf[d][0][ks], hb, a0, 0, 0, 0); a1 = __builtin_amdgcn_mfma_f32_16x16x32_bf16(wf[d][1][ks], hb, a1, 0, 0, 0); }
#pragma unroll
                    for (int j = 0; j < 8; ++j) { const bf16x8 ub = ubv[j];
                        if (j <= wave) { const bf16x8 t0 = *(const LAS bf16x8*)(tfl + ((2 * wave - 2 * j) * 64 + lane) * 16), t1 = *(const LAS bf16x8*)(tfl + ((2 * wave + 1 - 2 * j) * 64 + lane) * 16);
                            a0 = __builtin_amdgcn_mfma_f32_16x16x32_bf16(t0, ub, a0, 0, 0, 0); a1 = __builtin_amdgcn_mfma_f32_16x16x32_bf16(t1, ub, a1, 0, 0, 0); }
                        if (j >= wave) { const bf16x8 t0 = *(const LAS bf16x8*)(tfl + ((16 + 2 * j - 2 * wave + 1) * 64 + lane) * 16), t1 = *(const LAS bf16x8*)(tfl + ((16 + 2 * j - 2 * wave) * 64 + lane) * 16);
                            a0 = __builtin_amdgcn_mfma_f32_16x16x32_bf16(t0, ub, a0, 0, 0, 0); a1 = __builtin_amdgcn_mfma_f32_16x16x32_bf16(t1, ub, a1, 0, 0, 0); } }
#pragma unroll
                    for (int tt = 0; tt < 2; ++tt) { const size_t row = (size_t)b * TPB + c * 16 + 2 * wave + tt; const f32x4 av = tt ? a1 : a0;
                        const u32x2 uw = uwv[tt]; const float uu[4] = {bflo(uw.x), bfhi(uw.x), bflo(uw.y), bfhi(uw.y)}; float z[4];
#pragma unroll
                        for (int i = 0; i < 4; ++i) { const float y = av[i] + dsk[i] * uu[i]; const float a = 0.7978845608028654f * (y + 0.044715f * y * y * y);
                            const float th = 1.0f - 2.0f * __builtin_amdgcn_rcpf(1.0f + __expf(2.0f * a)); z[i] = 0.5f * y * (1.0f + th); }
                        u32x2 w; w.x = pk2(z[0], z[1]); w.y = pk2(z[2], z[3]); *(u32x2*)(ZG + row * 512 + g * 16 + 4 * kq) = w; }
                }
              } }
            GRID_BARP(7);
            { PHASE_ARGS(); pg8::SchedDense S; S.nM = NPANEL; S.nN = 2; S.G = Gp; S.c = bxp; S.g = 0; S.A = (const char*)WSP(bf16_t, WS_ZG); S.B = (const char*)(WSP(bf16_t, WS_WGLU) + (size_t)li * 512 * 512); S.a_tstep = (size_t)256 * 512 * 2; S.b_tstep = (size_t)256 * 512 * 2;
              pg8::EpiGlu E; E.ZG = WSP(bf16_t, WS_ZG); E.bias = IN(27) + li * 512; E.OL = WSP(unsigned char, WS_OL);
            for (int rep_ = 0; rep_ < DUPN(10); ++rep_)
              pg8::gemm_phase<pg8::EpiGlu, pg8::SchedDense, false, false>(wave0, lds + LDS_STAGE, 1024, 1024, nullptr, S, E); }
            GRID_BARP(8);
        } else {
#if !defined(NO_ODD)
            { PHASE_ARGS(); pg8::SchedDense S; S.nM = NPANEL; S.nN = 7; S.G = Gp; S.c = bxp; S.g = 0; S.A = (const char*)WSP(unsigned char, WS_H8); S.B = (const char*)(WSP(unsigned char, WS_WINCD) + (size_t)li * 1792 * 1024); S.a_tstep = (size_t)256 * 1024; S.b_tstep = (size_t)256 * 1024;
              pg8::EpiBf16 E; E.O = WSP(bf16_t, WS_PROJ); E.ldc = 1792; E.oscale = 1.0f / 64.0f;
            for (int rep_ = 0; rep_ < DUPN(2); ++rep_)
              pg8::gemm_phase<pg8::EpiBf16, pg8::SchedDense, false, true>(wave0, lds + LDS_STAGE, 1024, 1024, nullptr, S, E); }
            GRID_BARP(9);
            { PHASE_IDS(); PHASE_ARGS();
              bf16_t* PROJ = WSP(bf16_t, WS_PROJ); const float* T32 = WSP(float, WS_ROPE); const float* T16 = T32 + 64 * 32 * 2;
              const float* gq = IN(29) + li * 256; const float* gkv = IN(30) + li * 256;
              const f32x4 gq4 = *(const f32x4*)(gq + lane * 4), gkv4 = *(const f32x4*)(gkv + lane * 4);
              const int sub = lane & 15, half = sub >> 3, i0 = (sub & 7) * 4;
              const int colp[2] = {576 + (lane >> 4) * 128 + half * 64 + i0, 1088 + ((lane >> 4) & 1) * 128 + half * 64 + i0};
              const int kh = (lane >> 4) & 1, ki = lane & 15, kcol = 512 + kh * 32 + ki;
              for (int rb = gw * 3; rb < M; rb += NGW * 3) {
                u32x2 nv[3][2], av[3][2], cv[3][2]; unsigned short kr[3][2]; f32x4 tb[3][2]; f32x2 tk[3];
#pragma unroll
                for (int r = 0; r < 3; ++r) { const bf16_t* pr = PROJ + (size_t)(rb + r) * 1792;
#pragma unroll
                    for (int pass = 0; pass < 2; ++pass) { nv[r][pass] = *(const u32x2*)(pr + pass * 256 + lane * 4); av[r][pass] = *(const u32x2*)(pr + colp[pass]); cv[r][pass] = *(const u32x2*)(pr + colp[pass] + 32); }
                    kr[r][0] = pr[kcol]; kr[r][1] = pr[kcol + 16];
                    { const int t_ = (rb + r) % TPB; const int pos_ = t_ < CTXL ? 0 : t_ - CTXL; const float* tp_ = T32 + ((half ? (pos_ & 63) : (pos_ >> 6)) * 32 + i0) * 2; tb[r][0] = *(const f32x4*)tp_; tb[r][1] = *(const f32x4*)(tp_ + 4);
                      tk[r] = *(const f32x2*)(T16 + ((kh ? (pos_ & 63) : (pos_ >> 6)) * 16 + ki) * 2); } }
#pragma unroll
                for (int r = 0; r < 3; ++r) { const int row = rb + r; const int t = row % TPB; const bool isctx = t < CTXL; const int pos = t - CTXL; const int ri = pos >> 6, ci = pos & 63;
                    bf16_t* pr = PROJ + (size_t)row * 1792;
#pragma unroll
                    for (int pass = 0; pass < 2; ++pass) { const u32x2 a = nv[r][pass];
                        float x[4] = {bflo(a.x), bfhi(a.x), bflo(a.y), bfhi(a.y)}; const float ss = wave_sum(x[0] * x[0] + x[1] * x[1] + x[2] * x[2] + x[3] * x[3], lane);
                        const float rinv = 1.0f / sqrtf(ss * (1.0f / 256.0f) + 1e-6f); const f32x4 g4 = pass ? gkv4 : gq4;
                        u32x2 w; w.x = pk2(x[0] * rinv * g4[0], x[1] * rinv * g4[1]); w.y = pk2(x[2] * rinv * g4[2], x[3] * rinv * g4[3]); *(u32x2*)(pr + pass * 256 + lane * 4) = w; }
                    if (!isctx) {
                        if (lane < 32) { const float a = bf2f(kr[r][0]), c2 = bf2f(kr[r][1]);
                            const float cs = tk[r][0], sn = tk[r][1];
                            pr[kcol] = (bf16_t)f2bf(a * cs - c2 * sn); pr[kcol + 16] = (bf16_t)f2bf(c2 * cs + a * sn); }
#pragma unroll
                        for (int pass = 0; pass < 2; ++pass) {
                            const u32x2 a = av[r][pass], c2 = cv[r][pass];
                            float x1[4] = {bflo(a.x), bfhi(a.x), bflo(a.y), bfhi(a.y)}, x2[4] = {bflo(c2.x), bfhi(c2.x), bflo(c2.y), bfhi(c2.y)};
                            const float tpv[8] = {tb[r][0][0], tb[r][0][1], tb[r][0][2], tb[r][0][3], tb[r][1][0], tb[r][1][1], tb[r][1][2], tb[r][1][3]};
#pragma unroll
                            for (int i = 0; i < 4; ++i) { const float cs = tpv[2 * i], sn = tpv[2 * i + 1]; const float o1 = x1[i] * cs - x2[i] * sn, o2 = x2[i] * cs + x1[i] * sn; x1[i] = o1; x2[i] = o2; }
                            if (pass == 0 || lane < 32) { u32x2 w; w.x = pk2(x1[0], x1[1]); w.y = pk2(x1[2], x1[3]); *(u32x2*)(pr + colp[pass]) = w; w.x = pk2(x2[0], x2[1]); w.y = pk2(x2[2], x2[3]); *(u32x2*)(pr + colp[pass] + 32) = w; }
                        }
                    }
                }
              } }
            GRID_BARP(10);
            { PHASE_ARGS(); bf16_t* PROJ = WSP(bf16_t, WS_PROJ); pg8::SchedDual S; S.nM = NPANEL; S.nN0 = 3; S.nN1 = 4; S.G = Gp; S.c = vcup; S.A0 = (const char*)PROJ; S.A1 = (const char*)(PROJ + 256);
              S.B0 = (const char*)(WSP(bf16_t, WS_WUQ) + (size_t)li * 768 * 256); S.B1 = (const char*)(WSP(bf16_t, WS_WUKV) + (size_t)li * 1024 * 256); S.a_tstep = (size_t)256 * 1792 * 2; S.b_tstep = (size_t)256 * 256 * 2;
              pg8::EpiBf16Dual E; E.O0 = WSP(bf16_t, WS_QM); E.ldc0 = 768; E.O1 = WSP(bf16_t, WS_KVM); E.ldc1 = 1024;
            for (int rep_ = 0; rep_ < DUPN(11); ++rep_)
              pg8::gemm_phase<pg8::EpiBf16Dual, pg8::SchedDual, false, false>(wave0, lds + LDS_STAGE, 512, 3584, nullptr, S, E); }
            GRID_BARP(11);
            { PHASE_ARGS(); bf16_t* PROJ = WSP(bf16_t, WS_PROJ); unsigned char* OL8 = WSP(unsigned char, WS_OL); bf16_t* QM = WSP(bf16_t, WS_QM); bf16_t* KVM = WSP(bf16_t, WS_KVM); const float* T16 = WSP(float, WS_ROPE) + 64 * 32 * 2; const float* d_sink = IN(33);
              const float* w_exp_in = IN(11); const float* w_exp_out = IN(13); unsigned char* WexpIn = WSP(unsigned char, WS_WEXPIN); unsigned char* WexpOut = WSP(unsigned char, WS_WEXPOUT);
              for (int rep_ = 0; rep_ < DUPN(3); ++rep_) {
              int it_ = 0; const int slot_ = (rep_ == 0) ? (vcu & 3) : 99;
              for (int u = vcu; u < (lastl ? 1024 : 1152); u += G, ++it_) {
                if (it_ == slot_) EXPERT_CONV();
                att::Unit U; int b, h, row0, qb; bool mla, ctxq;
                if (u < 512) { mla = true; ctxq = false; b = u >> 5; h = (u >> 3) & 3; qb = u & 7; }
                else if (u < 1024) { const int v2 = u - 512; mla = false; ctxq = false; b = v2 >> 5; h = (v2 >> 3) & 3; qb = v2 & 7; }
                else { const int v2 = u - 1024; mla = (v2 < 64); ctxq = true; b = (v2 & 63) >> 2; h = v2 & 3; qb = 0; }
                row0 = b * TPB + (ctxq ? 0 : CTXL + qb * 256);
                const int q0 = qb * 256;
                if (mla) {
                    const bf16_t* kvb = KVM + (size_t)b * TPB * 1024;
                    U.Q = QM + (size_t)row0 * 768 + h * 192; U.ldq = 768; U.K = kvb + h * 256; U.ldk = 1024; U.KR = PROJ + (size_t)b * TPB * 1792 + 512; U.ldkr = 1792; U.V = kvb + h * 256 + 128; U.ldv = 1024;
                    U.O = OL8 + (size_t)row0 * 1024 + h * 128; U.ldo = 1024; U.NT = ctxq ? 4 : 36; U.kofs = 0; U.q0 = q0; U.sink = 0.f; U.has_sink = 0; U.rope = ctxq ? nullptr : T16; U.rope_row = 0; U.rope_col_base = 0;
                    att::attn_unit<192, false, 1, true>(U, (LAS char*)(lds + LDS_STAGE), wave0);
                } else {
                    const bf16_t* kb = PROJ + (size_t)b * TPB * 1792;
                    const int kstart = (q0 - 128) < 0 ? 0 : (q0 - 128), kend = (q0 + 384) > SEQ ? SEQ : (q0 + 384);
                    U.Q = PROJ + (size_t)row0 * 1792 + 576 + h * 128; U.ldq = 1792; U.K = kb + 1088 + (h >> 1) * 128; U.ldk = 1792; U.KR = nullptr; U.ldkr = 0; U.V = kb + 1344 + (h >> 1) * 128; U.ldv = 1792;
                    U.O = OL8 + (size_t)row0 * 1024 + 512 + h * 128; U.ldo = 1024; U.NT = ctxq ? 4 : 4 + (kend - kstart) / 64; U.kofs = kstart; U.q0 = q0; U.sink = d_sink[li * 4 + h]; U.has_sink = 1; U.rope = nullptr; U.rope_row = 0; U.rope_col_base = 0;
                    att::attn_unit<128, true, 2, false>(U, (LAS char*)(lds + LDS_STAGE), wave0);
                }
              }
              if (it_ <= slot_ && slot_ != 99) EXPERT_CONV(); } }
            GRID_BARP(12);
#endif
        }
        const bool has_mix = even
#if !defined(NO_ODD)
            || true
#endif
            ;
        if (has_mix) {
            { PHASE_ARGS(); pg8::SchedDense S; S.nM = lastl ? 128 : NPANEL; S.latent_only = lastl ? 1 : 0; S.nN = 4; S.G = Gp; S.c = bxp; S.g = 0; S.A = (const char*)WSP(unsigned char, WS_OL); S.B = (const char*)(WSP(unsigned char, WS_WMIX) + (size_t)layer * 1024 * 1024); S.a_tstep = (size_t)256 * 1024; S.b_tstep = (size_t)256 * 1024;
              pg8::EpiFp8P16 E; E.O = WSP(unsigned char, WS_Y); E.ldc = 1024; E.oscale = 64.0f / (16.0f * 64.0f);
            for (int rep_ = 0; rep_ < DUPN(6); ++rep_)
              pg8::gemm_phase<pg8::EpiFp8P16, pg8::SchedDense, false, true, false, true>(wave0, lds + LDS_STAGE, 1024, 1024, nullptr, S, E); }
            GRID_BARP(13);
        }
#else
        const bool has_mix = false;
#endif
        {
            PHASE_IDS(); PHASE_ARGS();
            const float* ln_g = IN(6); const float* ln_b = IN(7); const float* b_router = IN(10);
            const float* MOD = WSP(float, WS_MOD); const unsigned short* X16 = WSP(unsigned short, WS_X); const float* in_x = IN(0); const float* in_ctx = IN(2); unsigned char* H8 = WSP(unsigned char, WS_H8); const unsigned char* Y = WSP(unsigned char, WS_Y);
            int* slot_tok = WSP(int, WS_SLOTTOK); float* slot_gate = WSP(float, WS_SLOTGATE); int* tok_pos = WSP(int, WS_TOKPOS); unsigned* ctl = WSP(unsigned, WS_CTL);
            const bf16_t* WRF = WSP(bf16_t, WS_WRF) + (size_t)layer * (2 * 2 * 32 * 512);
            LAS bf16_t* HT1 = (LAS bf16_t*)(lds + LDS_STAGE); LAS bf16_t* HT2 = HT1 + 16 * 1032;
            LAS float* PART = (LAS float*)(lds + LDS_STAGE + 2 * 16 * 1032 * 2);
            LAS int* hist = (LAS int*)(lds + LDS_MISC + 64);
            LAS int* basel = (LAS int*)(lds + LDS_MISC + 64 + 128);
            LAS int* ent = (LAS int*)(lds + LDS_MISC + 512);
            if (tid < 32) hist[tid] = 0;
            __syncthreads();
            const float* g1 = ln_g + (size_t)(layer * 2 + 0) * 1024; const float* b1 = ln_b + (size_t)(layer * 2 + 0) * 1024;
            const int rows_per_wg = M / G;
            const int rbase = vcu * rows_per_wg;
            for (int rep_ = 0; rep_ < DUPN(12); ++rep_) {
            if (rep_ > 0) { __syncthreads(); if (tid < 32) hist[tid] = 0; __syncthreads(); }
            const int NG = rows_per_wg / 16;
#define LN1_VALID(gq) (!(lastl && (((rbase + (gq) * 16) % TPB) < CTXL)))
#define LN1_LOAD(gq, vv, yy) do { _Pragma("unroll") for (int rr = 0; rr < 2; ++rr) { const size_t row_ = (size_t)(rbase + (gq) * 16 + 2 * wave + rr); \
                _Pragma("unroll") for (int j = 0; j < 4; ++j) { xh[rr][j] = *(const u32x2*)(X16 + row_ * DM + 4 * lane + 256 * j); } \
                _Pragma("unroll") for (int j = 0; j < 4; ++j) { const int col_ = 4 * lane + 256 * j; if (has_mix) yy[rr][j] = *(const unsigned*)(Y + row_ * DM + col_); } } } while (0)
            { LAS float* gl_ = (LAS float*)(lds + LDS_STAGE + 98304) + 3072; for (int i = tid; i < 512; i += NTHR) { const float* sp_ = (i < 256) ? g1 + 4 * i : b1 + 4 * (i - 256); *(LAS f32x4*)(gl_ + 4 * i) = *(const f32x4*)sp_; } }
            const float brv = b_router[layer * 32 + (lane & 31)];
            bf16x8 wrf[4][4];
#pragma unroll
            for (int s4 = 0; s4 < 4; ++s4) { const int s = 4 * wave + s4;
                wrf[s4][0] = *(const bf16x8*)(WRF + ((size_t)(0 * 2 + 0) * 32 + s) * 512 + lane * 8); wrf[s4][1] = *(const bf16x8*)(WRF + ((size_t)(0 * 2 + 1) * 32 + s) * 512 + lane * 8);
                wrf[s4][2] = *(const bf16x8*)(WRF + ((size_t)(1 * 2 + 0) * 32 + s) * 512 + lane * 8); wrf[s4][3] = *(const bf16x8*)(WRF + ((size_t)(1 * 2 + 1) * 32 + s) * 512 + lane * 8); }
            int grp = 0; while (grp < NG && !LN1_VALID(grp)) ++grp;
            f32x4 v[2][4]; unsigned yv[2][4]; u32x2 xh[2][4];
#pragma unroll
            for (int rr = 0; rr < 2; ++rr)
#pragma unroll
                for (int j = 0; j < 4; ++j) { v[rr][j] = (f32x4){0.f, 0.f, 0.f, 0.f}; yv[rr][j] = 0u; xh[rr][j] = (u32x2){0u, 0u}; }
            if (grp < NG) LN1_LOAD(grp, v, yv);
            LAS float* MODL = (LAS float*)(lds + LDS_STAGE + 98304);
            int mod_kind = -1;
            while (grp < NG) {
                int gnx = grp + 1; while (gnx < NG && !LN1_VALID(gnx)) ++gnx;
                const int r0 = rbase + grp * 16; const int b = r0 / TPB; const bool isctx = (r0 % TPB) < CTXL;
                if (mod_kind != (isctx ? 1 : 0)) { mod_kind = isctx ? 1 : 0;
                    const float* mr = MOD + (size_t)(layer * 17 + (isctx ? 16 : b)) * 6144 + 2048;
                    __syncthreads();
                    for (int i = tid; i < 768; i += NTHR) *(LAS f32x4*)(MODL + 4 * i) = *(const f32x4*)(mr + 4 * i);
                    __syncthreads(); }
                f32x4 gtv[4], shv[4], scv[4];
#pragma unroll
                for (int j = 0; j < 4; ++j) { const int col = 4 * lane + 256 * j; gtv[j] = *(const LAS f32x4*)(MODL + col); shv[j] = *(const LAS f32x4*)(MODL + 1024 + col); scv[j] = *(const LAS f32x4*)(MODL + 2048 + col); }
#pragma unroll
                for (int rr = 0; rr < 2; ++rr)
#pragma unroll
                    for (int j = 0; j < 4; ++j) { v[rr][j] = h4_to_f32(xh[rr][j].x, xh[rr][j].y) * ALPHA;
                        if (has_mix) { const int yw = (int)yv[rr][j]; const f32x4 gt = gtv[j] * (1.0f / 64.0f);
                            const f32x2 ylo = __builtin_amdgcn_cvt_pk_f32_fp8(yw, false), yhi = __builtin_amdgcn_cvt_pk_f32_fp8(yw, true);
                            v[rr][j][0] += gt[0] * ylo[0]; v[rr][j][1] += gt[1] * ylo[1]; v[rr][j][2] += gt[2] * yhi[0]; v[rr][j][3] += gt[3] * yhi[1]; } }
                if (gnx < NG) LN1_LOAD(gnx, v, yv);
#pragma unroll
                for (int rr = 0; rr < 2; ++rr) { const size_t row = (size_t)(r0 + 2 * wave + rr); float s = 0.f;
#pragma unroll
                    for (int j = 0; j < 4; ++j) s += (v[rr][j][0] + v[rr][j][1]) + (v[rr][j][2] + v[rr][j][3]);
                    const float mean = wave_sum(s, lane) * (1.f / DM); float s2 = 0.f;
#pragma unroll
                    for (int j = 0; j < 4; ++j) { v[rr][j] = v[rr][j] - mean; s2 += (v[rr][j][0] * v[rr][j][0] + v[rr][j][1] * v[rr][j][1]) + (v[rr][j][2] * v[rr][j][2] + v[rr][j][3] * v[rr][j][3]); }
                    const float rstd = 1.f / sqrtf(wave_sum(s2, lane) * (1.f / DM) + LN_EPS);
#pragma unroll
                    for (int j = 0; j < 4; ++j) { const int col = 4 * lane + 256 * j; const f32x4 gg = *(const LAS f32x4*)(MODL + 3072 + col), bb = *(const LAS f32x4*)(MODL + 4096 + col);
                        const f32x4 xn = v[rr][j] * rstd * gg + bb;
                        const f32x4 sh = shv[j], sc = scv[j]; const f32x4 hv = xn * (sc + 1.0f) + sh;
                        *(unsigned*)(H8 + row * DM + col) = pg8::pk4_fp8(hv[0], hv[1], hv[2], hv[3]);
                        const unsigned h01 = pk2(hv[0], hv[1]), h23 = pk2(hv[2], hv[3]);
                        const unsigned l01 = pk2(hv[0] - bflo(h01), hv[1] - bfhi(h01)), l23 = pk2(hv[2] - bflo(h23), hv[3] - bfhi(h23));
                        *(LAS u32x2*)(HT1 + (2 * wave + rr) * 1032 + col) = (u32x2){h01, h23}; *(LAS u32x2*)(HT2 + (2 * wave + rr) * 1032 + col) = (u32x2){l01, l23}; } }
                __syncthreads();
                { f32x4 a0 = (f32x4){0.f, 0.f, 0.f, 0.f}, a1 = a0;
#pragma unroll
                  for (int s4 = 0; s4 < 4; ++s4) { const int s = 4 * wave + s4;
                    const bf16x8 h1 = *(const LAS bf16x8*)(HT1 + (lane & 15) * 1032 + 32 * s + 8 * (lane >> 4)), h2 = *(const LAS bf16x8*)(HT2 + (lane & 15) * 1032 + 32 * s + 8 * (lane >> 4));
                    const bf16x8 w10 = wrf[s4][0], w11 = wrf[s4][1], w20 = wrf[s4][2], w21 = wrf[s4][3];
                    a0 = __builtin_amdgcn_mfma_f32_16x16x32_bf16(h1, w10, a0, 0, 0, 0); a0 = __builtin_amdgcn_mfma_f32_16x16x32_bf16(h1, w20, a0, 0, 0, 0); a0 = __builtin_amdgcn_mfma_f32_16x16x32_bf16(h2, w10, a0, 0, 0, 0);
                    a1 = __builtin_amdgcn_mfma_f32_16x16x32_bf16(h1, w11, a1, 0, 0, 0); a1 = __builtin_amdgcn_mfma_f32_16x16x32_bf16(h1, w21, a1, 0, 0, 0); a1 = __builtin_amdgcn_mfma_f32_16x16x32_bf16(h2, w11, a1, 0, 0, 0); }
#pragma unroll
                  for (int i = 0; i < 4; ++i) { PART[wave * 512 + (4 * (lane >> 4) + i) * 32 + (lane & 15)] = a0[i]; PART[wave * 512 + (4 * (lane >> 4) + i) * 32 + 16 + (lane & 15)] = a1[i]; } }
                __syncthreads();
                { const int half = lane >> 5, my_e = lane & 31, rloc = 2 * wave + half;
                  float lg = brv;
#pragma unroll
                  for (int w8 = 0; w8 < 8; ++w8) lg += PART[w8 * 512 + rloc * 32 + my_e];
                  float tv[4]; int te[4];
#pragma unroll
                  for (int k = 0; k < 4; ++k) { float mx = lg;
                    mx = row16_max(mx); mx = fmaxf(mx, shx(mx, 16, lane));
                    const unsigned long long bal = __ballot(lg == mx); const unsigned m32 = (unsigned)(bal >> (32 * half)); const int e = __ffs((int)m32) - 1;
                    tv[k] = mx; te[k] = e; if (my_e == e) lg = -3.0e38f; }
                  const float e1 = __expf(tv[1] - tv[0]), e2 = __expf(tv[2] - tv[0]), e3 = __expf(tv[3] - tv[0]); const float inv = 1.0f / (1.0f + e1 + e2 + e3);
                  if (my_e < 4) { const int e = my_e == 0 ? te[0] : my_e == 1 ? te[1] : my_e == 2 ? te[2] : te[3]; const float gt = (my_e == 0 ? 1.0f : my_e == 1 ? e1 : my_e == 2 ? e2 : e3) * inv;
                    const int lr = __hip_atomic_fetch_add(hist + e, 1, __ATOMIC_RELAXED, __HIP_MEMORY_SCOPE_WORKGROUP);
                    LAS int* en = ent + ((grp * 16 + rloc) * 4 + my_e) * 3; en[0] = e; en[1] = lr; en[2] = __builtin_bit_cast(int, gt); } }
                grp = gnx;
            } }
#undef LN1_VALID
#undef LN1_LOAD
            __syncthreads();
            if (tid < 32) { const int hc = hist[tid]; basel[tid] = hc ? (int)__hip_atomic_fetch_add(ctl + CW_CURSOR + layer * 32 + tid, (unsigned)hc, __ATOMIC_RELAXED, __HIP_MEMORY_SCOPE_AGENT) : 0; }
            __syncthreads();
            for (int i = tid; i < rows_per_wg * 4; i += NTHR) { const int rl = i >> 2; const int row = rbase + rl; const bool isctx = (row % TPB) < CTXL; if (lastl && isctx) continue;
                const LAS int* en = ent + i * 3; const int e = en[0]; const int pos = e * CAP + basel[e] + en[1];
                slot_tok[pos] = row; slot_gate[pos] = __builtin_bit_cast(float, en[2]); tok_pos[row * 4 + (i & 3)] = pos; }
        }
        GRID_BARP(14);
        LAS int* tb_bb = (LAS int*)(lds + LDS_MISC + 64);
        LAS int* tb_cnt = (LAS int*)(lds + LDS_MISC + 64 + 256);
        if (wave0 == 0) { PHASE_ARGS(); unsigned* ctl = WSP(unsigned, WS_CTL); const int ln = lane_now();
            const int c = (ln < 32) ? (int)__hip_atomic_load(ctl + CW_CURSOR + layer * 32 + ln, __ATOMIC_RELAXED, __HIP_MEMORY_SCOPE_AGENT) : 0;
            int incl = (c + 255) >> 8;
#pragma unroll
            for (int o = 1; o < 32; o <<= 1) { const int t = __builtin_amdgcn_ds_bpermute(((ln - o) & 63) << 2, incl); if ((ln & 31) >= o) incl += t; }
            if (ln < 32) { tb_cnt[ln] = c; tb_bb[ln] = incl - ((c + 255) >> 8); if (ln == 31) tb_bb[32] = incl; } }
        __syncthreads();
        LAS int* tb_be = (LAS int*)(lds + LDS_MISC + 512);
        { PHASE_IDS(); const int nblk = tb_bb[32];
#pragma clang loop vectorize(disable) unroll(disable)
          for (int i = tid; i < nblk; i += NTHR) { int e = 0;
#pragma unroll
            for (int j = 1; j < 32; ++j) e += (i >= tb_bb[j]) ? 1 : 0;
            tb_be[i] = e; } }
        __syncthreads();
        LAS unsigned char* side_buf = lds + LDS_MISC + 4096;
        {
            PHASE_ARGS(); pg8::SchedMoE S; S.bb = tb_bb; S.cnt = tb_cnt; S.be = tb_be; S.NT = 8; S.G = Gp; S.c = vcup; S.Acompact = nullptr; S.a_tstep = 0;
            S.bias = IN(12) + (size_t)layer * 32 * 2048; S.bias_estride = 2048; S.bias_pnstep = 128; S.bias_seg1 = 1024;
            const int* slot_tok = WSP(int, WS_SLOTTOK); const float* slot_gate = WSP(float, WS_SLOTGATE);
            S.W = (const char*)(WSP(unsigned char, WS_WEXPIN) + (size_t)layer * 32 * 2048 * 1024); S.w_estep = (size_t)2048 * 1024; S.w_tstep = (size_t)256 * 1024; S.slot_tok = slot_tok; S.slot_gate = slot_gate;
            pg8::EpiSwiglu E; E.Z = WSP(unsigned char, WS_Z); E.bias = IN(12) + (size_t)layer * 32 * 2048;
            for (int rep_ = 0; rep_ < DUPN(4); ++rep_)
            pg8::gemm_phase<pg8::EpiSwiglu, pg8::SchedMoE, true, true, true>(wave0, lds + LDS_STAGE, 1024, 1024, (const char*)WSP(unsigned char, WS_H8), S, E, side_buf);
        }
        GRID_BARP(15);
        {
            PHASE_ARGS(); pg8::SchedMoE S; S.bb = tb_bb; S.cnt = tb_cnt; S.be = tb_be; S.NT = 4; S.G = Gp; S.c = vcup;
            S.bias = IN(14) + (size_t)layer * 32 * 1024; S.bias_estride = 1024; S.bias_pnstep = 256; S.bias_seg1 = 128; S.Acompact = (const char*)WSP(unsigned char, WS_Z); S.a_tstep = (size_t)256 * 1024;
            const int* slot_tok = WSP(int, WS_SLOTTOK); const float* slot_gate = WSP(float, WS_SLOTGATE);
            S.W = (const char*)(WSP(unsigned char, WS_WEXPOUT) + (size_t)layer * 32 * 1024 * 1024); S.w_estep = (size_t)1024 * 1024; S.w_tstep = (size_t)256 * 1024; S.slot_tok = slot_tok; S.slot_gate = slot_gate;
            pg8::EpiMoeOut E; E.Y2 = WSP(unsigned char, WS_Y2); E.bias = IN(14) + (size_t)layer * 32 * 1024;
            for (int rep_ = 0; rep_ < DUPN(5); ++rep_)
            pg8::gemm_phase<pg8::EpiMoeOut, pg8::SchedMoE, false, true, true, true>(wave0, lds + LDS_STAGE, 1024, 1024, nullptr, S, E, side_buf);
        }
        GRID_BARP(16);
        {
            PHASE_IDS(); PHASE_ARGS();
            const float* ln_g = IN(6); const float* ln_b = IN(7); const float* MOD = WSP(float, WS_MOD); unsigned short* X16 = WSP(unsigned short, WS_X); const unsigned char* Y = WSP(unsigned char, WS_Y); const float* in_x = IN(0); const float* in_ctx = IN(2); unsigned char* H = WSP(unsigned char, WS_H8);
            const unsigned char* Y2 = WSP(unsigned char, WS_Y2); const int* tok_pos = WSP(int, WS_TOKPOS); float* outp = A_->out;
            const float* g2 = ln_g + (size_t)(layer * 2 + 1) * 1024; const float* b2 = ln_b + (size_t)(layer * 2 + 1) * 1024;
            const float* g1 = ln_g + (size_t)(layer * 2 + 0) * 1024; const float* b1 = ln_b + (size_t)(layer * 2 + 0) * 1024;
            LAS float* L2V = (LAS float*)(lds + LDS_STAGE);
            __syncthreads();
            for (int i = tid; i < 1024; i += NTHR) { const int q = i >> 8, c4 = (i & 255) * 4; const float* sp_ = (q == 0 ? g2 : q == 1 ? b2 : q == 2 ? g1 : b1) + c4; *(LAS f32x4*)(L2V + 4096 + q * 1024 + c4) = *(const f32x4*)sp_; }
            const int rbase2 = vcu * (M / 256);
            int mod_kind = -1;
            for (int rep_ = 0; rep_ < DUPN(13); ++rep_) {
            u32x4 tpn[2];
#pragma unroll
            for (int rr = 0; rr < 2; ++rr) tpn[rr] = *(const u32x4*)(tok_pos + (size_t)(rbase2 + 2 * wave + rr) * 4);
            for (int trip = 0; trip < 9; ++trip) {
                const int row0 = rbase2 + 2 * (wave + 8 * trip); const int b = row0 / TPB, t = row0 % TPB; const bool isctx = t < CTXL;
                const u32x4 tpc[2] = {tpn[0], tpn[1]};
                if (trip + 1 < 9) {
#pragma unroll
                    for (int rr = 0; rr < 2; ++rr) tpn[rr] = *(const u32x4*)(tok_pos + (size_t)(row0 + 16 + rr) * 4); }
                if (lastl && isctx) continue;
                if (mod_kind != (isctx ? 1 : 0)) { mod_kind = isctx ? 1 : 0;
                    const float* mr_ = MOD + (size_t)(layer * 17 + (isctx ? 16 : b)) * 6144; const float* mn_ = MOD + (size_t)((layer + 1 < DEPTH ? layer + 1 : layer) * 17 + (isctx ? 16 : b)) * 6144;
                    __syncthreads();
                    for (int i = tid; i < 1024; i += NTHR) { const int q = i >> 8, c4 = (i & 255) * 4;
                        const f32x4 x_ = (q == 0) ? *(const f32x4*)(mr_ + 5120 + c4) * pg8::Y2SCALE_INV : (q == 1) ? *(const f32x4*)(mn_ + c4) : (q == 2) ? *(const f32x4*)(mn_ + 1024 + c4) : *(const f32x4*)(mr_ + 2048 + c4) * (1.0f / 64.0f);
                        *(LAS f32x4*)(L2V + q * 1024 + c4) = x_; }
                    __syncthreads(); }
                int zr[2][4];
#pragma unroll
                for (int rr = 0; rr < 2; ++rr) { const u32x4 tp = tpc[rr];
#pragma unroll
                    for (int k = 0; k < 4; ++k) { const int pos = (int)tp[k]; const int e = pos / CAP, rk = pos % CAP; zr[rr][k] = tb_bb[e] * 256 + rk; } }
                f32x4 v[2][4]; unsigned yw[2][4][4], y1w[2][4]; u32x2 xh[2][4];
#pragma unroll
                for (int rr = 0; rr < 2; ++rr) { const size_t row_ = (size_t)(row0 + rr);
#pragma unroll
                    for (int j = 0; j < 4; ++j) xh[rr][j] = *(const u32x2*)(X16 + row_ * DM + 4 * lane + 256 * j);
#pragma unroll
                    for (int j = 0; j < 4; ++j) { const int col = 4 * lane + 256 * j; y1w[rr][j] = *(const unsigned*)(Y + row_ * DM + col);
#pragma unroll
                        for (int k = 0; k < 4; ++k) yw[rr][j][k] = *(const unsigned*)(Y2 + (size_t)zr[rr][k] * 1024 + col); } }
#pragma unroll
                for (int rr = 0; rr < 2; ++rr) { float s = 0.f;
#pragma unroll
                    for (int j = 0; j < 4; ++j) { const int yw1 = (int)y1w[rr][j]; const f32x2 ylo = __builtin_amdgcn_cvt_pk_f32_fp8(yw1, false), yhi = __builtin_amdgcn_cvt_pk_f32_fp8(yw1, true); const f32x4 gt = *(const LAS f32x4*)(L2V + 3072 + 4 * lane + 256 * j);
                        v[rr][j] = h4_to_f32(xh[rr][j].x, xh[rr][j].y) * ALPHA; v[rr][j][0] += gt[0] * ylo[0]; v[rr][j][1] += gt[1] * ylo[1]; v[rr][j][2] += gt[2] * yhi[0]; v[rr][j][3] += gt[3] * yhi[1];
                        s += (v[rr][j][0] + v[rr][j][1]) + (v[rr][j][2] + v[rr][j][3]); }
                    const float mean = wave_sum(s, lane) * (1.f / DM); float s2 = 0.f;
#pragma unroll
                    for (int j = 0; j < 4; ++j) { v[rr][j] = v[rr][j] - mean; s2 += (v[rr][j][0] * v[rr][j][0] + v[rr][j][1] * v[rr][j][1]) + (v[rr][j][2] * v[rr][j][2] + v[rr][j][3] * v[rr][j][3]); }
                    const float rstd = 1.f / sqrtf(wave_sum(s2, lane) * (1.f / DM) + LN_EPS);
#pragma unroll
                    for (int j = 0; j < 4; ++j) v[rr][j] = v[rr][j] * rstd * *(const LAS f32x4*)(L2V + 6144 + 4 * lane + 256 * j) + *(const LAS f32x4*)(L2V + 7168 + 4 * lane + 256 * j); }
#pragma unroll
                for (int rr = 0; rr < 2; ++rr) { const int row = row0 + rr; float s = 0.f;
#pragma unroll
                    for (int j = 0; j < 4; ++j) { const int col = 4 * lane + 256 * j; f32x4 y = (f32x4){0.f, 0.f, 0.f, 0.f};
#pragma unroll
                        for (int k = 0; k < 4; ++k) { const int w = (int)yw[rr][j][k]; const f32x2 lo = __builtin_amdgcn_cvt_pk_f32_fp8(w, false), hi = __builtin_amdgcn_cvt_pk_f32_fp8(w, true); y[0] += lo[0]; y[1] += lo[1]; y[2] += hi[0]; y[3] += hi[1]; }
                        const f32x4 gt = *(const LAS f32x4*)(L2V + col);
                        v[rr][j] = v[rr][j] * ALPHA + gt * y; s += (v[rr][j][0] + v[rr][j][1]) + (v[rr][j][2] + v[rr][j][3]); }
                    const float mean = wave_sum(s, lane) * (1.f / DM); float s2 = 0.f;
#pragma unroll
                    for (int j = 0; j < 4; ++j) { v[rr][j] = v[rr][j] - mean; s2 += (v[rr][j][0] * v[rr][j][0] + v[rr][j][1] * v[rr][j][1]) + (v[rr][j][2] * v[rr][j][2] + v[rr][j][3] * v[rr][j][3]); }
                    const float rstd = 1.f / sqrtf(wave_sum(s2, lane) * (1.f / DM) + LN_EPS);
#pragma unroll
                    for (int j = 0; j < 4; ++j) { const int col = 4 * lane + 256 * j; const f32x4 gg = *(const LAS f32x4*)(L2V + 4096 + col), bb = *(const LAS f32x4*)(L2V + 5120 + col);
                        const f32x4 xn = v[rr][j] * rstd * gg + bb;
                        if (lastl) { *(f32x4*)(outp + ((size_t)b * SEQ + (t + rr - CTXL)) * DM + col) = xn; }
                        else { *(u32x2*)(X16 + (size_t)row * DM + col) = f32_to_h4(xn);
                            const f32x4 sh = *(const LAS f32x4*)(L2V + 1024 + col), sc = *(const LAS f32x4*)(L2V + 2048 + col); const f32x4 h = xn * (sc + 1.0f) + sh;
                            *(unsigned*)(H + (size_t)row * DM + col) = pg8::pk4_fp8(h[0], h[1], h[2], h[3]); } } }
            } }
        }
        if (!lastl) GRID_BARP(17);
    }
    if (PROBE_MASK != 0ull) {
        PT_SAMPLE(17);
        __syncthreads();
        const unsigned pt_target_ = MISC[3401] * PROBE_MULT; const unsigned pt_t0_ = (unsigned)__builtin_amdgcn_s_memrealtime();
        while ((unsigned)__builtin_amdgcn_s_memrealtime() - pt_t0_ < pt_target_) __builtin_amdgcn_s_sleep(32);
    }
}

extern "C" void kernel_launch(void* const* d_in, const int* in_sizes, int n_in, void* d_out, int out_size, void* d_ws, size_t ws_size, hipStream_t stream) {
    static int grid = 0;
    if (grid == 0) {
        if (n_in != 34 || ws_size < WS_END) { fprintf(stderr, "kernel_launch: unexpected n_in %d / ws %zu (need %zu)\n", n_in, ws_size, (size_t)WS_END); grid = -1; return; }
        int dev = 0, cus = 0, per_cu = 0;
        if (hipGetDevice(&dev) != hipSuccess || hipDeviceGetAttribute(&cus, hipDeviceAttributeMultiprocessorCount, dev) != hipSuccess) { grid = -1; return; }
        if (hipFuncSetAttribute((const void*)fwd_kernel, hipFuncAttributeMaxDynamicSharedMemorySize, LDS_BYTES) != hipSuccess) { fprintf(stderr, "kernel_launch: hipFuncSetAttribute failed\n"); grid = -1; return; }
        if (hipOccupancyMaxActiveBlocksPerMultiprocessor(&per_cu, (const void*)fwd_kernel, NTHR, LDS_BYTES) != hipSuccess || per_cu < 1) { fprintf(stderr, "kernel_launch: occupancy query says %d\n", per_cu); }
        (void)hipGetLastError();
        if (cus < 256) { fprintf(stderr, "kernel_launch: built for a 256-CU device (one resident workgroup per CU), found %d CUs\n", cus); grid = -1; return; }
        grid = 256;
    }
    if (grid < 0) return;
    (void)hipMemsetAsync((char*)d_ws + WS_CTL, 0, CTL_BYTES, stream);
    Args a{};
    for (int i = 0; i < 34; ++i) a.in[i] = (const float*)d_in[i];
    a.out = (float*)d_out; a.ws = (unsigned char*)d_ws;
    hipLaunchKernelGGL(fwd_kernel, dim3(grid), dim3(NTHR), LDS_BYTES, stream, a);
    const hipError_t le = hipPeekAtLastError();
    if (le != hipSuccess) fprintf(stderr, "kernel_launch: launch failed: %s\n", hipGetErrorName(le));
}
```

```cpp
#include <hip/hip_runtime.h>
#include <stdint.h>
#include <stdio.h>
#ifndef DUPSEL
#define DUPSEL 0
#endif
#define DUPN(k) ((DUPSEL == (k)) ? 2 : 1)
#define PROBE_MASK 0ull

#define LAS __attribute__((address_space(3)))
#define GAS __attribute__((address_space(1)))
typedef unsigned short bf16_t;
typedef short bf16x8 __attribute__((ext_vector_type(8)));
typedef float f32x4 __attribute__((ext_vector_type(4)));
typedef float f32x2 __attribute__((ext_vector_type(2)));
typedef unsigned u32x4 __attribute__((ext_vector_type(4)));
typedef unsigned u32x2 __attribute__((ext_vector_type(2)));

constexpr int DM = 1024, NB = 16, SEQ = 2048, CTXL = 256, TPB = SEQ + CTXL  ;
constexpr int M = NB * TPB;
constexpr int NPANEL = M / 256;
constexpr int DEPTH = 4, NEXP = 32, TOPK = 4, DFF = 1024;
constexpr int CAP = M;
constexpr int NPAD = M * TOPK + NEXP * 256;
constexpr float ALPHA = 1.681792830507429f;
constexpr float LN_EPS = 1e-5f;
constexpr int NWAVES = 8, NTHR = 512;

constexpr size_t MiB = 1ull << 20;
constexpr size_t WS_CTL = 0, CTL_BYTES = 1 * MiB;
constexpr size_t WS_MOD = 1 * MiB;
constexpr size_t WS_X = 4 * MiB;
constexpr size_t WS_H = WS_X + 144 * MiB;
constexpr size_t WS_Y = WS_H + 72 * MiB;
constexpr size_t WS_OL = WS_Y + 72 * MiB;
constexpr size_t WS_PROJ = WS_OL + 72 * MiB;
constexpr size_t WS_Z = WS_PROJ + 126 * MiB;
constexpr size_t WS_Y2 = WS_Z + 304 * MiB;
constexpr size_t WS_SLOTTOK = WS_Y2 + 304 * MiB;
constexpr size_t WS_SLOTGATE = WS_SLOTTOK + 5 * MiB;
constexpr size_t WS_TOKPOS = WS_SLOTGATE + 5 * MiB;
constexpr size_t WS_WEXPIN = WS_TOKPOS + 1 * MiB;
constexpr size_t WS_WEXPOUT = WS_WEXPIN + 512 * MiB;
constexpr size_t WS_WMIX = WS_WEXPOUT + 256 * MiB;
constexpr size_t WS_WINAB = WS_WMIX + 8 * MiB;
constexpr size_t WS_WINCD = WS_WINAB + 6 * MiB;
constexpr size_t WS_WGLU = WS_WINCD + 7 * MiB;
constexpr size_t WS_WUQ = WS_WGLU + 1 * MiB;
constexpr size_t WS_WUKV = WS_WUQ + 1 * MiB;
constexpr size_t WS_ROPE = WS_WUKV + 1 * MiB;
constexpr size_t WS_QM = WS_ROPE + 1 * MiB;
constexpr size_t WS_KVM = WS_QM + 54 * MiB;
constexpr size_t WS_UT = WS_KVM + 72 * MiB;
constexpr size_t WS_XS = WS_UT + 36 * MiB;
constexpr size_t WS_HIN = WS_XS + 72 * MiB;
constexpr size_t WS_ZG = WS_HIN + 36 * MiB;
constexpr size_t WS_TF = WS_ZG + 36 * MiB;
constexpr size_t WS_SF = WS_TF + 2 * MiB;
constexpr size_t WS_WF = WS_SF + 8 * MiB;
constexpr size_t WS_LAM16 = WS_WF + 8 * MiB;
constexpr size_t WS_ZG8 = WS_LAM16 + 1 * MiB;
constexpr size_t WS_X1 = WS_LAM16 + 1 * MiB;
constexpr size_t WS_H8 = WS_X1 + 144 * MiB;
constexpr size_t WS_WRF = WS_H8 + 36 * MiB;
constexpr size_t WS_END = WS_WRF + 1 * MiB;

constexpr int CW_BAR = 4096;
constexpr int CW_CURSOR = 8192;

constexpr int LDS_STAGE = 0, LDS_MISC = 133120, LDS_BYTES = 147456;

__device__ __forceinline__ int lane_now() { int l; asm volatile("v_mbcnt_lo_u32_b32 %0, -1, 0\n\tv_mbcnt_hi_u32_b32 %0, -1, %0" : "=v"(l)); return l; }
__device__ __forceinline__ unsigned f2bf(float f) { unsigned u = __builtin_bit_cast(unsigned, f); return (u + 0x7fffu + ((u >> 16) & 1u)) >> 16; }
__device__ __forceinline__ unsigned pk2(float lo, float hi) { unsigned r; asm("v_cvt_pk_bf16_f32 %0, %1, %2" : "=v"(r) : "v"(lo), "v"(hi)); return r; }
__device__ __forceinline__ float bf2f(unsigned short b) { return __builtin_bit_cast(float, ((unsigned)b) << 16); }
__device__ __forceinline__ float bflo(unsigned w) { return __builtin_bit_cast(float, w << 16); }
__device__ __forceinline__ float bfhi(unsigned w) { return __builtin_bit_cast(float, w & 0xffff0000u); }
__device__ __forceinline__ float shx(float v, int o, int lane) { return __builtin_bit_cast(float, __builtin_amdgcn_ds_bpermute((lane ^ o) << 2, __builtin_bit_cast(int, v))); }
__device__ __forceinline__ float row16_sum(float v) {
    v += __builtin_bit_cast(float, __builtin_amdgcn_update_dpp(0, __builtin_bit_cast(int, v), 0xB1, 0xF, 0xF, true));
    v += __builtin_bit_cast(float, __builtin_amdgcn_update_dpp(0, __builtin_bit_cast(int, v), 0x4E, 0xF, 0xF, true));
    v += __builtin_bit_cast(float, __builtin_amdgcn_update_dpp(0, __builtin_bit_cast(int, v), 0x141, 0xF, 0xF, true));
    v += __builtin_bit_cast(float, __builtin_amdgcn_update_dpp(0, __builtin_bit_cast(int, v), 0x140, 0xF, 0xF, true));
    return v;
}
__device__ __forceinline__ float row16_max(float v) {
    v = fmaxf(v, __builtin_bit_cast(float, __builtin_amdgcn_update_dpp(__builtin_bit_cast(int, v), __builtin_bit_cast(int, v), 0xB1, 0xF, 0xF, false)));
    v = fmaxf(v, __builtin_bit_cast(float, __builtin_amdgcn_update_dpp(__builtin_bit_cast(int, v), __builtin_bit_cast(int, v), 0x4E, 0xF, 0xF, false)));
    v = fmaxf(v, __builtin_bit_cast(float, __builtin_amdgcn_update_dpp(__builtin_bit_cast(int, v), __builtin_bit_cast(int, v), 0x141, 0xF, 0xF, false)));
    v = fmaxf(v, __builtin_bit_cast(float, __builtin_amdgcn_update_dpp(__builtin_bit_cast(int, v), __builtin_bit_cast(int, v), 0x140, 0xF, 0xF, false)));
    return v;
}
__device__ __forceinline__ float wave_sum(float v, int lane) {
    (void)lane;
    v += __builtin_bit_cast(float, __builtin_amdgcn_update_dpp(0, __builtin_bit_cast(int, v), 0xB1, 0xF, 0xF, true));
    v += __builtin_bit_cast(float, __builtin_amdgcn_update_dpp(0, __builtin_bit_cast(int, v), 0x4E, 0xF, 0xF, true));
    v += __builtin_bit_cast(float, __builtin_amdgcn_update_dpp(0, __builtin_bit_cast(int, v), 0x141, 0xF, 0xF, true));
    v += __builtin_bit_cast(float, __builtin_amdgcn_update_dpp(0, __builtin_bit_cast(int, v), 0x140, 0xF, 0xF, true));
    const int vi = __builtin_bit_cast(int, v);
    return (__builtin_bit_cast(float, __builtin_amdgcn_readlane(vi, 0)) + __builtin_bit_cast(float, __builtin_amdgcn_readlane(vi, 16))) +
           (__builtin_bit_cast(float, __builtin_amdgcn_readlane(vi, 32)) + __builtin_bit_cast(float, __builtin_amdgcn_readlane(vi, 48)));
}
__device__ __forceinline__ int uni(int v) { return __builtin_amdgcn_readfirstlane(v); }
typedef _Float16 h16x4 __attribute__((ext_vector_type(4)));
__device__ __forceinline__ float h2f(unsigned short b) { return (float)__builtin_bit_cast(_Float16, b); }
__device__ __forceinline__ f32x4 h4_to_f32(unsigned lo, unsigned hi) { return (f32x4){h2f((unsigned short)(lo & 0xffffu)), h2f((unsigned short)(lo >> 16)), h2f((unsigned short)(hi & 0xffffu)), h2f((unsigned short)(hi >> 16))}; }
__device__ __forceinline__ u32x2 f32_to_h4(f32x4 v) { const h16x4 h = {(_Float16)v[0], (_Float16)v[1], (_Float16)v[2], (_Float16)v[3]}; return __builtin_bit_cast(u32x2, h); }
__device__ __forceinline__ const char* unip(const char* p) { const unsigned long long v = (unsigned long long)p; const unsigned lo = (unsigned)__builtin_amdgcn_readfirstlane((int)(unsigned)v), hi = (unsigned)__builtin_amdgcn_readfirstlane((int)(unsigned)(v >> 32)); return (const char*)(((unsigned long long)hi << 32) | lo); }
#define PHASE_IDS() const int lane = lane_now(); const int wave = wave0; const int tid = wave0 * 64 + lane; const int gw = vcu * NWAVES + wave; (void)lane; (void)gw
#define LDS_WAIT() asm volatile("s_waitcnt lgkmcnt(0)" ::: "memory")
#define VM_WAIT() asm volatile("s_waitcnt vmcnt(0)" ::: "memory")

#define XB_TMO      128
#define XB_XCNT(j)  (256  + 64 * (j))
#define XB_XSUB(j)  (1280 + 64 * (j))
#define XB_XGEN(j)  (2304 + 64 * (j))
#define XB_TOP      3328
#define XB_TOPGEN   3392
#define XCD_BAR_WORDS 3456
#define XB_SPIN_CAP (1u << 22)

__device__ __forceinline__ unsigned xb_ld(unsigned* p)              { return __hip_atomic_load(p, __ATOMIC_RELAXED, __HIP_MEMORY_SCOPE_AGENT); }
__device__ __forceinline__ unsigned xb_add(unsigned* p, unsigned v) { return __hip_atomic_fetch_add(p, v, __ATOMIC_RELAXED, __HIP_MEMORY_SCOPE_AGENT); }
__device__ __forceinline__ unsigned xb_xcc_id() { return (unsigned)__builtin_amdgcn_s_getreg((3 << 11) | 20) & 0xFu; }
#define XB_SPIN(cond, bar) do { unsigned _sp = 0; while (cond) { __builtin_amdgcn_s_sleep(1); \
    if ((++_sp & 255u) == 0u) { if (xb_ld(&(bar)[XB_TMO])) break; if (_sp > XB_SPIN_CAP) { atomicAdd(&(bar)[XB_TMO], 1u); break; } } } } while (0)

struct XcdBarrier { unsigned* bar; unsigned x; volatile LAS unsigned* st; };

__device__ __forceinline__ XcdBarrier xcd_barrier_post(unsigned* bar, volatile LAS unsigned* st) {
    XcdBarrier b; b.bar = bar; b.x = 0; b.st = st;
    if (threadIdx.x == 0) (void)xb_add(&bar[XB_XCNT(xb_xcc_id())], 1u);
    return b;
}
__device__ __forceinline__ void xcd_barrier_complete(unsigned* bar, unsigned x, unsigned& nloc, unsigned& nx) {
    const unsigned G = gridDim.x * gridDim.y * gridDim.z;
    unsigned sum, cnt, mine, sp = 0u;
    for (;;) {
        sum = 0u; cnt = 0u; mine = 0u;
#pragma unroll
        for (unsigned j = 0; j < 16; ++j) { const unsigned c = xb_ld(&bar[XB_XCNT(j)]); sum += c; cnt += (c > 0u) ? 1u : 0u; mine = (j == x) ? c : mine; }
        if (sum == G) break;
        __builtin_amdgcn_s_sleep(1);
        if ((++sp & 255u) == 0u) { if (xb_ld(&bar[XB_TMO])) break; if (sp > XB_SPIN_CAP) { atomicAdd(&bar[XB_TMO], 1u); break; } }
    }
    nloc = mine > 0u ? mine : 1u; nx = cnt > 0u ? cnt : 1u;
}
__device__ __forceinline__ void xcd_barrier(const XcdBarrier& b) {
    asm volatile("s_waitcnt vmcnt(0)" ::: "memory");
    __syncthreads();
    if (b.x == 0u && lane_now() == 0) {
        unsigned* bar = b.bar;
        __builtin_amdgcn_s_waitcnt(0);
        unsigned bx_; asm volatile("s_getreg_b32 %0, hwreg(HW_REG_XCC_ID, 0, 4)" : "=s"(bx_));
        unsigned nloc = b.st[0], nx = b.st[1];
        if (nloc == 0u) { xcd_barrier_complete(bar, bx_, nloc, nx); b.st[0] = nloc; b.st[1] = nx; }
        const unsigned old = xb_add(&bar[XB_XSUB(bx_)], 1u);
        const unsigned gen = old / nloc;
        if (old + 1u == (gen + 1u) * nloc) {
            __builtin_amdgcn_fence(__ATOMIC_RELEASE, "agent");
            asm volatile("s_waitcnt vmcnt(0)" ::: "memory");
            const unsigned og = xb_add(&bar[XB_TOP], 1u);
            const unsigned tg = og / nx;
            if (og + 1u == (tg + 1u) * nx) xb_add(&bar[XB_TOPGEN], 1u);
            else XB_SPIN(xb_ld(&bar[XB_TOPGEN]) == tg, bar);
            __builtin_amdgcn_fence(__ATOMIC_ACQUIRE, "agent");
            xb_add(&bar[XB_XGEN(bx_)], 1u);
            asm volatile("s_waitcnt vmcnt(0)" ::: "memory");
        } else {
            XB_SPIN(xb_ld(&bar[XB_XGEN(bx_)]) == gen, bar);
            __builtin_amdgcn_fence(__ATOMIC_ACQUIRE, "agent");
            asm volatile("s_waitcnt vmcnt(0)" ::: "memory");
        }
    }
    __syncthreads();
}

namespace pg8 {
constexpr int BM = 256, BK = 64, HALF = 128, HTB = HALF * BK * 2, STAGE_BYTES = 8 * HTB;
__device__ __forceinline__ int lds_byte(int r, int c) { const int st = (r >> 4) * 2 + (c >> 5), rr = r & 15, cc = c & 31, ob = rr * 64 + cc * 2; return st * 1024 + (ob ^ (((ob >> 9) & 1) << 5)); }
__device__ __forceinline__ void stage_rc(int b, int& R, int& C) { const int st = b / 1024, sb = b % 1024, swz = sb ^ (((sb >> 9) & 1) << 5); R = (st >> 1) * 16 + swz / 64; C = (st & 1) * 32 + (swz % 64) / 2; }
__device__ __forceinline__ int perm32(int rho) { const int n = rho >> 4, i = rho & 15; return 8 * (i >> 2) + 4 * n + (i & 3); }

struct Unit { int pm, pn, g, e, nvalid, pad; const char* A; const char* B; const int* rows; const float* gates; const float* bias0; const float* bias1; };
constexpr int SIDE_BYTES = 3072;

__device__ __forceinline__ unsigned cvt_pk_bf16(float lo, float hi) { unsigned r; asm volatile("v_cvt_pk_bf16_f32 %0, %1, %2" : "=v"(r) : "v"(lo), "v"(hi)); return r; }

typedef int i32x8 __attribute__((ext_vector_type(8)));
typedef int i32x4 __attribute__((ext_vector_type(4)));
__device__ __forceinline__ i32x8 cat8(bf16x8 lo, bf16x8 hi) { const i32x4 a = __builtin_bit_cast(i32x4, lo), b = __builtin_bit_cast(i32x4, hi); return (i32x8){a[0], a[1], a[2], a[3], b[0], b[1], b[2], b[3]}; }
template <class Epi, class Sched, bool GATHER, bool FP8, bool SIDE = false, bool P16 = false>
__device__ __forceinline__ void gemm_phase(const int wid0, LAS unsigned char* lds, const int Kb, const int ldab, const char* Agather, const Sched& S, const Epi& E, LAS unsigned char* side = nullptr) {
    const int lane = lane_now(); const int wid = wid0; const int tid = wid0 * 64 + lane;
    const int wr = wid >> 2, wc = wid & 3, fr = lane & 15, fq = lane >> 4;
    const int nt = Kb / 128;
    constexpr bool PG_PROBE = FP8 && SIDE && ((GATHER && ((PROBE_MASK >> 31) & 1ull)) || (!GATHER && ((PROBE_MASK >> 30) & 1ull)));
    unsigned voffA[2], voffB[2]; int rowA[2]; unsigned colA2[2];
#pragma unroll
    for (int i = 0; i < 2; ++i) { int R, C; stage_rc(tid * 16 + i * 8192, R, C); const int Rb = P16 ? (64 * (R >> 5) + 16 * ((R & 15) >> 2) + 4 * ((R >> 4) & 1) + (R & 3)) : ((R & ~31) + perm32(R & 31));
        voffA[i] = (unsigned)(R * ldab + C * 2); voffB[i] = (unsigned)(Rb * Kb + C * 2); rowA[i] = R; colA2[i] = (unsigned)C * 2u; }
    const size_t kstep = (size_t)(BK * 2);
    const size_t hstepA = (size_t)HALF * ldab, hstepB = P16 ? (size_t)8 * Kb : (size_t)HALF * Kb;
    const unsigned ldsw = (unsigned)wid * 1024u;
    const int aoff = lds_byte(wr * 64 + fr, fq * 8), boff = lds_byte(wc * 32 + fr, fq * 8);
#define PG8_SA(b, h) (((b) * 2 + (h)) * HTB)
#define PG8_SB(b, h) ((4 + (b) * 2 + (h)) * HTB)
#define PG8_GLDS(gp, lp) __builtin_amdgcn_global_load_lds((const unsigned*)(gp), (LAS unsigned*)(lp), 16, 0, 0)
#define PG8_GLDS4(gp, lp) __builtin_amdgcn_global_load_lds((const unsigned*)(gp), (LAS unsigned*)(lp), 4, 0, 0)
#define PG8_STAGE_B(bufoff, gbase) do { const char* _q = (const char*)(gbase); asm volatile("" : "+s"(_q)); _Pragma("unroll") for (int _i = 0; _i < 2; ++_i) PG8_GLDS(_q + voffB[_i], lds + (bufoff) + ldsw + _i * 8192); } while (0)
#define PG8_STAGE_A(bufoff, h, nx, kb) do { if constexpr (GATHER) { const char* _p = Agather + (kb); asm volatile("" : "+s"(_p)); _Pragma("unroll") for (int _i = 0; _i < 2; ++_i) PG8_GLDS(_p + ((nx) ? nvo[h][_i] : cvo[h][_i]), lds + (bufoff) + ldsw + _i * 8192); } \
        else { const char* _p = ((nx) ? nA : cA) + (size_t)(h) * hstepA + (kb); asm volatile("" : "+s"(_p)); _Pragma("unroll") for (int _i = 0; _i < 2; ++_i) PG8_GLDS(_p + voffA[_i], lds + (bufoff) + ldsw + _i * 8192); } } while (0)
#define PG8_LDA(dst, b, h) do { _Pragma("unroll") for (int m = 0; m < 4; ++m) _Pragma("unroll") for (int k = 0; k < 2; ++k) dst[m][k] = *(const LAS bf16x8*)(lds + PG8_SA(b, h) + aoff + m * 2048 + k * 1024); } while (0)
#define PG8_LDB(dst, b, h) do { _Pragma("unroll") for (int n = 0; n < 2; ++n) _Pragma("unroll") for (int k = 0; k < 2; ++k) dst[n][k] = *(const LAS bf16x8*)(lds + PG8_SB(b, h) + boff + n * 2048 + k * 1024); } while (0)
#define PG8_MMA(ai, bj, At, Bt) do { __builtin_amdgcn_s_setprio(1); if constexpr (FP8) { _Pragma("unroll") for (int m = 0; m < 4; ++m) _Pragma("unroll") for (int n = 0; n < 2; ++n) \
        asm volatile("v_mfma_f32_16x16x128_f8f6f4 %0, %1, %2, %0" : "+v"(acc[ai][bj][m][n]) : "v"(cat8(Bt[n][0], Bt[n][1])), "v"(cat8(At[m][0], At[m][1]))); } \
      else { _Pragma("unroll") for (int m = 0; m < 4; ++m) _Pragma("unroll") for (int n = 0; n < 2; ++n) _Pragma("unroll") for (int k = 0; k < 2; ++k) \
        acc[ai][bj][m][n] = __builtin_amdgcn_mfma_f32_16x16x32_bf16(Bt[n][k], At[m][k], acc[ai][bj][m][n], 0, 0, 0); } __builtin_amdgcn_s_setprio(0); } while (0)
#define PG8_WAIT_V(n) asm volatile("s_waitcnt vmcnt(" #n ")" ::: "memory")
#define PG8_WAIT_L(n) asm volatile("s_waitcnt lgkmcnt(" #n ")" ::: "memory")
#define PG8_BAR __builtin_amdgcn_s_barrier()
#define PG8_SCHED __builtin_amdgcn_sched_barrier(0)
#define PG8_LOADVO(dst, par) do { if constexpr (GATHER) { const LAS int* _rw = (const LAS int*)(side + (par) * SIDE_BYTES); _Pragma("unroll") for (int _h = 0; _h < 2; ++_h) _Pragma("unroll") for (int _i = 0; _i < 2; ++_i) { \
        const int _t = _rw[_h * 128 + rowA[_i]]; dst[_h][_i] = (unsigned)_t * (unsigned)ldab + colA2[_i]; } } } while (0)
#define PG8_SIDE_DMA(u, par) do { if constexpr (SIDE) { LAS unsigned char* _sb = side + (par) * SIDE_BYTES; const int _e = (wid & 3) * 64 + lane; \
        if (wid < 4) { const int _ec = (_e < (u).nvalid) ? _e : 0; if constexpr (GATHER) PG8_GLDS4((const char*)((u).rows + _ec), _sb + (wid & 3) * 256); else PG8_GLDS4((const char*)((u).gates + _ec), _sb + 2048 + (wid & 3) * 256); } \
        else { const float* _bp = (_e < 128) ? (u).bias0 + _e : (u).bias1 + (_e - 128); PG8_GLDS4((const char*)_bp, _sb + 1024 + (wid & 3) * 256); } } } while (0)
    Unit cur, nxt; int ui = 0;
    if (!S.next(0, cur)) return;
    f32x4 acc[2][2][4][2];
#pragma unroll
    for (int a = 0; a < 2; ++a)
#pragma unroll
        for (int b = 0; b < 2; ++b)
#pragma unroll
            for (int m = 0; m < 4; ++m)
#pragma unroll
                for (int n = 0; n < 2; ++n) acc[a][b][m][n] = (f32x4){0.f, 0.f, 0.f, 0.f};
    bf16x8 At[4][2], B0[2][2], B1[2][2];
    unsigned cvo[2][2] = {{0u, 0u}, {0u, 0u}}, nvo[2][2] = {{0u, 0u}, {0u, 0u}};
    const char* cA = cur.A; const char* cB = cur.B; const char* nA = cA; const char* nB = cB;
    if constexpr (SIDE) { PG8_SIDE_DMA(cur, 0); PG8_WAIT_V(0); PG8_BAR; }
    PG8_LOADVO(cvo, 0);
    PG8_STAGE_B(PG8_SB(0, 0), cB); PG8_STAGE_A(PG8_SA(0, 0), 0, false, 0); PG8_STAGE_B(PG8_SB(0, 1), cB + hstepB); PG8_STAGE_A(PG8_SA(0, 1), 1, false, 0);
    if (wr == 1) PG8_BAR;
    PG8_WAIT_V(4); PG8_BAR;
    PG8_STAGE_B(PG8_SB(1, 0), cB + kstep); PG8_STAGE_A(PG8_SA(1, 0), 0, false, kstep); PG8_STAGE_B(PG8_SB(1, 1), cB + hstepB + kstep);
    PG8_WAIT_V(6); PG8_BAR;
    for (;;) {
        const bool has_next = S.next(ui + 1, nxt);
        const int npar = (ui + 1) % 3;
        if (has_next) { nA = nxt.A; nB = nxt.B; PG8_SIDE_DMA(nxt, npar); }
        else { nA = cA; nB = cB;
#pragma unroll
            for (int h = 0; h < 2; ++h)
#pragma unroll
                for (int i = 0; i < 2; ++i) nvo[h][i] = cvo[h][i]; }
        unsigned pg_t0_ = 0; if constexpr (PG_PROBE) pg_t0_ = (unsigned)__builtin_amdgcn_s_memrealtime();
#pragma clang loop unroll(disable)
        for (int t = 0; t < nt; t += 2) {
            const bool last = (t == nt - 2);
            if (last && has_next) PG8_LOADVO(nvo, npar);
            const size_t k1 = (size_t)(t + 1) * kstep;
            const size_t k2 = last ? 0 : (size_t)(t + 2) * kstep, k3 = k2 + kstep;
            const char* b2 = last ? nB : cB + (size_t)(t + 2) * kstep; const char* b3 = b2 + kstep;
            PG8_LDB(B0, 0, 0); PG8_SCHED; PG8_LDA(At, 0, 0); PG8_STAGE_A(PG8_SA(1, 1), 1, false, k1);
            PG8_WAIT_L(8); PG8_BAR; PG8_WAIT_L(0); PG8_MMA(0, 0, At, B0); PG8_BAR; PG8_SCHED;
            PG8_LDB(B1, 0, 1); PG8_STAGE_B(PG8_SB(0, 0), b2);
            PG8_BAR; PG8_WAIT_L(0); PG8_MMA(0, 1, At, B1); PG8_BAR;
            PG8_LDA(At, 0, 1); PG8_STAGE_A(PG8_SA(0, 0), 0, last, k2);
            PG8_BAR; PG8_WAIT_L(0); PG8_MMA(1, 0, At, B0); PG8_BAR; PG8_SCHED;
            PG8_STAGE_B(PG8_SB(0, 1), b2 + hstepB);
            PG8_WAIT_V(6); PG8_BAR; PG8_MMA(1, 1, At, B1); PG8_BAR;
            PG8_LDB(B0, 1, 0); PG8_SCHED; PG8_LDA(At, 1, 0); PG8_STAGE_A(PG8_SA(0, 1), 1, last, k2);
            PG8_WAIT_L(8); PG8_BAR; PG8_WAIT_L(0); PG8_MMA(0, 0, At, B0); PG8_BAR; PG8_SCHED;
            PG8_LDB(B1, 1, 1); PG8_STAGE_B(PG8_SB(1, 0), b3);
            PG8_BAR; PG8_WAIT_L(0); PG8_MMA(0, 1, At, B1); PG8_BAR;
            PG8_LDA(At, 1, 1); PG8_STAGE_A(PG8_SA(1, 0), 0, last, k3);
            PG8_BAR; PG8_WAIT_L(0); PG8_MMA(1, 0, At, B0); PG8_BAR; PG8_SCHED;
            PG8_STAGE_B(PG8_SB(1, 1), b3 + hstepB);
            PG8_WAIT_V(6); PG8_BAR; PG8_MMA(1, 1, At, B1); PG8_BAR;
        }
        if constexpr (PG_PROBE) { const unsigned pg_t1_ = (unsigned)__builtin_amdgcn_s_memrealtime(); if (wid == 0 && lane_now() == 0) { volatile LAS unsigned* pm_ = (volatile LAS unsigned*)(lds + LDS_MISC); pm_[3401] = pm_[3401] + (pg_t1_ - pg_t0_); } }
        if constexpr (FP8) asm volatile("s_nop 15\n\ts_nop 15" ::: "memory");
        { int fr2 = fr, fq2 = fq; asm volatile("" : "+v"(fr2), "+v"(fq2));
          E(acc, cur, wr, wc, fr2, fq2, side + (ui % 3) * SIDE_BYTES);
          if ((DUPSEL == 16 && FP8 && !GATHER) || (DUPSEL == 17 && FP8 && GATHER) || (DUPSEL == 18 && !FP8)) { asm volatile("" : "+v"(fr2), "+v"(fq2)); E(acc, cur, wr, wc, fr2, fq2, side + (ui % 3) * SIDE_BYTES); } }
        if (!has_next) break;
#pragma unroll
        for (int a = 0; a < 2; ++a)
#pragma unroll
            for (int b = 0; b < 2; ++b)
#pragma unroll
                for (int m = 0; m < 4; ++m)
#pragma unroll
                    for (int n = 0; n < 2; ++n) acc[a][b][m][n] = (f32x4){0.f, 0.f, 0.f, 0.f};
        cur = nxt; cA = nA; cB = nB; ++ui;
#pragma unroll
        for (int h = 0; h < 2; ++h)
#pragma unroll
            for (int i = 0; i < 2; ++i) cvo[h][i] = nvo[h][i];
    }
    PG8_WAIT_V(0);
    if (wr == 0) PG8_BAR;
    PG8_BAR;
#undef PG8_SA
#undef PG8_SB
#undef PG8_GLDS
#undef PG8_STAGE_A
#undef PG8_STAGE_B
#undef PG8_LDA
#undef PG8_LDB
#undef PG8_MMA
#undef PG8_WAIT_V
#undef PG8_WAIT_L
#undef PG8_BAR
#undef PG8_SCHED
#undef PG8_LOADVO
#undef PG8_SIDE_DMA
#undef PG8_GLDS4
}

struct SchedDense {
    int nM, nN, G, c, g; const char* A; const char* B; size_t a_tstep, b_tstep; int latent_only = 0;
    __device__ __forceinline__ bool next(int i, Unit& u) const {
        const int nwg = nM * nN; const long L = (long)i * G + c; if (L >= nwg) return false;
        int wgid = (int)L; { const int q = nwg / 8, r = nwg % 8, xcd = wgid % 8, off = wgid / 8; wgid = (xcd < r ? xcd * (q + 1) : r * (q + 1) + (xcd - r) * q) + off; }
        const int nig = 8 * nN, gid = wgid / nig, fm = gid * 8, gsz = (nM - fm) < 8 ? (nM - fm) : 8;
        u.pm = fm + ((wgid % nig) % gsz); u.pn = (wgid % nig) / gsz; u.g = g; u.e = 0; u.nvalid = 256; u.pad = 0;
        if (latent_only) u.pm = (u.pm >> 3) * 9 + 1 + (u.pm & 7);
        u.A = A + (size_t)u.pm * a_tstep; u.B = B + (size_t)u.pn * b_tstep; u.rows = nullptr; u.gates = nullptr; u.bias0 = nullptr; u.bias1 = nullptr; return true;
    }
};
struct SchedDual {
    int nM, nN0, nN1, G, c; const char* A0; const char* A1; const char* B0; const char* B1; size_t a_tstep, b_tstep;
    __device__ __forceinline__ bool next(int i, Unit& u) const {
        const int n0 = nM * nN0, n1 = nM * nN1; int L = i * G + c; if (L >= n0 + n1) return false;
        const int g = (L >= n0) ? 1 : 0; if (g) L -= n0; const int nN = g ? nN1 : nN0;
        u.pm = L / nN; u.pn = L % nN; u.g = g; u.e = 0; u.nvalid = 256; u.pad = 0;
        u.A = (g ? A1 : A0) + (size_t)u.pm * a_tstep; u.B = (g ? B1 : B0) + (size_t)u.pn * b_tstep; u.rows = nullptr; u.gates = nullptr; u.bias0 = nullptr; u.bias1 = nullptr; return true;
    }
};
struct SchedMoE {
    const LAS int* bb; const LAS int* cnt; const LAS int* be; int NT, G, c; const char* Acompact; size_t a_tstep; const char* W; size_t w_estep, w_tstep; const int* slot_tok; const float* slot_gate;
    const float* bias; int bias_estride, bias_seg1;
    int bias_pnstep;
    __device__ __forceinline__ bool next(int i, Unit& u) const {
        const int L = i * G + c; const int blk = L / NT, pn = L % NT;
        if (blk >= uni(bb[32])) return false;
        const int e = uni(be[blk]);
        const int rank0 = (blk - uni(bb[e])) * 256; int nv = uni(cnt[e]) - rank0; nv = nv > 256 ? 256 : nv;
        u.pm = blk; u.pn = pn; u.g = 0; u.e = e; u.nvalid = nv; u.pad = 0;
        u.A = unip(Acompact + (size_t)blk * a_tstep); u.B = unip(W + (size_t)e * w_estep + (size_t)pn * w_tstep);
        u.rows = (const int*)unip((const char*)(slot_tok + (size_t)e * CAP + rank0)); u.gates = (const float*)unip((const char*)(slot_gate + (size_t)e * CAP + rank0));
        u.bias0 = (const float*)unip((const char*)(bias + (size_t)e * bias_estride + pn * bias_pnstep)); u.bias1 = u.bias0 + bias_seg1; return true;
    }
};

__device__ __forceinline__ unsigned pk4_fp8(float a, float b, float c, float d) { int w = 0; w = __builtin_amdgcn_cvt_pk_fp8_f32(a, b, w, false); w = __builtin_amdgcn_cvt_pk_fp8_f32(c, d, w, true); return (unsigned)w; }
struct EpiBf16 {
    bf16_t* O; int ldc; float oscale = 1.0f;
    __device__ __forceinline__ void operator()(const f32x4 (&acc)[2][2][4][2], const Unit& u, int wr, int wc, int fr, int fq, LAS unsigned char* = nullptr) const {
        const int row0 = u.pm * BM + wr * 64 + fr, col0 = u.pn * BM + wc * 32 + 8 * fq;
#pragma unroll
        for (int ai = 0; ai < 2; ++ai)
#pragma unroll
            for (int m = 0; m < 4; ++m) { bf16_t* rowp = O + (size_t)(row0 + ai * HALF + m * 16) * ldc + col0;
#pragma unroll
                for (int bj = 0; bj < 2; ++bj) { const f32x4 v0 = acc[ai][bj][m][0] * oscale, v1 = acc[ai][bj][m][1] * oscale;
                    u32x4 w; w.x = cvt_pk_bf16(v0[0], v0[1]); w.y = cvt_pk_bf16(v0[2], v0[3]); w.z = cvt_pk_bf16(v1[0], v1[1]); w.w = cvt_pk_bf16(v1[2], v1[3]);
                    *(u32x4*)(rowp + bj * HALF) = w; } }
    }
};
struct EpiBf16U {
    bf16_t* O; int ldc; float oscale; bf16_t* UT;
    __device__ __forceinline__ void operator()(const f32x4 (&acc)[2][2][4][2], const Unit& u, int wr, int wc, int fr, int fq, LAS unsigned char* = nullptr) const {
        if (u.pn < 4) { EpiBf16 e; e.O = O; e.ldc = ldc; e.oscale = oscale; e(acc, u, wr, wc, fr, fq); return; }
        const int row0 = u.pm * BM + wr * 64 + fr, ch0 = (u.pn - 4) * BM + wc * 32 + 8 * fq;
        const int b = (u.pm * BM) / TPB, t0 = row0 - b * TPB;
#pragma unroll
        for (int ai = 0; ai < 2; ++ai)
#pragma unroll
            for (int m = 0; m < 4; ++m) { const int t = t0 + ai * HALF + m * 16;
#pragma unroll
                for (int bj = 0; bj < 2; ++bj) { const f32x4 v0 = acc[ai][bj][m][0] * oscale, v1 = acc[ai][bj][m][1] * oscale; const int ch = ch0 + bj * HALF;
                    u32x4 w; w.x = cvt_pk_bf16(v0[0], v0[1]); w.y = cvt_pk_bf16(v0[2], v0[3]); w.z = cvt_pk_bf16(v1[0], v1[1]); w.w = cvt_pk_bf16(v1[2], v1[3]);
                    *(u32x4*)(UT + ((((size_t)(ch >> 4) * TPB + t) * 16 + b) * 16 + (ch & 8))) = w; } }
    }
};
struct EpiFp8 {
    unsigned char* O; int ldc; float oscale;
    __device__ __forceinline__ void operator()(const f32x4 (&acc)[2][2][4][2], const Unit& u, int wr, int wc, int fr, int fq, LAS unsigned char* = nullptr) const {
        const int row0 = u.pm * BM + wr * 64 + fr, col0 = u.pn * BM + wc * 32 + 8 * fq;
#pragma unroll
        for (int ai = 0; ai < 2; ++ai)
#pragma unroll
            for (int m = 0; m < 4; ++m) { unsigned char* rowp = O + (size_t)(row0 + ai * HALF + m * 16) * ldc + col0;
#pragma unroll
                for (int bj = 0; bj < 2; ++bj) { const f32x4 v0 = acc[ai][bj][m][0] * oscale, v1 = acc[ai][bj][m][1] * oscale;
                    u32x2 w; w.x = pk4_fp8(v0[0], v0[1], v0[2], v0[3]); w.y = pk4_fp8(v1[0], v1[1], v1[2], v1[3]);
                    *(u32x2*)(rowp + bj * HALF) = w; } }
    }
};
struct EpiFp8P16 {
    unsigned char* O; int ldc; float oscale;
    __device__ __forceinline__ void operator()(const f32x4 (&acc)[2][2][4][2], const Unit& u, int wr, int wc, int fr, int fq, LAS unsigned char* = nullptr) const {
        const int row0 = u.pm * BM + wr * 64 + fr, col0 = u.pn * BM + wc * 64 + 16 * fq;
#pragma unroll
        for (int ai = 0; ai < 2; ++ai)
#pragma unroll
            for (int m = 0; m < 4; ++m) { u32x4 w;
#pragma unroll
                for (int bj = 0; bj < 2; ++bj) { const f32x4 v0 = acc[ai][bj][m][0] * oscale, v1 = acc[ai][bj][m][1] * oscale; w[2 * bj] = pk4_fp8(v0[0], v0[1], v0[2], v0[3]); w[2 * bj + 1] = pk4_fp8(v1[0], v1[1], v1[2], v1[3]); }
                *(u32x4*)(O + (size_t)(row0 + ai * HALF + m * 16) * ldc + col0) = w; }
    }
};
struct EpiGlu {
    const unsigned char* ZG8; const float* bias; unsigned char* OL; float ascale;
    __device__ __forceinline__ void operator()(const f32x4 (&acc)[2][2][4][2], const Unit& u, int wr, int wc, int fr, int fq, LAS unsigned char* = nullptr) const {
        const int row0 = u.pm * BM + wr * 64 + fr, col0 = u.pn * BM + wc * 32 + 8 * fq;
        f32x4 bv[2][2];
#pragma unroll
        for (int bj = 0; bj < 2; ++bj)
#pragma unroll
            for (int n = 0; n < 2; ++n) bv[bj][n] = *(const f32x4*)(bias + col0 + bj * HALF + 4 * n);
        u32x2 zwv[2][4][2];
#pragma unroll
        for (int ai = 0; ai < 2; ++ai)
#pragma unroll
            for (int m = 0; m < 4; ++m)
#pragma unroll
                for (int bj = 0; bj < 2; ++bj) zwv[ai][m][bj] = *(const u32x2*)(ZG8 + (size_t)(row0 + ai * HALF + m * 16) * 512 + col0 + bj * HALF);
#pragma unroll
        for (int ai = 0; ai < 2; ++ai)
#pragma unroll
            for (int m = 0; m < 4; ++m) { const int row = row0 + ai * HALF + m * 16;
#pragma unroll
                for (int bj = 0; bj < 2; ++bj) { const u32x2 zw = zwv[ai][m][bj];
                    const f32x2 z01 = __builtin_amdgcn_cvt_pk_f32_fp8((int)zw.x, false), z23 = __builtin_amdgcn_cvt_pk_f32_fp8((int)zw.x, true), z45 = __builtin_amdgcn_cvt_pk_f32_fp8((int)zw.y, false), z67 = __builtin_amdgcn_cvt_pk_f32_fp8((int)zw.y, true);
                    const float z[8] = {z01[0], z01[1], z23[0], z23[1], z45[0], z45[1], z67[0], z67[1]}; float o[8];
#pragma unroll
                    for (int n = 0; n < 2; ++n)
#pragma unroll
                        for (int j = 0; j < 4; ++j) { const float a = acc[ai][bj][m][n][j] * ascale + bv[bj][n][j]; o[n * 4 + j] = z[n * 4 + j] * __builtin_amdgcn_rcpf(1.0f + __expf(-a)); }
                    u32x2 w; w.x = pk4_fp8(o[0], o[1], o[2], o[3]); w.y = pk4_fp8(o[4], o[5], o[6], o[7]);
                    *(u32x2*)(OL + (size_t)row * 1024 + 512 + col0 + bj * HALF) = w; } }
    }
};
struct EpiBf16Dual {
    bf16_t* O0; int ldc0; bf16_t* O1; int ldc1;
    __device__ __forceinline__ void operator()(const f32x4 (&acc)[2][2][4][2], const Unit& u, int wr, int wc, int fr, int fq, LAS unsigned char* = nullptr) const {
        EpiBf16 e; e.O = u.g ? O1 : O0; e.ldc = u.g ? ldc1 : ldc0; e(acc, u, wr, wc, fr, fq);
    }
};
constexpr float WSCALE = 64.0f, WSCALE_INV = 1.0f / 64.0f;
struct EpiSwiglu {
    unsigned char* Z; const float* bias;
    __device__ __forceinline__ void operator()(const f32x4 (&acc)[2][2][4][2], const Unit& u, int wr, int wc, int fr, int fq, LAS unsigned char* sd) const {
        const int row0 = u.pm * BM + wr * 64 + fr, c0 = u.pn * 128 + wc * 32 + 8 * fq;
        const LAS float* be = (const LAS float*)(sd + 1024) + wc * 32 + 8 * fq;
        const f32x4 bg0 = *(const LAS f32x4*)(be), bg1 = *(const LAS f32x4*)(be + 4), bl0 = *(const LAS f32x4*)(be + 128), bl1 = *(const LAS f32x4*)(be + 132);
#pragma unroll
        for (int ai = 0; ai < 2; ++ai)
#pragma unroll
            for (int m = 0; m < 4; ++m) {
                float o[8];
#pragma unroll
                for (int n = 0; n < 2; ++n) { const f32x4 ga = acc[ai][0][m][n], la = acc[ai][1][m][n], bg = n ? bg1 : bg0, bl = n ? bl1 : bl0;
#pragma unroll
                    for (int j = 0; j < 4; j += 2) {
                        f32x2 g2 = (f32x2){ga[j], ga[j + 1]} * WSCALE_INV + (f32x2){bg[j], bg[j + 1]}, l2 = (f32x2){la[j], la[j + 1]} * WSCALE_INV + (f32x2){bl[j], bl[j + 1]};
                        g2.x = __builtin_amdgcn_fmed3f(g2.x, -24.0f, 7.0f); g2.y = __builtin_amdgcn_fmed3f(g2.y, -24.0f, 7.0f); l2.x = __builtin_amdgcn_fmed3f(l2.x, -7.0f, 7.0f); l2.y = __builtin_amdgcn_fmed3f(l2.y, -7.0f, 7.0f);
                        const f32x2 t2 = g2 * -2.4554669595930157f; f32x2 a2; a2.x = __builtin_amdgcn_exp2f(t2.x); a2.y = __builtin_amdgcn_exp2f(t2.y); a2 = a2 + 1.0f;
                        const float r = __builtin_amdgcn_rcpf(a2.x * a2.y);
                        const f32x2 o2 = g2 * (l2 + 1.0f) * ((f32x2){a2.y, a2.x} * r);
                        o[n * 4 + j] = o2.x; o[n * 4 + j + 1] = o2.y; } }
                u32x2 w; w.x = pk4_fp8(o[0], o[1], o[2], o[3]); w.y = pk4_fp8(o[4], o[5], o[6], o[7]);
                *(u32x2*)(Z + (size_t)(row0 + ai * HALF + m * 16) * 1024 + c0) = w; }
    }
};
constexpr float Y2SCALE = 32.0f, Y2SCALE_INV = 1.0f / 32.0f;
struct EpiMoeOut {
    unsigned char* Y2; const float* bias;
    __device__ __forceinline__ void operator()(const f32x4 (&acc)[2][2][4][2], const Unit& u, int wr, int wc, int fr, int fq, LAS unsigned char* sd) const {
        const int r0 = wr * 64 + fr, col0 = u.pn * BM + wc * 64 + 16 * fq;
        const LAS float* be = (const LAS float*)(sd + 1024) + wc * 64 + 16 * fq;
        const LAS float* gts = (const LAS float*)(sd + 2048);
        f32x4 bv[2][2];
#pragma unroll
        for (int bj = 0; bj < 2; ++bj)
#pragma unroll
            for (int n = 0; n < 2; ++n) bv[bj][n] = *(const LAS f32x4*)(be + 8 * bj + 4 * n);
#pragma unroll
        for (int ai = 0; ai < 2; ++ai)
#pragma unroll
            for (int m = 0; m < 4; ++m) { const int r = r0 + ai * HALF + m * 16; const float gt = gts[r] * Y2SCALE;
                u32x4 w;
#pragma unroll
                for (int bj = 0; bj < 2; ++bj) { const f32x4 v0 = (acc[ai][bj][m][0] * WSCALE_INV + bv[bj][0]) * gt, v1 = (acc[ai][bj][m][1] * WSCALE_INV + bv[bj][1]) * gt;
                    w[2 * bj] = pk4_fp8(v0[0], v0[1], v0[2], v0[3]); w[2 * bj + 1] = pk4_fp8(v1[0], v1[1], v1[2], v1[3]); }
                *(u32x4*)(Y2 + (size_t)(u.pm * BM + r) * 1024 + col0) = w; }
    }
};
}


namespace att {
constexpr int NW = 8, QBLK = 32, KVBLK = 64, DV = 128;
typedef short s16x4 __attribute__((ext_vector_type(4)));
typedef float f32x16 __attribute__((ext_vector_type(16)));
#define SBAR() __builtin_amdgcn_sched_barrier(0)
__device__ __forceinline__ int crow(int r, int hi) { return (r & 3) + 8 * (r >> 2) + 4 * hi; }
__device__ __forceinline__ unsigned cvtpk(float lo, float hi) { unsigned r; asm volatile("v_cvt_pk_bf16_f32 %0, %1, %2" : "=v"(r) : "v"(lo), "v"(hi)); return r; }
template <int DK> __device__ __forceinline__ int kswz(int row, int colB) { return row * (DK * 2) + (colB ^ ((row & 7) << 4)); }
constexpr float THR = 8.f;

template <int DK, bool WINDOW>
__device__ __forceinline__ void partialSM(f32x16& p0, f32x16& p1, float& m_reg, float& mn, float& alpha, const bool masked, const int mbase) {
  constexpr float SCALE = (DK == 128) ? 0.088388347648318440f : 0.072168783648703220f;
  constexpr float C = SCALE * 1.4426950408889634f;
  if (WINDOW && masked) {
#pragma unroll
    for (int r = 0; r < 16; ++r) { const int d0 = mbase + (r & 3) + 8 * (r >> 2); const int d1 = d0 + 32;
      p0[r] = (d0 < -128 || d0 > 128) ? -1e30f : p0[r]; p1[r] = (d1 < -128 || d1 > 128) ? -1e30f : p1[r]; }
  }
  float pmax = p0[0];
#pragma unroll
  for (int r = 1; r < 16; ++r) pmax = fmaxf(pmax, p0[r]);
#pragma unroll
  for (int r = 0; r < 16; ++r) pmax = fmaxf(pmax, p1[r]);
  { auto rr = __builtin_amdgcn_permlane32_swap(__float_as_uint(pmax), __float_as_uint(pmax), false, false);
    pmax = fmaxf(__uint_as_float(rr[0]), __uint_as_float(rr[1])); }
  if (__builtin_expect(__all(pmax - m_reg <= THR / SCALE), 1)) { mn = m_reg; alpha = 1.f; }
  else { mn = fmaxf(m_reg, pmax); alpha = __builtin_amdgcn_exp2f((m_reg - mn) * C); m_reg = mn; }
  const float mnC = -mn * C;
#pragma unroll
  for (int r = 0; r < 16; ++r) p0[r] = fmaf(p0[r], C, mnC);
#pragma unroll
  for (int r = 0; r < 16; ++r) p1[r] = fmaf(p1[r], C, mnC);
#pragma unroll
  for (int r = 0; r < 16; ++r) p0[r] = __builtin_amdgcn_exp2f(p0[r]);
}
__device__ __forceinline__ void finishSM(f32x16& p0, f32x16& p1, float alpha, float& l_reg, bf16x8& pa0, bf16x8& pa1, bf16x8& pa2, bf16x8& pa3) {
#pragma unroll
  for (int r = 0; r < 16; ++r) p1[r] = __builtin_amdgcn_exp2f(p1[r]);
  float ps = 0;
#pragma unroll
  for (int r = 0; r < 16; ++r) ps += p0[r];
#pragma unroll
  for (int r = 0; r < 16; ++r) ps += p1[r];
  { auto rr = __builtin_amdgcn_permlane32_swap(__float_as_uint(ps), __float_as_uint(ps), false, false);
    ps = __uint_as_float(rr[0]) + __uint_as_float(rr[1]); }
  l_reg = l_reg * alpha + ps;
#define PK4(P, BASE, OUT) do { unsigned a0 = cvtpk(P[BASE + 0], P[BASE + 1]), a1 = cvtpk(P[BASE + 2], P[BASE + 3]);   \
    unsigned b0 = cvtpk(P[BASE + 4], P[BASE + 5]), b1 = cvtpk(P[BASE + 6], P[BASE + 7]);                              \
    auto r0 = __builtin_amdgcn_permlane32_swap(a0, b0, false, false); auto r1 = __builtin_amdgcn_permlane32_swap(a1, b1, false, false); \
    u32x4 w = {r0[0], r1[0], r0[1], r1[1]}; OUT = *reinterpret_cast<bf16x8*>(&w); } while (0)
  PK4(p0, 0, pa0); PK4(p0, 8, pa1); PK4(p1, 0, pa2); PK4(p1, 8, pa3);
#undef PK4
}
template <int DK>
__device__ __forceinline__ void qkt(f32x16& p0, f32x16& p1, const LAS char* Ks, const bf16x8* qr, int r32, int hi) {
  p0 = f32x16{}; p1 = f32x16{};
#pragma unroll
  for (int d0 = 0; d0 < DK / 16; ++d0) { const int cb = (d0 * 16 + hi * 8) * 2;
    const bf16x8 b0 = *reinterpret_cast<const LAS bf16x8*>(Ks + kswz<DK>(r32, cb));
    const bf16x8 b1 = *reinterpret_cast<const LAS bf16x8*>(Ks + kswz<DK>(32 + r32, cb));
    p0 = __builtin_amdgcn_mfma_f32_32x32x16_bf16(b0, qr[d0], p0, 0, 0, 0);
    p1 = __builtin_amdgcn_mfma_f32_32x32x16_bf16(b1, qr[d0], p1, 0, 0, 0); }
}
__device__ __forceinline__ int v_st(int k, int c) { const int kk = (k & ~0xC) | ((k & 4) << 1) | ((k & 8) >> 1); return ((kk >> 3) * 4 + (c >> 5)) * 512 + ((kk & 7) * 32 + (c & 31)) * 2; }
__device__ __forceinline__ int v_rd_base(int lane) { return ((lane & 3) << 3) | (((lane >> 2) & 3) << 6) | (((lane >> 4) & 1) << 5) | (((lane >> 5) & 1) << 8); }
constexpr int v_rd_off(int d0, int ks, int half) { return d0 * 512 + ks * 4096 + half * 2048; }
template <int OFF> __device__ __forceinline__ s16x4 tr_read(int vb) {
  s16x4 r; asm volatile("ds_read_b64_tr_b16 %0, %1 offset:%2" : "=&v"(r) : "v"(vb), "i"(OFF) : "memory"); return r;
}
template <int D0> __device__ __forceinline__ void pv_one(f32x16& od, int vb, bf16x8 pa0, bf16x8 pa1, bf16x8 pa2, bf16x8 pa3) {
  const s16x4 l0 = tr_read<v_rd_off(D0, 0, 0)>(vb), h0 = tr_read<v_rd_off(D0, 0, 1)>(vb), l1 = tr_read<v_rd_off(D0, 1, 0)>(vb), h1 = tr_read<v_rd_off(D0, 1, 1)>(vb);
  const s16x4 l2 = tr_read<v_rd_off(D0, 2, 0)>(vb), h2 = tr_read<v_rd_off(D0, 2, 1)>(vb), l3 = tr_read<v_rd_off(D0, 3, 0)>(vb), h3 = tr_read<v_rd_off(D0, 3, 1)>(vb);
  asm volatile("s_waitcnt lgkmcnt(0)" ::: "memory"); SBAR();
#define PK(L, H) (bf16x8){L[0], L[1], L[2], L[3], H[0], H[1], H[2], H[3]}
  od = __builtin_amdgcn_mfma_f32_32x32x16_bf16(pa0, PK(l0, h0), od, 0, 0, 0);
  od = __builtin_amdgcn_mfma_f32_32x32x16_bf16(pa1, PK(l1, h1), od, 0, 0, 0);
  od = __builtin_amdgcn_mfma_f32_32x32x16_bf16(pa2, PK(l2, h2), od, 0, 0, 0);
  od = __builtin_amdgcn_mfma_f32_32x32x16_bf16(pa3, PK(l3, h3), od, 0, 0, 0);
#undef PK
}
__device__ __forceinline__ void pv_d0(f32x16* o, int vb, bf16x8 pa0, bf16x8 pa1, bf16x8 pa2, bf16x8 pa3) {
  pv_one<0>(o[0], vb, pa0, pa1, pa2, pa3); pv_one<1>(o[1], vb, pa0, pa1, pa2, pa3); pv_one<2>(o[2], vb, pa0, pa1, pa2, pa3); pv_one<3>(o[3], vb, pa0, pa1, pa2, pa3);
}

struct Unit {
  const bf16_t* Q; int ldq;
  const bf16_t* K; int ldk;
  const bf16_t* KR; int ldkr;
  const bf16_t* V; int ldv;
  unsigned char* O; int ldo;
  int NT;
  int kofs;
  int q0;
  float sink; int has_sink;
  const float* rope; int rope_row, rope_col_base;
  const float* qgain;
};

template <int DK, bool WINDOW, int SD, bool SIMPLE>
__device__ __forceinline__ void attn_unit(const Unit& U, LAS char* lds, const int wid0) {
  constexpr int SHM_V = KVBLK * DV * 2, SHM_K = KVBLK * DK * 2;
  constexpr float SCALE = (DK == 128) ? 0.088388347648318440f : 0.072168783648703220f;
  constexpr float C = SCALE * 1.4426950408889634f;
  constexpr int NKC = (DK == 128) ? 2 : 3;
  const int lane = lane_now(); const int wid = wid0; const int tid = wid0 * 64 + lane; const int r32 = lane & 31, hi = lane >> 5;
  LAS char* V_lds = lds; LAS char* K_lds = lds + 2 * SHM_V;
  LAS float* wsf = (LAS float*)(lds + 2 * SHM_V + 2 * SHM_K) + wid * 64; LAS float* li_l = wsf; LAS float* al_l = wsf + 32;
  float m_reg = -1e30f, l_reg = 0; f32x16 o[4] = {}; bf16x8 qr[DK / 16];
  const bf16_t* Qw = U.Q + (long)(wid * QBLK + r32) * U.ldq + hi * 8;
#pragma unroll
  for (int d0 = 0; d0 < DK / 16; ++d0) qr[d0] = *reinterpret_cast<const bf16x8*>(Qw + d0 * 16);
  if (DK == 192 && U.rope != nullptr) {
    const int pos = U.q0 + wid * QBLK + r32; const int ri = pos >> 6, ci = pos & 63;
#pragma unroll
    for (int hf = 0; hf < 2; ++hf) { const float* tp = U.rope + ((hf ? ci : ri) * 16 + hi * 8) * 2;
      bf16x8 x1 = qr[8 + 2 * hf], x2 = qr[9 + 2 * hf];
#pragma unroll
      for (int i = 0; i < 8; ++i) { const float c = tp[2 * i], sn = tp[2 * i + 1]; const float a = bf2f((unsigned short)x1[i]), b = bf2f((unsigned short)x2[i]);
        x1[i] = (short)f2bf(a * c - b * sn); x2[i] = (short)f2bf(b * c + a * sn); }
      qr[8 + 2 * hf] = x1; qr[9 + 2 * hf] = x2; }
  }
  if constexpr (DK == 128) {
    if (U.qgain != nullptr || U.rope != nullptr) {
      float x[8][8];
#pragma unroll
      for (int d0 = 0; d0 < 8; ++d0)
#pragma unroll
        for (int j = 0; j < 8; ++j) x[d0][j] = bf2f((unsigned short)qr[d0][j]);
      if (U.qgain != nullptr) { float ss = 0.f;
#pragma unroll
        for (int d0 = 0; d0 < 8; ++d0)
#pragma unroll
          for (int j = 0; j < 8; ++j) ss += x[d0][j] * x[d0][j];
        { auto rr = __builtin_amdgcn_permlane32_swap(__float_as_uint(ss), __float_as_uint(ss), false, false); ss = __uint_as_float(rr[0]) + __uint_as_float(rr[1]); }
        const float rinv = __builtin_amdgcn_rsqf(ss * (1.0f / 128.0f) + 1e-6f);
#pragma unroll
        for (int d0 = 0; d0 < 8; ++d0) { const f32x4 g0 = *reinterpret_cast<const f32x4*>(U.qgain + 16 * d0 + 8 * hi), g1 = *reinterpret_cast<const f32x4*>(U.qgain + 16 * d0 + 8 * hi + 4);
#pragma unroll
          for (int j = 0; j < 4; ++j) { x[d0][j] = x[d0][j] * rinv * g0[j]; x[d0][4 + j] = x[d0][4 + j] * rinv * g1[j]; } } }
      if (U.rope != nullptr) { const int pos = U.q0 + wid * QBLK + r32; const int ri = pos >> 6, ci = pos & 63;
#pragma unroll
        for (int hf = 0; hf < 2; ++hf)
#pragma unroll
          for (int dd = 0; dd < 2; ++dd) { const float* tp = U.rope + ((hf ? ci : ri) * 32 + 16 * dd + 8 * hi) * 2; const int da = 4 * hf + dd, db = da + 2;
#pragma unroll
            for (int j = 0; j < 8; ++j) { const float c = tp[2 * j], sn = tp[2 * j + 1]; const float a = x[da][j], b2 = x[db][j]; x[da][j] = a * c - b2 * sn; x[db][j] = b2 * c + a * sn; } } }
#pragma unroll
      for (int d0 = 0; d0 < 8; ++d0) { u32x4 w; w.x = pk2(x[d0][0], x[d0][1]); w.y = pk2(x[d0][2], x[d0][3]); w.z = pk2(x[d0][4], x[d0][5]); w.w = pk2(x[d0][6], x[d0][7]); qr[d0] = __builtin_bit_cast(bf16x8, w); }
    }
  }
  const int sr = tid >> 4, sc = (tid & 15) * 8, vst0 = v_st(sr, sc), vst1 = v_st(32 + sr, sc);
  int krw[NKC], kcs[NKC], kdst[NKC];
#pragma unroll
  for (int i = 0; i < NKC; ++i) { const int id = tid + 512 * i; if (DK == 128) { krw[i] = (i == 0) ? sr : 32 + sr; kcs[i] = sc; } else { krw[i] = id / 24; kcs[i] = (id % 24) * 8; }
    kdst[i] = kswz<DK>(krw[i], kcs[i] * 2); }
  const int vb0 = (int)(uintptr_t)V_lds + v_rd_base(lane);
  struct { bf16x8 vs0, vs1, ks[NKC]; } sr_[SD];
  constexpr int SO = SD - 1;
  const int kofs = U.kofs;
#define KROW(j) (64 * (j) + (((j) >= 4) ? kofs : 0))
#define SLOAD(i, jt) do { const int _k0 = KROW(jt); sr_[i].vs0 = *reinterpret_cast<const bf16x8*>(&U.V[(long)(_k0 + sr) * U.ldv + sc]); sr_[i].vs1 = *reinterpret_cast<const bf16x8*>(&U.V[(long)(_k0 + 32 + sr) * U.ldv + sc]); \
    _Pragma("unroll") for (int _c = 0; _c < NKC; ++_c) { if (DK == 128 || kcs[_c] < 128) sr_[i].ks[_c] = *reinterpret_cast<const bf16x8*>(&U.K[(long)(_k0 + krw[_c]) * U.ldk + kcs[_c]]); \
      else sr_[i].ks[_c] = *reinterpret_cast<const bf16x8*>(&U.KR[(long)(_k0 + krw[_c]) * U.ldkr + (kcs[_c] - 128)]); } } while (0)
#define SWRITE(b, i) do { *(LAS bf16x8*)(V_lds + (b) * SHM_V + vst0) = sr_[i].vs0; *(LAS bf16x8*)(V_lds + (b) * SHM_V + vst1) = sr_[i].vs1; \
    _Pragma("unroll") for (int _c = 0; _c < NKC; ++_c) *(LAS bf16x8*)(K_lds + (b) * SHM_K + kdst[_c]) = sr_[i].ks[_c]; } while (0)
#define SWAIT() asm volatile("s_waitcnt vmcnt(%0)" :: "n"(SD == 2 ? 2 + NKC : 0) : "memory")
#define RESC(a) do { if (__any((a) < 1.f)) { if (hi == 0) al_l[r32] = (a); asm volatile("s_waitcnt lgkmcnt(0)" ::: "memory"); \
    _Pragma("unroll") for (int d = 0; d < 4; ++d) _Pragma("unroll") for (int r = 0; r < 16; ++r) o[d][r] *= al_l[crow(r, hi)]; } } while (0)
  const int qpos = U.q0 + wid * QBLK + r32;
#define MBASE(jt) (kofs + 64 * (jt) - 256 - qpos + 4 * hi)
  bf16x8 pa0, pa1, pa2, pa3; const int NT = U.NT;
  if constexpr (SIMPLE) {
    f32x16 p0, p1; float mn, al;
    SLOAD(0, 0); asm volatile("s_waitcnt vmcnt(0)" ::: "memory"); SWRITE(0, 0); __syncthreads();
    for (int j = 0; j < NT; ++j) {
      const int bsel = j & 1;
      if (j + 1 < NT) SLOAD(0, j + 1);
      SBAR(); qkt<DK>(p0, p1, K_lds + bsel * SHM_K, qr, r32, hi);
      partialSM<DK, WINDOW>(p0, p1, m_reg, mn, al, j >= 4, MBASE(j));
      RESC(al);
      finishSM(p0, p1, al, l_reg, pa0, pa1, pa2, pa3); SBAR();
      pv_d0(o, vb0 + bsel * SHM_V, pa0, pa1, pa2, pa3);
      if (j + 1 < NT) { asm volatile("s_waitcnt vmcnt(0)" ::: "memory"); SWRITE(bsel ^ 1, 0); }
      __syncthreads();
    }
  } else {
  f32x16 pA0, pA1, pB0, pB1; float mnA, mnB, alA, alB;
  SLOAD(0, 0); asm volatile("s_waitcnt vmcnt(0)" ::: "memory"); SWRITE(0, 0); __syncthreads();
  qkt<DK>(pA0, pA1, K_lds, qr, r32, hi); partialSM<DK, WINDOW>(pA0, pA1, m_reg, mnA, alA, false, 0);
  SLOAD(SO, 1); if (SD == 2 && 2 < NT) SLOAD(0, 2);
  SWAIT(); SWRITE(1, SO); __syncthreads();
  for (int j = 1; j + 1 < NT; j += 2) {
    SBAR(); qkt<DK>(pB0, pB1, K_lds + SHM_K, qr, r32, hi);
    finishSM(pA0, pA1, alA, l_reg, pa0, pa1, pa2, pa3); SBAR();
    SLOAD(SO, j + SD); SBAR();
    pv_d0(o, vb0, pa0, pa1, pa2, pa3); partialSM<DK, WINDOW>(pB0, pB1, m_reg, mnB, alB, j >= 4, MBASE(j));
    __syncthreads(); SWAIT(); SWRITE(0, 0);
    RESC(alB); __syncthreads();
    SBAR(); qkt<DK>(pA0, pA1, K_lds, qr, r32, hi);
    finishSM(pB0, pB1, alB, l_reg, pa0, pa1, pa2, pa3); SBAR();
    if (SD == 1 || j + 3 < NT) SLOAD(0, j + 1 + SD); SBAR();
    pv_d0(o, vb0 + SHM_V, pa0, pa1, pa2, pa3); partialSM<DK, WINDOW>(pA0, pA1, m_reg, mnA, alA, j + 1 >= 4, MBASE(j + 1));
    __syncthreads(); SWAIT(); SWRITE(1, SO);
    RESC(alA); __syncthreads();
  }
  SBAR(); qkt<DK>(pB0, pB1, K_lds + SHM_K, qr, r32, hi);
  finishSM(pA0, pA1, alA, l_reg, pa0, pa1, pa2, pa3); SBAR();
  pv_d0(o, vb0, pa0, pa1, pa2, pa3); partialSM<DK, WINDOW>(pB0, pB1, m_reg, mnB, alB, NT - 1 >= 4, MBASE(NT - 1));
  __syncthreads(); RESC(alB);
  finishSM(pB0, pB1, alB, l_reg, pa0, pa1, pa2, pa3); SBAR();
  pv_d0(o, vb0 + SHM_V, pa0, pa1, pa2, pa3);
  }
  if (WINDOW && U.has_sink) l_reg += __builtin_amdgcn_exp2f(U.sink * 1.4426950408889634f - m_reg * C);
  if (hi == 0) li_l[r32] = l_reg; asm volatile("s_waitcnt lgkmcnt(0)" ::: "memory");
  float rli[16];
#pragma unroll
  for (int r = 0; r < 16; ++r) rli[r] = __builtin_amdgcn_rcpf(li_l[crow(r, hi)]);
  __syncthreads();
  { LAS unsigned char* ot = (LAS unsigned char*)V_lds + wid * 4096;
#pragma unroll
    for (int r = 0; r < 16; ++r) { const int orow = crow(r, hi);
#pragma unroll
      for (int d0 = 0; d0 < 4; ++d0) { const float ov = o[d0][r] * rli[r] * 16.0f; ot[orow * 128 + d0 * 32 + r32] = (unsigned char)(__builtin_amdgcn_cvt_pk_fp8_f32(ov, ov, 0, false) & 0xff); } }
    asm volatile("s_waitcnt lgkmcnt(0)" ::: "memory");
    unsigned char* Ow = U.O + (long)(wid * QBLK + (lane >> 1)) * U.ldo + (lane & 1) * 64;
    const LAS unsigned char* os = ot + (lane >> 1) * 128 + (lane & 1) * 64;
#pragma unroll
    for (int q = 0; q < 4; ++q) *(u32x4*)(Ow + q * 16) = *(const LAS u32x4*)(os + q * 16); }
  __syncthreads();
#undef KROW
#undef SLOAD
#undef SWRITE
#undef SWAIT
#undef RESC
#undef MBASE
}
}

struct Args { const float* in[34]; float* out; unsigned char* ws; };

__device__ __forceinline__ void transpose_item(const float* W, int ldw, int K, bf16_t* WT, int k0, int n0, int drow0, LAS float* scr, int lane) {
#pragma unroll 32
    for (int i = 0; i < 32; ++i) { const int kk = 2 * i + (lane >> 5); scr[kk * 33 + (lane & 31)] = W[(size_t)(k0 + kk) * ldw + n0 + (lane & 31)]; }
    LDS_WAIT(); asm volatile("" ::: "memory");
    const int c = lane & 7;
#pragma unroll
    for (int j = 0; j < 4; ++j) { const int n = (lane >> 3) + 8 * j; const LAS float* s = scr + (8 * c) * 33 + n;
        u32x4 o; o.x = pk2(s[0 * 33], s[1 * 33]); o.y = pk2(s[2 * 33], s[3 * 33]); o.z = pk2(s[4 * 33], s[5 * 33]); o.w = pk2(s[6 * 33], s[7 * 33]);
        *(u32x4*)(WT + (size_t)(drow0 + n) * K + k0 + 8 * c) = o; }
    LDS_WAIT(); asm volatile("" ::: "memory");
}

__device__ __forceinline__ void transpose_item_fp8(const float* W, int ldw, int K, unsigned char* WT, int k0, int n0, int drow0, LAS float* scr, int lane) {
#pragma unroll 32
    for (int i = 0; i < 32; ++i) { const int kk = 2 * i + (lane >> 5); scr[kk * 33 + (lane & 31)] = W[(size_t)(k0 + kk) * ldw + n0 + (lane & 31)] * 64.0f; }
    LDS_WAIT(); asm volatile("" ::: "memory");
    const int c = lane & 7;
#pragma unroll
    for (int j = 0; j < 4; ++j) { const int n = (lane >> 3) + 8 * j; const LAS float* s = scr + (8 * c) * 33 + n;
        u32x2 o; o.x = pg8::pk4_fp8(s[0 * 33], s[1 * 33], s[2 * 33], s[3 * 33]); o.y = pg8::pk4_fp8(s[4 * 33], s[5 * 33], s[6 * 33], s[7 * 33]);
        *(u32x2*)(WT + (size_t)(drow0 + n) * K + k0 + 8 * c) = o; }
    LDS_WAIT(); asm volatile("" ::: "memory");
}
struct ConvHalf { const float* src; unsigned char* dst; int ldw; int drow[2]; };
__device__ __forceinline__ ConvHalf conv_half_of(const float* w_exp_in, const float* w_exp_out, unsigned char* WexpIn, unsigned char* WexpOut, int layer, int hidx) {
    const int g = hidx >> 1, hp = hidx & 1; ConvHalf c;
    if (g < 8192) { const int le = layer * 32 + (g >> 8), q = g & 255; const int k0 = (q >> 4) * 64, n0 = (q & 15) * 128 + 64 * hp;
        c.src = w_exp_in + (size_t)le * 1024 * 2048 + (size_t)k0 * 2048 + n0; c.ldw = 2048; c.dst = WexpIn + (size_t)le * 2048 * 1024 + k0;
#pragma unroll
        for (int sb = 0; sb < 2; ++sb) { const int nn = n0 + 32 * sb; c.drow[sb] = (nn < 1024) ? ((nn >> 7) * 256 + (nn & 127)) : (((nn - 1024) >> 7) * 256 + 128 + ((nn - 1024) & 127)); } }
    else { const int g2 = g - 8192; const int le = layer * 32 + (g2 >> 7), q = g2 & 127; const int k0 = (q >> 3) * 64, n0 = (q & 7) * 128 + 64 * hp;
        c.src = w_exp_out + (size_t)le * 1024 * 1024 + (size_t)k0 * 1024 + n0; c.ldw = 1024; c.dst = WexpOut + (size_t)le * 1024 * 1024 + k0; c.drow[0] = n0; c.drow[1] = n0 + 32; }
    return c;
}
#define CONV_LOAD(ch, wv) do { _Pragma("unroll") for (int sb_ = 0; sb_ < 2; ++sb_) _Pragma("unroll") for (int i_ = 0; i_ < 32; ++i_) { const int kk_ = 2 * i_ + (lane >> 5); wv[sb_][i_] = (ch).src[(size_t)kk_ * (ch).ldw + 32 * sb_ + (lane & 31)]; } } while (0)
#define CONV_STORE(ch, wv) do { _Pragma("unroll") for (int sb_ = 0; sb_ < 2; ++sb_) { \
        _Pragma("unroll") for (int i_ = 0; i_ < 32; ++i_) { const int kk_ = 2 * i_ + (lane >> 5); scr[kk_ * 33 + (lane & 31)] = wv[sb_][i_] * 64.0f; } \
        LDS_WAIT(); asm volatile("" ::: "memory"); \
        _Pragma("unroll") for (int j_ = 0; j_ < 4; ++j_) { const int n_ = (lane >> 3) + 8 * j_; const LAS float* sp_ = scr + (8 * (lane & 7)) * 33 + n_; \
            u32x2 o_; o_.x = pg8::pk4_fp8(sp_[0 * 33], sp_[1 * 33], sp_[2 * 33], sp_[3 * 33]); o_.y = pg8::pk4_fp8(sp_[4 * 33], sp_[5 * 33], sp_[6 * 33], sp_[7 * 33]); \
            *(u32x2*)((ch).dst + (size_t)((ch).drow[sb_] + n_) * 1024 + 8 * (lane & 7)) = o_; } \
        LDS_WAIT(); asm volatile("" ::: "memory"); } } while (0)
__device__ __forceinline__ void expert_conv_run(const float* w_exp_in, const float* w_exp_out, unsigned char* WexpIn, unsigned char* WexpOut, int layer, int h0, int nh, LAS float* scr, int lane) {
    float wa[2][32], wb[2][32];
    ConvHalf ca = conv_half_of(w_exp_in, w_exp_out, WexpIn, WexpOut, layer, h0), cb = ca;
    CONV_LOAD(ca, wa);
#pragma clang loop unroll(disable)
    for (int h = 0; h < nh; h += 2) {
        cb = conv_half_of(w_exp_in, w_exp_out, WexpIn, WexpOut, layer, h0 + (h + 1) * 8); CONV_LOAD(cb, wb);
        CONV_STORE(ca, wa);
        if (h + 2 < nh) { ca = conv_half_of(w_exp_in, w_exp_out, WexpIn, WexpOut, layer, h0 + (h + 2) * 8); CONV_LOAD(ca, wa); }
        CONV_STORE(cb, wb);
    }
}
__device__ __forceinline__ bool conv_group(int& r, const float* W, int nmat, int K, int N, bf16_t* WT, int ldrows, LAS float* scr, int lane) {
    const int per = (K / 64) * (N / 32); if (r >= nmat * per) { r -= nmat * per; return false; }
    const int mi = r / per, q = r % per, kb = q / (N / 32), nb = q % (N / 32);
    transpose_item(W + (size_t)mi * K * N, N, K, WT + (size_t)mi * ldrows * K, kb * 64, nb * 32, nb * 32, scr, lane); return true;
}

typedef const Args __attribute__((address_space(4))) CArgs;
#define PHASE_ARGS() CArgs* A_ = (CArgs*)__builtin_amdgcn_kernarg_segment_ptr(); asm volatile("" : "+s"(A_)); unsigned char* const ws = A_->ws; (void)ws; int Gp = G, vcup = vcu, bxp = bx; asm volatile("" : "+s"(Gp), "+s"(vcup), "+s"(bxp)); (void)Gp; (void)vcup; (void)bxp
#define IN(k) (A_->in[k])
#define WSP(T, off) ((T*)(ws + (off)))
__global__ void __launch_bounds__(NTHR, 2) fwd_kernel(Args args) {
    extern __shared__ __attribute__((aligned(16))) unsigned char lds_raw[];
    LAS unsigned char* lds = (LAS unsigned char*)lds_raw;
    const int G = gridDim.x; const int bx = blockIdx.x; const int vcu = (G % 8 == 0) ? (bx % 8) * (G / 8) + bx / 8 : bx;
    volatile LAS unsigned* MISC = (volatile LAS unsigned*)(lds + LDS_MISC);
    const int wave0 = __builtin_amdgcn_readfirstlane((int)threadIdx.x >> 6);
    for (int u = threadIdx.x; u < (LDS_BYTES - LDS_MISC) / 4; u += NTHR) MISC[u] = 0u;
    __syncthreads();
    XcdBarrier bar = xcd_barrier_post((unsigned*)(args.ws + WS_CTL) + CW_BAR, MISC + 0);
    bar.x = (unsigned)wave0;
#define GRID_BAR() do { xcd_barrier(bar); if (DUPSEL == 15) xcd_barrier(bar); } while (0)
#define PROBE_MULT 4u
#define PT_SAMPLE(id) do { if (PROBE_MASK != 0ull) { const unsigned pt_now_ = (unsigned)__builtin_amdgcn_s_memrealtime(); if (wave0 == 0 && lane_now() == 0) { const unsigned pt_last_ = MISC[3400]; if ((PROBE_MASK >> (id)) & 1ull) MISC[3401] = MISC[3401] + (pt_now_ - pt_last_); MISC[3400] = pt_now_; } } } while (0)
#define GRID_BARP(id) do { GRID_BAR(); PT_SAMPLE(id); } while (0)
    const int NGW = G * NWAVES;
    PT_SAMPLE(0);

    {
        PHASE_IDS(); PHASE_ARGS();
        const float* in_c = IN(1); const float* in_cctx = IN(3); const float* w_mod = IN(4); const float* b_mod = IN(5);
        const float* w_mix_out = IN(8); const float* w_exp_in = IN(11); const float* w_exp_out = IN(13);
        const float* w_in_ab = IN(15); const float* w_glu = IN(26); const float* w_in_cd = IN(28); const float* w_uq = IN(31); const float* w_ukv = IN(32);
        float* MOD = WSP(float, WS_MOD); unsigned char* WexpIn = WSP(unsigned char, WS_WEXPIN); unsigned char* WexpOut = WSP(unsigned char, WS_WEXPOUT); unsigned char* Wmix = WSP(unsigned char, WS_WMIX);
        unsigned char* WinAB = WSP(unsigned char, WS_WINAB); unsigned char* WinCD = WSP(unsigned char, WS_WINCD); unsigned char* Wglu = WSP(unsigned char, WS_WGLU); bf16_t* Wuq = WSP(bf16_t, WS_WUQ); bf16_t* Wukv = WSP(bf16_t, WS_WUKV);
        float* T32 = WSP(float, WS_ROPE); float* T16 = T32 + 64 * 32 * 2;
        LAS float* scr = (LAS float*)(lds + LDS_STAGE + wave * 16384);
        constexpr int I_MIX = 16 * 32;
        constexpr int NIT = 4 * I_MIX + 2 * (16 * 48 + 16 * 50 + 8 * 16 + 4 * 24 + 4 * 32);
        for (int rep_ = 0; rep_ < DUPN(1); ++rep_)
        for (int it = gw; it < NIT; it += NGW) {
            int r = it;
            if (r < 4 * I_MIX) { const int mi = r / I_MIX, q = r % I_MIX, kb = q / 32, nb = q % 32;
                transpose_item_fp8(w_mix_out + (size_t)mi * 1024 * 1024, 1024, 1024, Wmix + (size_t)mi * 1024 * 1024, kb * 64, nb * 32, nb * 32, scr, lane); continue; }
            r -= 4 * I_MIX;
            if (r < 2 * 16 * 48) { const int mi = r / (16 * 48), q = r % (16 * 48), kb = q / 48, nb = q % 48;
                transpose_item_fp8(w_in_ab + (size_t)mi * 1024 * 1536, 1536, 1024, WinAB + (size_t)mi * 1536 * 1024, kb * 64, nb * 32, nb * 32, scr, lane); continue; }
            r -= 2 * 16 * 48;
            if (r < 2 * 16 * 50) { const int mi = r / (16 * 50), q = r % (16 * 50), kb = q / 50, nb = q % 50;
                transpose_item_fp8(w_in_cd + (size_t)mi * 1024 * 1600, 1600, 1024, WinCD + (size_t)mi * 1792 * 1024, kb * 64, nb * 32, nb * 32, scr, lane); continue; }
            r -= 2 * 16 * 50;
            if (r < 2 * 128) { const int mi = r / 128, q = r % 128, kb = q / 16, nb = q % 16;
                transpose_item_fp8(w_glu + (size_t)mi * 512 * 512, 512, 512, Wglu + (size_t)mi * 512 * 512, kb * 64, nb * 32, nb * 32, scr, lane); continue; }
            r -= 2 * 128;
            if (conv_group(r, w_uq, 2, 256, 768, Wuq, 768, scr, lane)) continue;
            (void)conv_group(r, w_ukv, 2, 256, 1024, Wukv, 1024, scr, lane);
        }
        PT_SAMPLE(20);
        for (int i = vcu * NTHR + tid; i < 2 * 192 * 1024 / 16; i += G * NTHR) { const int mi = i / (192 * 64), q = i % (192 * 64); *(u32x4*)(WinCD + ((size_t)mi * 1792 + 1600) * 1024 + (size_t)q * 16) = (u32x4){0u, 0u, 0u, 0u}; }
        { const float* w_router = IN(9); bf16_t* WRFo = WSP(bf16_t, WS_WRF);
          for (int i = vcu * NTHR + tid; i < 4 * 2 * 32 * 64 * 8; i += G * NTHR) { const int ii = i & 7, ln = (i >> 3) & 63, sidx = (i >> 9) & 31, nt = (i >> 14) & 1, l = i >> 15;
            const int k = 32 * sidx + 8 * (ln >> 4) + ii, e = nt * 16 + (ln & 15); const float w = w_router[((size_t)l * 1024 + k) * 32 + e]; const unsigned hi = f2bf(w); const unsigned lo = f2bf(w - bflo(hi));
            WRFo[(size_t)l * 65536 + ((size_t)(0 * 2 + nt) * 32 + sidx) * 512 + ln * 8 + ii] = (bf16_t)hi; WRFo[(size_t)l * 65536 + ((size_t)(1 * 2 + nt) * 32 + sidx) * 512 + ln * 8 + ii] = (bf16_t)lo; } }
        for (int i = vcu * NTHR + tid; i < 64 * 32 + 64 * 16; i += G * NTHR) {
            if (i < 64 * 32) { const int idx = i >> 5, j = i & 31; const float ang = (float)idx * expf(-(float)j * (1.0f / 32.0f) * 9.210340371976184f); float sn, cs; sincosf(ang, &sn, &cs); T32[i * 2] = cs; T32[i * 2 + 1] = sn; }
            else { const int q = i - 64 * 32, idx = q >> 4, j = q & 15; const float ang = (float)idx * expf(-(float)j * (1.0f / 16.0f) * 9.210340371976184f); float sn, cs; sincosf(ang, &sn, &cs); T16[q * 2] = cs; T16[q * 2 + 1] = sn; }
        }

        PT_SAMPLE(21);
        {
            const float* lam_re = IN(18); const float* lam_im = IN(19); const float* log_dt = IN(20); const float* b_re = IN(21); const float* b_im = IN(22); const float* c_re = IN(23); const float* c_im = IN(24);
            bf16_t* TFb = WSP(bf16_t, WS_TF); bf16_t* SFb = WSP(bf16_t, WS_SF); bf16_t* WFb = WSP(bf16_t, WS_WF); float* LAM16 = WSP(float, WS_LAM16);
            __syncthreads();
            LAS f32x2* Pw = (LAS f32x2*)(lds + LDS_STAGE);
            LAS f32x2* Bb = Pw + 17 * 64;
            LAS f32x2* Cc = Bb + 64 * 16;
            LAS float* Kt = (LAS float*)(Cc + 64 * 16);
            for (int unit = vcu - (G - 128); unit >= 0 && unit < 128; unit += G) {
                const int dir = (unit >> 5) & 1;
                for (int idx = tid; idx < 17 * 64; idx += NTHR) { const int tau = idx >> 6, n = idx & 63; const float lr = lam_re[unit * 64 + n], lim = lam_im[unit * 64 + n], dt = expf(log_dt[unit]);
                    const float mag = expf((float)tau * dt * lr); float sn, cs; sincosf((float)tau * dt * lim, &sn, &cs); Pw[idx] = (f32x2){mag * cs, mag * sn}; }
                for (int idx = tid; idx < 64 * 16; idx += NTHR) { const int n = idx >> 4; const float lr = lam_re[unit * 64 + n], lim = lam_im[unit * 64 + n], dt = expf(log_dt[unit]);
                    const float mag = expf(dt * lr); float sn, cs; sincosf(dt * lim, &sn, &cs); const float nr = mag * cs - 1.0f, ni = mag * sn; const float den = 1.0f / (lr * lr + lim * lim);
                    const float cbr = (nr * lr + ni * lim) * den, cbi = (ni * lr - nr * lim) * den;
                    const float br = b_re[(size_t)unit * 1024 + idx], bi = b_im[(size_t)unit * 1024 + idx]; Bb[idx] = (f32x2){cbr * br - cbi * bi, cbr * bi + cbi * br};
                    Cc[(idx & 63) * 16 + (idx >> 6)] = (f32x2){c_re[(size_t)unit * 1024 + idx], c_im[(size_t)unit * 1024 + idx]}; }
                __syncthreads();
                { const int tau = tid >> 5, cout = (tid >> 1) & 15, ch = tid & 1; float ka[8];
#pragma unroll
                  for (int j = 0; j < 8; ++j) ka[j] = 0.f;
                  for (int n = 0; n < 64; ++n) { const f32x2 c = Cc[n * 16 + cout], pw = Pw[tau * 64 + n]; const float tr = c.x * pw.x - c.y * pw.y, ti = c.x * pw.y + c.y * pw.x;
                      const LAS f32x4* bp = (const LAS f32x4*)(Bb + n * 16 + ch * 8);
#pragma unroll
                      for (int j = 0; j < 4; ++j) { const f32x4 b2 = bp[j]; ka[2 * j] += tr * b2[0] - ti * b2[1]; ka[2 * j + 1] += tr * b2[2] - ti * b2[3]; } }
#pragma unroll
                  for (int j = 0; j < 8; ++j) Kt[(tau * 16 + cout) * 16 + ch * 8 + j] = ka[j]; }
                __syncthreads();
                for (int pq = tid; pq < 16 * 64; pq += NTHR) { const int f = pq >> 6, l = pq & 63; const int cout = l & 15, kq = l >> 4, sl = kq >> 1;
                    const int tau = dir == 0 ? f - sl : f - 1 + sl; u32x4 w = (u32x4){0u, 0u, 0u, 0u};
                    if (tau >= 0 && tau <= 15) { const LAS f32x4* kp = (const LAS f32x4*)(Kt + (tau * 16 + cout) * 16 + (kq & 1) * 8); const f32x4 a = kp[0], b2 = kp[1];
                        w.x = pk2(a[0], a[1]); w.y = pk2(a[2], a[3]); w.z = pk2(b2[0], b2[1]); w.w = pk2(b2[2], b2[3]); }
                    *(u32x4*)(TFb + (size_t)unit * 8192 + (size_t)pq * 8) = w; }
                for (int pq = tid; pq < 64 * 64; pq += NTHR) { const int fr = pq >> 6, l = pq & 63;
                    { const int mt = fr >> 3, j = fr & 7; const int kp = mt * 16 + (l & 15), n = kp >> 1, ri = kp & 1; const int kidx0 = j * 32 + (l >> 4) * 8, sidx = kidx0 >> 4, cin0 = kidx0 & 15;
                      const int e = dir == 0 ? 15 - sidx : sidx; const f32x2 pw = Pw[e * 64 + n]; const LAS f32x4* bp = (const LAS f32x4*)(Bb + n * 16 + cin0); float o[8];
#pragma unroll
                      for (int q = 0; q < 4; ++q) { const f32x4 b2 = bp[q];
                          o[2 * q] = ri ? (pw.x * b2[1] + pw.y * b2[0]) : (pw.x * b2[0] - pw.y * b2[1]); o[2 * q + 1] = ri ? (pw.x * b2[3] + pw.y * b2[2]) : (pw.x * b2[2] - pw.y * b2[3]); }
                      u32x4 w; w.x = pk2(o[0], o[1]); w.y = pk2(o[2], o[3]); w.z = pk2(o[4], o[5]); w.w = pk2(o[6], o[7]);
                      *(u32x4*)(SFb + (size_t)unit * 32768 + (size_t)pq * 8) = w; }
                    { const int t = fr >> 2, ks = fr & 3; const int cout = l & 15, n0 = (ks * 32 + (l >> 4) * 8) >> 1; const int e = dir == 0 ? t + 1 : 16 - t; float o[8];
#pragma unroll
                      for (int q = 0; q < 4; ++q) { const f32x2 c = Cc[(n0 + q) * 16 + cout], pw = Pw[e * 64 + n0 + q]; o[2 * q] = c.x * pw.x - c.y * pw.y; o[2 * q + 1] = -(c.x * pw.y + c.y * pw.x); }
                      u32x4 w; w.x = pk2(o[0], o[1]); w.y = pk2(o[2], o[3]); w.z = pk2(o[4], o[5]); w.w = pk2(o[6], o[7]);
                      *(u32x4*)(WFb + (size_t)unit * 32768 + (size_t)pq * 8) = w; } }
                if (tid < 128) { const f32x2 pw = Pw[16 * 64 + (tid >> 1)]; LAM16[unit * 128 + tid] = (tid & 1) ? pw.y : pw.x; }
                __syncthreads();
            }
        }
        __syncthreads();
        PT_SAMPLE(22);
        LAS float* sl = (LAS float*)(lds + LDS_STAGE);
        LAS float* red = (LAS float*)(lds + LDS_STAGE + 1024 * 20 * 4);
        for (int i = tid; i < 17 * 1024; i += NTHR) { const int row = i >> 10, k = i & 1023; const float v = (row < 16) ? in_c[row * 1024 + k] : in_cctx[k]; sl[k * 20 + row] = v / (1.0f + __expf(-v)); }
        __syncthreads();
        PT_SAMPLE(23);
        for (int rep_ = 0; rep_ < DUPN(14); ++rep_)
        for (int it = vcu; it < 4 * 96 && vcu < G - 128; it += G - 128) {
            const int l = it / 96, cb = it % 96, c4 = lane & 15, ksub = lane >> 4, kg = wave;
            f32x4 a[17];
#pragma unroll
            for (int r = 0; r < 17; ++r) a[r] = (f32x4){0.f, 0.f, 0.f, 0.f};
            const float* wp = w_mod + ((size_t)l * 1024 + kg * 128 + ksub) * 6144 + cb * 64 + c4 * 4;
            for (int s0_ = 0; s0_ < 32; s0_ += 16) {
                f32x4 wv[16];
#pragma unroll
                for (int q = 0; q < 16; ++q) wv[q] = *(const f32x4*)(wp + (size_t)((s0_ + q) * 4) * 6144);
#pragma unroll
                for (int q = 0; q < 16; ++q) { const f32x4 w = wv[q]; const LAS float* sp = sl + (kg * 128 + (s0_ + q) * 4 + ksub) * 20;
                    const f32x4 s0 = *(const LAS f32x4*)(sp), s1 = *(const LAS f32x4*)(sp + 4), s2 = *(const LAS f32x4*)(sp + 8), s3 = *(const LAS f32x4*)(sp + 12); const float s4 = sp[16];
                    a[0] += s0[0] * w; a[1] += s0[1] * w; a[2] += s0[2] * w; a[3] += s0[3] * w; a[4] += s1[0] * w; a[5] += s1[1] * w; a[6] += s1[2] * w; a[7] += s1[3] * w;
                    a[8] += s2[0] * w; a[9] += s2[1] * w; a[10] += s2[2] * w; a[11] += s2[3] * w; a[12] += s3[0] * w; a[13] += s3[1] * w; a[14] += s3[2] * w; a[15] += s3[3] * w; a[16] += s4 * w; }
            }
#pragma unroll
            for (int r = 0; r < 17; ++r)
#pragma unroll
                for (int j = 0; j < 4; ++j) { float v = a[r][j]; v += shx(v, 16, lane); v += shx(v, 32, lane); a[r][j] = v; }
            if (lane < 16) {
#pragma unroll
                for (int r = 0; r < 17; ++r)
#pragma unroll
                    for (int j = 0; j < 4; ++j) red[(kg * 64 + c4 * 4 + j) * 17 + r] = a[r][j]; }
            __syncthreads();
            for (int o = tid; o < 64 * 17; o += NTHR) { const int c2 = o / 17, r = o % 17; float s = 0.f;
#pragma unroll
                for (int g8 = 0; g8 < 8; ++g8) s += red[(g8 * 64 + c2) * 17 + r];
                MOD[((size_t)l * 17 + r) * 6144 + cb * 64 + c2] = s + b_mod[l * 6144 + cb * 64 + c2]; }
            __syncthreads();
        }
    }
    GRID_BARP(1);
    { PHASE_IDS(); PHASE_ARGS();
    const float* in_x = IN(0); const float* in_ctx = IN(2); const float* MOD = WSP(float, WS_MOD); unsigned char* H = WSP(unsigned char, WS_H8); unsigned short* X16 = WSP(unsigned short, WS_X);
    const int wbase = vcu * (M / 256) + wave * 18;
    int kind = -1; f32x4 shq[4], scq[4];
#pragma unroll
    for (int j = 0; j < 4; ++j) { shq[j] = (f32x4){0.f, 0.f, 0.f, 0.f}; scq[j] = shq[j]; }
    for (int i0 = 0; i0 < 18; i0 += 4) {
        const int nr = (i0 + 4 <= 18) ? 4 : 2; const int row0 = wbase + i0;
        const int b = row0 / TPB, t0 = row0 % TPB; const bool isctx = t0 < CTXL;
        if (kind != (isctx ? 1 : 0)) { kind = isctx ? 1 : 0; const float* mr = MOD + (size_t)(0 * 17 + (isctx ? 16 : b)) * 6144;
#pragma unroll
            for (int j = 0; j < 4; ++j) { const int col = 4 * lane + 256 * j; shq[j] = *(const f32x4*)(mr + col); scq[j] = *(const f32x4*)(mr + 1024 + col); } }
        f32x4 vq[4][4];
#pragma unroll
        for (int r = 0; r < 4; ++r) { if (r < nr) { const int t = t0 + r; const float* src = isctx ? in_ctx + ((size_t)b * CTXL + t) * DM : in_x + ((size_t)b * SEQ + (t - CTXL)) * DM;
#pragma unroll
            for (int j = 0; j < 4; ++j) vq[r][j] = *(const f32x4*)(src + 4 * lane + 256 * j); } }
#pragma unroll
        for (int r = 0; r < 4; ++r) { if (r < nr) { const size_t row = (size_t)(row0 + r);
#pragma unroll
            for (int j = 0; j < 4; ++j) { const int col = 4 * lane + 256 * j; const f32x4 v = vq[r][j];
                const f32x4 h = v * (scq[j] + 1.0f) + shq[j];
                *(unsigned*)(H + row * DM + col) = pg8::pk4_fp8(h[0], h[1], h[2], h[3]);
                *(u32x2*)(X16 + row * DM + col) = f32_to_h4(v); } } }
    } }
    GRID_BARP(2);

    for (int layer = 0; layer < DEPTH; ++layer) {
        const bool lastl = (layer == DEPTH - 1);
        const int li = layer >> 1;
        const bool even = (layer & 1) == 0;
#if !defined(NO_MIXER)
        if (even) {
            { PHASE_ARGS(); pg8::SchedDense S; S.nM = NPANEL; S.nN = 6; S.G = Gp; S.c = bxp; S.g = 0; S.A = (const char*)WSP(unsigned char, WS_H8); S.B = (const char*)(WSP(unsigned char, WS_WINAB) + (size_t)li * 1536 * 1024); S.a_tstep = (size_t)256 * 1024; S.b_tstep = (size_t)256 * 1024;
              pg8::EpiBf16U E; E.O = WSP(bf16_t, WS_PROJ); E.ldc = 1536; E.oscale = 1.0f / 64.0f; E.UT = WSP(bf16_t, WS_UT);
            for (int rep_ = 0; rep_ < DUPN(2); ++rep_)
              pg8::gemm_phase<pg8::EpiBf16U, pg8::SchedDense, false, true>(wave0, lds + LDS_STAGE, 1024, 1024, nullptr, S, E); }
            GRID_BARP(3);
            { PHASE_IDS(); PHASE_ARGS();
              bf16_t* PROJ = WSP(bf16_t, WS_PROJ); bf16_t* UT = WSP(bf16_t, WS_UT); const float* T32 = WSP(float, WS_ROPE);
              const float* gq = IN(16) + li * 128; const float* gk = IN(17) + li * 128;
              const int sub = lane & 15, half = sub >> 3, i0 = (sub & 7) * 4;
              const int colp[2] = {(lane >> 4) * 128 + half * 64 + i0, 512 + ((lane >> 4) & 1) * 128 + half * 64 + i0};
              f32x4 g1[2], g2[2];
#pragma unroll
              for (int pass = 1; pass < 2; ++pass) { const float* gg = (pass ? gk : gq) + half * 64 + i0; g1[pass] = *(const f32x4*)gg; g2[pass] = *(const f32x4*)(gg + 32); }
              for (int rb = gw * 3; rb < M; rb += NGW * 3) {
                u32x2 av[3][2], cv[3][2]; f32x4 tb[3][2];
#pragma unroll
                for (int r = 0; r < 3; ++r) { const bf16_t* pr = PROJ + (size_t)(rb + r) * 1536;
#pragma unroll
                    for (int pass = 1; pass < 2; ++pass) { av[r][pass] = *(const u32x2*)(pr + colp[pass]); cv[r][pass] = *(const u32x2*)(pr + colp[pass] + 32); }
                    { const int t_ = (rb + r) % TPB; const int pos_ = t_ < CTXL ? 0 : t_ - CTXL; const float* tp_ = T32 + ((half ? (pos_ & 63) : (pos_ >> 6)) * 32 + i0) * 2; tb[r][0] = *(const f32x4*)tp_; tb[r][1] = *(const f32x4*)(tp_ + 4); } }
#pragma unroll
                for (int r = 0; r < 3; ++r) { const int row = rb + r; const int b = row / TPB, t = row % TPB; const bool isctx = t < CTXL; const int pos = t - CTXL; const int ri = pos >> 6, ci = pos & 63;
                    bf16_t* pr = PROJ + (size_t)row * 1536;
#pragma unroll
                    for (int pass = 1; pass < 2; ++pass) {
                        const u32x2 a = av[r][pass], c2 = cv[r][pass];
                        float x1[4] = {bflo(a.x), bfhi(a.x), bflo(a.y), bfhi(a.y)}, x2[4] = {bflo(c2.x), bfhi(c2.x), bflo(c2.y), bfhi(c2.y)};
                        float ss = 0.f;
#pragma unroll
                        for (int i = 0; i < 4; ++i) ss += x1[i] * x1[i] + x2[i] * x2[i];
                        ss = row16_sum(ss);
                        const float rinv = __builtin_amdgcn_rsqf(ss * (1.0f / 128.0f) + 1e-6f);
#pragma unroll
                        for (int i = 0; i < 4; ++i) { x1[i] = x1[i] * rinv * g1[pass][i]; x2[i] = x2[i] * rinv * g2[pass][i]; }
                        if (!isctx) { const float tpv[8] = {tb[r][0][0], tb[r][0][1], tb[r][0][2], tb[r][0][3], tb[r][1][0], tb[r][1][1], tb[r][1][2], tb[r][1][3]};
#pragma unroll
                            for (int i = 0; i < 4; ++i) { const float cs = tpv[2 * i], sn = tpv[2 * i + 1]; const float o1 = x1[i] * cs - x2[i] * sn, o2 = x2[i] * cs + x1[i] * sn; x1[i] = o1; x2[i] = o2; } }
                        if (pass == 0 || lane < 32) { u32x2 w; w.x = pk2(x1[0], x1[1]); w.y = pk2(x1[2], x1[3]); *(u32x2*)(pr + colp[pass]) = w; w.x = pk2(x2[0], x2[1]); w.y = pk2(x2[2], x2[3]); *(u32x2*)(pr + colp[pass] + 32) = w; }
                    }
                }
              } }
            GRID_BARP(4);
            { PHASE_IDS(); PHASE_ARGS();
              const bf16_t* UT = WSP(bf16_t, WS_UT); const bf16_t* SFb = WSP(bf16_t, WS_SF); unsigned short* XS = WSP(unsigned short, WS_XS);
              for (int rep_ = 0; rep_ < DUPN(7); ++rep_)
              for (int unit = vcu; unit < 256; unit += G) {
                const int g = unit >> 3, r8 = unit & 7;
                bf16x8 sa[2][8];
#pragma unroll
                for (int d = 0; d < 2; ++d)
#pragma unroll
                    for (int j = 0; j < 8; ++j) sa[d][j] = *(const bf16x8*)(SFb + ((size_t)((li * 2 + d) * 32 + g) * 64 + wave * 8 + j) * 512 + lane * 8);
                const int b = lane & 15, kq = lane >> 4;
#define S5A_LOAD(UB, cc) do { _Pragma("unroll") for (int j = 0; j < 8; ++j) UB[j] = *(const bf16x8*)(UT + (((size_t)g * TPB + (cc) * 16 + 2 * j + (kq >> 1)) * 16 + b) * 16 + (kq & 1) * 8); } while (0)
#define S5A_COMP(UB, cc) do { f32x4 a0 = (f32x4){0.f, 0.f, 0.f, 0.f}, a1 = a0; \
                    _Pragma("unroll") for (int j = 0; j < 8; ++j) { a0 = __builtin_amdgcn_mfma_f32_16x16x32_bf16(sa[0][j], UB[j], a0, 0, 0, 0); a1 = __builtin_amdgcn_mfma_f32_16x16x32_bf16(sa[1][j], UB[j], a1, 0, 0, 0); } \
                    *(u32x2*)(XS + ((size_t)(g * 2 + 0) * 144 + (cc)) * 2048 + b * 128 + wave * 16 + 4 * kq) = f32_to_h4(a0); \
                    *(u32x2*)(XS + ((size_t)(g * 2 + 1) * 144 + (cc)) * 2048 + b * 128 + wave * 16 + 4 * kq) = f32_to_h4(a1); } while (0)
                bf16x8 uba[8], ubb[8];
                S5A_LOAD(uba, r8 * 18);
                for (int c = r8 * 18; c < r8 * 18 + 18; c += 2) {
                    S5A_LOAD(ubb, c + 1);
                    S5A_COMP(uba, c);
                    if (c + 2 < r8 * 18 + 18) S5A_LOAD(uba, c + 2);
                    S5A_COMP(ubb, c + 1);
                }
#undef S5A_LOAD
#undef S5A_COMP
              } }
            { PHASE_ARGS(); bf16_t* PROJ = WSP(bf16_t, WS_PROJ); unsigned char* OL8 = WSP(unsigned char, WS_OL); const float* T32 = WSP(float, WS_ROPE); const float* gq = IN(16) + li * 128;
              const float* w_exp_in = IN(11); const float* w_exp_out = IN(13); unsigned char* WexpIn = WSP(unsigned char, WS_WEXPIN); unsigned char* WexpOut = WSP(unsigned char, WS_WEXPOUT);
#define EXPERT_CONV() do { __syncthreads(); const int ln_ = lane_now(); LAS float* scr_ = (LAS float*)(lds + LDS_STAGE + wave0 * 16384); \
                expert_conv_run(w_exp_in, w_exp_out, WexpIn, WexpOut, layer, vcu * 96 + wave0, 12, scr_, ln_); __syncthreads(); } while (0)
              for (int rep_ = 0; rep_ < DUPN(3); ++rep_) {
              int it_ = 0; const int slot_ = (rep_ == 0) ? (vcu % 3) : 99;
              for (int u = vcu; u < 576; u += G, ++it_) {
                if (it_ == slot_) EXPERT_CONV();
                att::Unit U; int b, h, row0;
                if (u < 512) { b = u >> 5; h = (u >> 3) & 3; row0 = b * TPB + CTXL + (u & 7) * 256; U.NT = 36; } else { const int uc = u - 512; b = uc >> 2; h = uc & 3; row0 = b * TPB; U.NT = 4; }
                const bf16_t* kb = PROJ + (size_t)b * TPB * 1536;
                U.Q = PROJ + (size_t)row0 * 1536 + h * 128; U.ldq = 1536; U.K = kb + 512 + (h >> 1) * 128; U.ldk = 1536; U.KR = nullptr; U.ldkr = 0; U.V = kb + 768 + (h >> 1) * 128; U.ldv = 1536;
                U.O = OL8 + (size_t)row0 * 1024 + h * 128; U.ldo = 1024; U.kofs = 0; U.q0 = (u < 512) ? (u & 7) * 256 : 0; U.sink = 0.f; U.has_sink = 0; U.rope = (u < 512) ? T32 : nullptr; U.rope_row = 0; U.rope_col_base = 0; U.qgain = gq;
                att::attn_unit<128, false, 2, false>(U, (LAS char*)(lds + LDS_STAGE), wave0);
              }
              if (it_ <= slot_ && slot_ != 99) EXPERT_CONV(); } }
            GRID_BARP(5);
            { PHASE_IDS(); PHASE_ARGS();
              const unsigned short* XS = WSP(unsigned short, WS_XS); bf16_t* HIN = WSP(bf16_t, WS_HIN); const float* LAM16 = WSP(float, WS_LAM16);
              const int id = vcu * 256 + (tid & 255);
              for (int rep_ = 0; rep_ < DUPN(8); ++rep_)
              if (wave < 4) {
                const int n = id & 63, b = (id >> 6) & 15, gd = id >> 10, g = gd >> 1, dir = gd & 1;
                const f32x2 lam = *(const f32x2*)(LAM16 + ((li * 2 + dir) * 32 + g) * 128 + 2 * n);
                const unsigned short* xp = XS + (size_t)gd * 144 * 2048 + b * 128 + 2 * n;
                bf16_t* hp = HIN + (size_t)gd * 144 * 2048 + (((2 * n) >> 5) * 64 + (((2 * n) >> 3) & 3) * 16 + b) * 8 + ((2 * n) & 7);
                float hr = 0.f, hi2 = 0.f;
#define S5B_CC(st) (dir == 0 ? (st) : ((st) < 16 ? 15 - (st) : 159 - (st)))
#define S5B_LOAD(buf, s1) do { _Pragma("unroll") for (int q = 0; q < 12; ++q) buf[q] = *(const unsigned*)(xp + (size_t)S5B_CC((s1) + q) * 2048); } while (0)
#define S5B_USE(buf, s1) do { _Pragma("unroll") for (int q = 0; q < 12; ++q) { *(unsigned*)(hp + (size_t)S5B_CC((s1) + q) * 2048) = pk2(hr, hi2); \
                        const float nr = lam.x * hr - lam.y * hi2 + h2f((unsigned short)(buf[q] & 0xffffu)), ni = lam.x * hi2 + lam.y * hr + h2f((unsigned short)(buf[q] >> 16)); hr = nr; hi2 = ni; } } while (0)
                unsigned xa[12], xb[12];
                S5B_LOAD(xa, 0); S5B_LOAD(xb, 12);
                for (int s0 = 0; s0 < 144; s0 += 24) {
                    S5B_USE(xa, s0); if (s0 + 24 < 144) S5B_LOAD(xa, s0 + 24);
                    S5B_USE(xb, s0 + 12); if (s0 + 36 < 144) S5B_LOAD(xb, s0 + 36);
                }
#undef S5B_CC
#undef S5B_LOAD
#undef S5B_USE
              } }
            GRID_BARP(6);
            { PHASE_IDS(); PHASE_ARGS();
              const bf16_t* UT = WSP(bf16_t, WS_UT); const bf16_t* TFb = WSP(bf16_t, WS_TF); const bf16_t* WFb = WSP(bf16_t, WS_WF); const bf16_t* HIN = WSP(bf16_t, WS_HIN);
              unsigned char* ZG8 = WSP(unsigned char, WS_ZG8); const float* s5d = IN(25) + li * 512;
              LAS unsigned char* tfl = lds + LDS_STAGE;
              for (int rep_ = 0; rep_ < DUPN(9); ++rep_)
              for (int unit = vcu; unit < 256; unit += G) {
                const int g = unit >> 3, r8 = unit & 7;
                __syncthreads();
                for (int i = tid; i < 2048; i += NTHR) { const int d = i >> 10, q = i & 1023; *(LAS u32x4*)(tfl + (size_t)i * 16) = *(const u32x4*)(TFb + (size_t)((li * 2 + d) * 32 + g) * 8192 + q * 8); }
                bf16x8 wf[2][2][4];
#pragma unroll
                for (int d = 0; d < 2; ++d)
#pragma unroll
                    for (int tt = 0; tt < 2; ++tt)
#pragma unroll
                        for (int ks = 0; ks < 4; ++ks) wf[d][tt][ks] = *(const bf16x8*)(WFb + ((size_t)((li * 2 + d) * 32 + g) * 64 + (2 * wave + tt) * 4 + ks) * 512 + lane * 8);
                __syncthreads();
                const int b = lane & 15, kq = lane >> 4;
                const f32x4 dsk = *(const f32x4*)(s5d + g * 16 + 4 * kq);
                for (int c = r8 * 18; c < r8 * 18 + 18; ++c) {
                    f32x4 a0 = (f32x4){0.f, 0.f, 0.f, 0.f}, a1 = a0; bf16x8 hbv[2][4], ubv[8]; u32x2 uwv[2];
#pragma unroll
                    for (int d = 0; d < 2; ++d)
#pragma unroll
                        for (int ks = 0; ks < 4; ++ks) hbv[d][ks] = *(const bf16x8*)(HIN + ((size_t)(g * 2 + d) * 144 + c) * 2048 + (ks * 64 + lane) * 8);
#pragma unroll
                    for (int j = 0; j < 8; ++j) ubv[j] = *(const bf16x8*)(UT + (((size_t)g * TPB + c * 16 + 2 * j + (kq >> 1)) * 16 + b) * 16 + (kq & 1) * 8);
#pragma unroll
                    for (int tt = 0; tt < 2; ++tt) uwv[tt] = *(const u32x2*)(UT + (((size_t)g * TPB + c * 16 + 2 * wave + tt) * 16 + b) * 16 + 4 * kq);
#pragma unroll
                    for (int d = 0; d < 2; ++d)
#pragma unroll
                        for (int ks = 0; ks < 4; ++ks) { const bf16x8 hb = hbv[d][ks];
                            a0 = __builtin_amdgcn_mfma_f32_16x16x32_bf16(wf[d][0][ks], hb, a0, 0, 0, 0); a1 = __builtin_amdgcn_mfma_f32_16x16x32_bf16(wf[d][1][ks], hb, a1, 0, 0, 0); }
#pragma unroll
                    for (int j = 0; j < 8; ++j) { const bf16x8 ub = ubv[j];
                        if (j <= wave) { const bf16x8 t0 = *(const LAS bf16x8*)(tfl + ((2 * wave - 2 * j) * 64 + lane) * 16), t1 = *(const LAS bf16x8*)(tfl + ((2 * wave + 1 - 2 * j) * 64 + lane) * 16);
                            a0 = __builtin_amdgcn_mfma_f32_16x16x32_bf16(t0, ub, a0, 0, 0, 0); a1 = __builtin_amdgcn_mfma_f32_16x16x32_bf16(t1, ub, a1, 0, 0, 0); }
                        if (j >= wave) { const bf16x8 t0 = *(const LAS bf16x8*)(tfl + ((16 + 2 * j - 2 * wave + 1) * 64 + lane) * 16), t1 = *(const LAS bf16x8*)(tfl + ((16 + 2 * j - 2 * wave) * 64 + lane) * 16);
                            a0 = __builtin_amdgcn_mfma_f32_16x16x32_bf16(t0, ub, a0, 0, 0, 0); a1 = __builtin_amdgcn_mfma_f32_16x16x32_bf16(t1, ub, a1, 0, 0, 0); } }
#pragma unroll
                    for (int tt = 0; tt < 2; ++tt) { const size_t row = (size_t)b * TPB + c * 16 + 2 * wave + tt; const f32x4 av = tt ? a1 : a0;
                        const u32x2 uw = uwv[tt]; const float uu[4] = {bflo(uw.x), bfhi(uw.x), bflo(uw.y), bfhi(uw.y)}; float z[4];
#pragma unroll
                        for (int i = 0; i < 4; ++i) { const float y = av[i] + dsk[i] * uu[i]; const float a = 0.7978845608028654f * (y + 0.044715f * y * y * y);
                            const float th = 1.0f - 2.0f * __builtin_amdgcn_rcpf(1.0f + __expf(2.0f * a)); z[i] = 0.5f * y * (1.0f + th); }
                        *(unsigned*)(ZG8 + row * 512 + g * 16 + 4 * kq) = pg8::pk4_fp8(16.0f * z[0], 16.0f * z[1], 16.0f * z[2], 16.0f * z[3]); }
                }
              } }
            GRID_BARP(7);
            { PHASE_ARGS(); pg8::SchedDense S; S.nM = NPANEL; S.nN = 2; S.G = Gp; S.c = bxp; S.g = 0; S.A = (const char*)WSP(unsigned char, WS_ZG8); S.B = (const char*)(WSP(unsigned char, WS_WGLU) + (size_t)li * 512 * 512); S.a_tstep = (size_t)256 * 512; S.b_tstep = (size_t)256 * 512;
              pg8::EpiGlu E; E.ZG8 = WSP(unsigned char, WS_ZG8); E.bias = IN(27) + li * 512; E.OL = WSP(unsigned char, WS_OL); E.ascale = 1.0f / (64.0f * 16.0f);
            for (int rep_ = 0; rep_ < DUPN(10); ++rep_)
              pg8::gemm_phase<pg8::EpiGlu, pg8::SchedDense, false, true>(wave0, lds + LDS_STAGE, 512, 512, nullptr, S, E); }
            GRID_BARP(8);
        } else {
#if !defined(NO_ODD)
            { PHASE_ARGS(); pg8::SchedDense S; S.nM = NPANEL; S.nN = 7; S.G = Gp; S.c = bxp; S.g = 0; S.A = (const char*)WSP(unsigned char, WS_H8); S.B = (const char*)(WSP(unsigned char, WS_WINCD) + (size_t)li * 1792 * 1024); S.a_tstep = (size_t)256 * 1024; S.b_tstep = (size_t)256 * 1024;
              pg8::EpiBf16 E; E.O = WSP(bf16_t, WS_PROJ); E.ldc = 1792; E.oscale = 1.0f / 64.0f;
            for (int rep_ = 0; rep_ < DUPN(2); ++rep_)
              pg8::gemm_phase<pg8::EpiBf16, pg8::SchedDense, false, true>(wave0, lds + LDS_STAGE, 1024, 1024, nullptr, S, E); }
            GRID_BARP(9);
            { PHASE_IDS(); PHASE_ARGS();
              bf16_t* PROJ = WSP(bf16_t, WS_PROJ); const float* T32 = WSP(float, WS_ROPE); const float* T16 = T32 + 64 * 32 * 2;
              const float* gq = IN(29) + li * 256; const float* gkv = IN(30) + li * 256;
              const f32x4 gq4 = *(const f32x4*)(gq + lane * 4), gkv4 = *(const f32x4*)(gkv + lane * 4);
              const int sub = lane & 15, half = sub >> 3, i0 = (sub & 7) * 4;
              const int colp[2] = {576 + (lane >> 4) * 128 + half * 64 + i0, 1088 + ((lane >> 4) & 1) * 128 + half * 64 + i0};
              const int kh = (lane >> 4) & 1, ki = lane & 15, kcol = 512 + kh * 32 + ki;
              for (int rb = gw * 3; rb < M; rb += NGW * 3) {
                u32x2 nv[3][2], av[3][2], cv[3][2]; unsigned short kr[3][2]; f32x4 tb[3][2]; f32x2 tk[3];
#pragma unroll
                for (int r = 0; r < 3; ++r) { const bf16_t* pr = PROJ + (size_t)(rb + r) * 1792;
#pragma unroll
                    for (int pass = 0; pass < 2; ++pass) { nv[r][pass] = *(const u32x2*)(pr + pass * 256 + lane * 4); if (pass == 1) { av[r][pass] = *(const u32x2*)(pr + colp[pass]); cv[r][pass] = *(const u32x2*)(pr + colp[pass] + 32); } }
                    kr[r][0] = pr[kcol]; kr[r][1] = pr[kcol + 16];
                    { const int t_ = (rb + r) % TPB; const int pos_ = t_ < CTXL ? 0 : t_ - CTXL; const float* tp_ = T32 + ((half ? (pos_ & 63) : (pos_ >> 6)) * 32 + i0) * 2; tb[r][0] = *(const f32x4*)tp_; tb[r][1] = *(const f32x4*)(tp_ + 4);
                      tk[r] = *(const f32x2*)(T16 + ((kh ? (pos_ & 63) : (pos_ >> 6)) * 16 + ki) * 2); } }
#pragma unroll
                for (int r = 0; r < 3; ++r) { const int row = rb + r; const int t = row % TPB; const bool isctx = t < CTXL; const int pos = t - CTXL; const int ri = pos >> 6, ci = pos & 63;
                    bf16_t* pr = PROJ + (size_t)row * 1792;
#pragma unroll
                    for (int pass = 0; pass < 2; ++pass) { const u32x2 a = nv[r][pass];
                        float x[4] = {bflo(a.x), bfhi(a.x), bflo(a.y), bfhi(a.y)}; const float ss = wave_sum(x[0] * x[0] + x[1] * x[1] + x[2] * x[2] + x[3] * x[3], lane);
                        const float rinv = __builtin_amdgcn_rsqf(ss * (1.0f / 256.0f) + 1e-6f); const f32x4 g4 = pass ? gkv4 : gq4;
                        u32x2 w; w.x = pk2(x[0] * rinv * g4[0], x[1] * rinv * g4[1]); w.y = pk2(x[2] * rinv * g4[2], x[3] * rinv * g4[3]); *(u32x2*)(pr + pass * 256 + lane * 4) = w; }
                    if (!isctx) {
                        if (lane < 32) { const float a = bf2f(kr[r][0]), c2 = bf2f(kr[r][1]);
                            const float cs = tk[r][0], sn = tk[r][1];
                            pr[kcol] = (bf16_t)f2bf(a * cs - c2 * sn); pr[kcol + 16] = (bf16_t)f2bf(c2 * cs + a * sn); }
#pragma unroll
                        for (int pass = 1; pass < 2; ++pass) {
                            const u32x2 a = av[r][pass], c2 = cv[r][pass];
                            float x1[4] = {bflo(a.x), bfhi(a.x), bflo(a.y), bfhi(a.y)}, x2[4] = {bflo(c2.x), bfhi(c2.x), bflo(c2.y), bfhi(c2.y)};
                            const float tpv[8] = {tb[r][0][0], tb[r][0][1], tb[r][0][2], tb[r][0][3], tb[r][1][0], tb[r][1][1], tb[r][1][2], tb[r][1][3]};
#pragma unroll
                            for (int i = 0; i < 4; ++i) { const float cs = tpv[2 * i], sn = tpv[2 * i + 1]; const float o1 = x1[i] * cs - x2[i] * sn, o2 = x2[i] * cs + x1[i] * sn; x1[i] = o1; x2[i] = o2; }
                            if (pass == 0 || lane < 32) { u32x2 w; w.x = pk2(x1[0], x1[1]); w.y = pk2(x1[2], x1[3]); *(u32x2*)(pr + colp[pass]) = w; w.x = pk2(x2[0], x2[1]); w.y = pk2(x2[2], x2[3]); *(u32x2*)(pr + colp[pass] + 32) = w; }
                        }
                    }
                }
              } }
            GRID_BARP(10);
            { PHASE_ARGS(); bf16_t* PROJ = WSP(bf16_t, WS_PROJ); pg8::SchedDual S; S.nM = NPANEL; S.nN0 = 3; S.nN1 = 4; S.G = Gp; S.c = vcup; S.A0 = (const char*)PROJ; S.A1 = (const char*)(PROJ + 256);
              S.B0 = (const char*)(WSP(bf16_t, WS_WUQ) + (size_t)li * 768 * 256); S.B1 = (const char*)(WSP(bf16_t, WS_WUKV) + (size_t)li * 1024 * 256); S.a_tstep = (size_t)256 * 1792 * 2; S.b_tstep = (size_t)256 * 256 * 2;
              pg8::EpiBf16Dual E; E.O0 = WSP(bf16_t, WS_QM); E.ldc0 = 768; E.O1 = WSP(bf16_t, WS_KVM); E.ldc1 = 1024;
            for (int rep_ = 0; rep_ < DUPN(11); ++rep_)
              pg8::gemm_phase<pg8::EpiBf16Dual, pg8::SchedDual, false, false>(wave0, lds + LDS_STAGE, 512, 3584, nullptr, S, E); }
            GRID_BARP(11);
            { PHASE_ARGS(); bf16_t* PROJ = WSP(bf16_t, WS_PROJ); unsigned char* OL8 = WSP(unsigned char, WS_OL); bf16_t* QM = WSP(bf16_t, WS_QM); bf16_t* KVM = WSP(bf16_t, WS_KVM); const float* T16 = WSP(float, WS_ROPE) + 64 * 32 * 2; const float* d_sink = IN(33);
              const float* w_exp_in = IN(11); const float* w_exp_out = IN(13); unsigned char* WexpIn = WSP(unsigned char, WS_WEXPIN); unsigned char* WexpOut = WSP(unsigned char, WS_WEXPOUT);
              for (int rep_ = 0; rep_ < DUPN(3); ++rep_) {
              int it_ = 0; const int slot_ = (rep_ == 0) ? (vcu & 3) : 99;
              for (int u = vcu; u < (lastl ? 1024 : 1152); u += G, ++it_) {
                if (it_ == slot_) EXPERT_CONV();
                att::Unit U; int b, h, row0, qb; bool mla, ctxq;
                if (u < 512) { mla = true; ctxq = false; b = u >> 5; h = (u >> 3) & 3; qb = u & 7; }
                else if (u < 1024) { const int v2 = u - 512; mla = false; ctxq = false; b = v2 >> 5; h = (v2 >> 3) & 3; qb = v2 & 7; }
                else { const int v2 = u - 1024; mla = (v2 < 64); ctxq = true; b = (v2 & 63) >> 2; h = v2 & 3; qb = 0; }
                row0 = b * TPB + (ctxq ? 0 : CTXL + qb * 256);
                const int q0 = qb * 256;
                if (mla) {
                    const bf16_t* kvb = KVM + (size_t)b * TPB * 1024;
                    U.Q = QM + (size_t)row0 * 768 + h * 192; U.ldq = 768; U.K = kvb + h * 256; U.ldk = 1024; U.KR = PROJ + (size_t)b * TPB * 1792 + 512; U.ldkr = 1792; U.V = kvb + h * 256 + 128; U.ldv = 1024;
                    U.O = OL8 + (size_t)row0 * 1024 + h * 128; U.ldo = 1024; U.NT = ctxq ? 4 : 36; U.kofs = 0; U.q0 = q0; U.sink = 0.f; U.has_sink = 0; U.rope = ctxq ? nullptr : T16; U.rope_row = 0; U.rope_col_base = 0; U.qgain = nullptr;
                    att::attn_unit<192, false, 1, true>(U, (LAS char*)(lds + LDS_STAGE), wave0);
                } else {
                    const bf16_t* kb = PROJ + (size_t)b * TPB * 1792;
                    const int kstart = (q0 - 128) < 0 ? 0 : (q0 - 128), kend = (q0 + 384) > SEQ ? SEQ : (q0 + 384);
                    U.Q = PROJ + (size_t)row0 * 1792 + 576 + h * 128; U.ldq = 1792; U.K = kb + 1088 + (h >> 1) * 128; U.ldk = 1792; U.KR = nullptr; U.ldkr = 0; U.V = kb + 1344 + (h >> 1) * 128; U.ldv = 1792;
                    U.O = OL8 + (size_t)row0 * 1024 + 512 + h * 128; U.ldo = 1024; U.NT = ctxq ? 4 : 4 + (kend - kstart) / 64; U.kofs = kstart; U.q0 = q0; U.sink = d_sink[li * 4 + h]; U.has_sink = 1; U.rope = ctxq ? nullptr : T16 - 64 * 32 * 2; U.rope_row = 0; U.rope_col_base = 0; U.qgain = nullptr;
                    att::attn_unit<128, true, 2, false>(U, (LAS char*)(lds + LDS_STAGE), wave0);
                }
              }
              if (it_ <= slot_ && slot_ != 99) EXPERT_CONV(); } }
            GRID_BARP(12);
#endif
        }
        const bool has_mix = even
#if !defined(NO_ODD)
            || true
#endif
            ;
        if (has_mix) {
            { PHASE_ARGS(); pg8::SchedDense S; S.nM = lastl ? 128 : NPANEL; S.latent_only = lastl ? 1 : 0; S.nN = 4; S.G = Gp; S.c = bxp; S.g = 0; S.A = (const char*)WSP(unsigned char, WS_OL); S.B = (const char*)(WSP(unsigned char, WS_WMIX) + (size_t)layer * 1024 * 1024); S.a_tstep = (size_t)256 * 1024; S.b_tstep = (size_t)256 * 1024;
              pg8::EpiFp8P16 E; E.O = WSP(unsigned char, WS_Y); E.ldc = 1024; E.oscale = 64.0f / (16.0f * 64.0f);
            for (int rep_ = 0; rep_ < DUPN(6); ++rep_)
              pg8::gemm_phase<pg8::EpiFp8P16, pg8::SchedDense, false, true, false, true>(wave0, lds + LDS_STAGE, 1024, 1024, nullptr, S, E); }
            GRID_BARP(13);
        }
#else
        const bool has_mix = false;
#endif
        {
            PHASE_IDS(); PHASE_ARGS();
            const float* ln_g = IN(6); const float* ln_b = IN(7); const float* b_router = IN(10);
            const float* MOD = WSP(float, WS_MOD); const unsigned short* X16 = WSP(unsigned short, WS_X); const float* in_x = IN(0); const float* in_ctx = IN(2); unsigned char* H8 = WSP(unsigned char, WS_H8); const unsigned char* Y = WSP(unsigned char, WS_Y);
            int* slot_tok = WSP(int, WS_SLOTTOK); float* slot_gate = WSP(float, WS_SLOTGATE); int* tok_pos = WSP(int, WS_TOKPOS); unsigned* ctl = WSP(unsigned, WS_CTL);
            const bf16_t* WRF = WSP(bf16_t, WS_WRF) + (size_t)layer * (2 * 2 * 32 * 512);
            LAS bf16_t* HT1 = (LAS bf16_t*)(lds + LDS_STAGE); LAS bf16_t* HT2 = HT1 + 16 * 1032;
            LAS float* PART = (LAS float*)(lds + LDS_STAGE + 2 * 16 * 1032 * 2);
            LAS int* hist = (LAS int*)(lds + LDS_MISC + 64);
            LAS int* basel = (LAS int*)(lds + LDS_MISC + 64 + 128);
            LAS int* ent = (LAS int*)(lds + LDS_MISC + 512);
            if (tid < 32) hist[tid] = 0;
            __syncthreads();
            const float* g1 = ln_g + (size_t)(layer * 2 + 0) * 1024; const float* b1 = ln_b + (size_t)(layer * 2 + 0) * 1024;
            const int rows_per_wg = M / G;
            const int rbase = vcu * rows_per_wg;
            for (int rep_ = 0; rep_ < DUPN(12); ++rep_) {
            if (rep_ > 0) { __syncthreads(); if (tid < 32) hist[tid] = 0; __syncthreads(); }
            const int NG = rows_per_wg / 16;
#define LN1_VALID(gq) (!(lastl && (((rbase + (gq) * 16) % TPB) < CTXL)))
#define LN1_LOAD(gq, vv, yy) do { _Pragma("unroll") for (int rr = 0; rr < 2; ++rr) { const size_t row_ = (size_t)(rbase + (gq) * 16 + 2 * wave + rr); \
                _Pragma("unroll") for (int j = 0; j < 4; ++j) { xh[rr][j] = *(const u32x2*)(X16 + row_ * DM + 4 * lane + 256 * j); } \
                _Pragma("unroll") for (int j = 0; j < 4; ++j) { const int col_ = 4 * lane + 256 * j; if (has_mix) yy[rr][j] = *(const unsigned*)(Y + row_ * DM + col_); } } } while (0)
            { LAS float* gl_ = (LAS float*)(lds + LDS_STAGE + 98304) + 3072; for (int i = tid; i < 512; i += NTHR) { const float* sp_ = (i < 256) ? g1 + 4 * i : b1 + 4 * (i - 256); *(LAS f32x4*)(gl_ + 4 * i) = *(const f32x4*)sp_; } }
            const float brv = b_router[layer * 32 + (lane & 31)];
            bf16x8 wrf[4][4];
#pragma unroll
            for (int s4 = 0; s4 < 4; ++s4) { const int s = 4 * wave + s4;
                wrf[s4][0] = *(const bf16x8*)(WRF + ((size_t)(0 * 2 + 0) * 32 + s) * 512 + lane * 8); wrf[s4][1] = *(const bf16x8*)(WRF + ((size_t)(0 * 2 + 1) * 32 + s) * 512 + lane * 8);
                wrf[s4][2] = *(const bf16x8*)(WRF + ((size_t)(1 * 2 + 0) * 32 + s) * 512 + lane * 8); wrf[s4][3] = *(const bf16x8*)(WRF + ((size_t)(1 * 2 + 1) * 32 + s) * 512 + lane * 8); }
            int grp = 0; while (grp < NG && !LN1_VALID(grp)) ++grp;
            f32x4 v[2][4]; unsigned yv[2][4]; u32x2 xh[2][4];
#pragma unroll
            for (int rr = 0; rr < 2; ++rr)
#pragma unroll
                for (int j = 0; j < 4; ++j) { v[rr][j] = (f32x4){0.f, 0.f, 0.f, 0.f}; yv[rr][j] = 0u; xh[rr][j] = (u32x2){0u, 0u}; }
            if (grp < NG) LN1_LOAD(grp, v, yv);
            LAS float* MODL = (LAS float*)(lds + LDS_STAGE + 98304);
            int mod_kind = -1;
            while (grp < NG) {
                int gnx = grp + 1; while (gnx < NG && !LN1_VALID(gnx)) ++gnx;
                const int r0 = rbase + grp * 16; const int b = r0 / TPB; const bool isctx = (r0 % TPB) < CTXL;
                if (mod_kind != (isctx ? 1 : 0)) { mod_kind = isctx ? 1 : 0;
                    const float* mr = MOD + (size_t)(layer * 17 + (isctx ? 16 : b)) * 6144 + 2048;
                    __syncthreads();
                    for (int i = tid; i < 768; i += NTHR) *(LAS f32x4*)(MODL + 4 * i) = *(const f32x4*)(mr + 4 * i);
                    __syncthreads(); }
                f32x4 gtv[4], shv[4], scv[4];
#pragma unroll
                for (int j = 0; j < 4; ++j) { const int col = 4 * lane + 256 * j; gtv[j] = *(const LAS f32x4*)(MODL + col); shv[j] = *(const LAS f32x4*)(MODL + 1024 + col); scv[j] = *(const LAS f32x4*)(MODL + 2048 + col); }
#pragma unroll
                for (int rr = 0; rr < 2; ++rr)
#pragma unroll
                    for (int j = 0; j < 4; ++j) { v[rr][j] = h4_to_f32(xh[rr][j].x, xh[rr][j].y) * ALPHA;
                        if (has_mix) { const int yw = (int)yv[rr][j]; const f32x4 gt = gtv[j] * (1.0f / 64.0f);
                            const f32x2 ylo = __builtin_amdgcn_cvt_pk_f32_fp8(yw, false), yhi = __builtin_amdgcn_cvt_pk_f32_fp8(yw, true);
                            v[rr][j][0] += gt[0] * ylo[0]; v[rr][j][1] += gt[1] * ylo[1]; v[rr][j][2] += gt[2] * yhi[0]; v[rr][j][3] += gt[3] * yhi[1]; } }
                if (gnx < NG) LN1_LOAD(gnx, v, yv);
#pragma unroll
                for (int rr = 0; rr < 2; ++rr) { const size_t row = (size_t)(r0 + 2 * wave + rr); float s = 0.f;
#pragma unroll
                    for (int j = 0; j < 4; ++j) s += (v[rr][j][0] + v[rr][j][1]) + (v[rr][j][2] + v[rr][j][3]);
                    const float mean = wave_sum(s, lane) * (1.f / DM); float s2 = 0.f;
#pragma unroll
                    for (int j = 0; j < 4; ++j) { v[rr][j] = v[rr][j] - mean; s2 += (v[rr][j][0] * v[rr][j][0] + v[rr][j][1] * v[rr][j][1]) + (v[rr][j][2] * v[rr][j][2] + v[rr][j][3] * v[rr][j][3]); }
                    const float rstd = __builtin_amdgcn_rsqf(wave_sum(s2, lane) * (1.f / DM) + LN_EPS);
#pragma unroll
                    for (int j = 0; j < 4; ++j) { const int col = 4 * lane + 256 * j; const f32x4 gg = *(const LAS f32x4*)(MODL + 3072 + col), bb = *(const LAS f32x4*)(MODL + 4096 + col);
                        const f32x4 xn = v[rr][j] * rstd * gg + bb;
                        const f32x4 sh = shv[j], sc = scv[j]; const f32x4 hv = xn * (sc + 1.0f) + sh;
                        *(unsigned*)(H8 + row * DM + col) = pg8::pk4_fp8(hv[0], hv[1], hv[2], hv[3]);
                        const unsigned h01 = pk2(hv[0], hv[1]), h23 = pk2(hv[2], hv[3]);
                        *(LAS u32x2*)(HT1 + (2 * wave + rr) * 1032 + col) = (u32x2){h01, h23}; } }
                __syncthreads();
                { f32x4 a0 = (f32x4){0.f, 0.f, 0.f, 0.f}, a1 = a0;
#pragma unroll
                  for (int s4 = 0; s4 < 4; ++s4) { const int s = 4 * wave + s4;
                    const bf16x8 h1 = *(const LAS bf16x8*)(HT1 + (lane & 15) * 1032 + 32 * s + 8 * (lane >> 4));
                    const bf16x8 w10 = wrf[s4][0], w11 = wrf[s4][1], w20 = wrf[s4][2], w21 = wrf[s4][3];
                    a0 = __builtin_amdgcn_mfma_f32_16x16x32_bf16(h1, w10, a0, 0, 0, 0); a0 = __builtin_amdgcn_mfma_f32_16x16x32_bf16(h1, w20, a0, 0, 0, 0);
                    a1 = __builtin_amdgcn_mfma_f32_16x16x32_bf16(h1, w11, a1, 0, 0, 0); a1 = __builtin_amdgcn_mfma_f32_16x16x32_bf16(h1, w21, a1, 0, 0, 0); }
#pragma unroll
                  for (int i = 0; i < 4; ++i) { PART[wave * 512 + (4 * (lane >> 4) + i) * 32 + (lane & 15)] = a0[i]; PART[wave * 512 + (4 * (lane >> 4) + i) * 32 + 16 + (lane & 15)] = a1[i]; } }
                __syncthreads();
                { const int half = lane >> 5, my_e = lane & 31, rloc = 2 * wave + half;
                  float lg = brv;
#pragma unroll
                  for (int w8 = 0; w8 < 8; ++w8) lg += PART[w8 * 512 + rloc * 32 + my_e];
                  float tv[4]; int te[4];
#pragma unroll
                  for (int k = 0; k < 4; ++k) { float mx = lg;
                    mx = row16_max(mx); mx = fmaxf(mx, shx(mx, 16, lane));
                    const unsigned long long bal = __ballot(lg == mx); const unsigned m32 = (unsigned)(bal >> (32 * half)); const int e = __ffs((int)m32) - 1;
                    tv[k] = mx; te[k] = e; if (my_e == e) lg = -3.0e38f; }
                  const float e1 = __expf(tv[1] - tv[0]), e2 = __expf(tv[2] - tv[0]), e3 = __expf(tv[3] - tv[0]); const float inv = 1.0f / (1.0f + e1 + e2 + e3);
                  if (my_e < 4) { const int e = my_e == 0 ? te[0] : my_e == 1 ? te[1] : my_e == 2 ? te[2] : te[3]; const float gt = (my_e == 0 ? 1.0f : my_e == 1 ? e1 : my_e == 2 ? e2 : e3) * inv;
                    const int lr = __hip_atomic_fetch_add(hist + e, 1, __ATOMIC_RELAXED, __HIP_MEMORY_SCOPE_WORKGROUP);
                    LAS int* en = ent + ((grp * 16 + rloc) * 4 + my_e) * 3; en[0] = e; en[1] = lr; en[2] = __builtin_bit_cast(int, gt); } }
                grp = gnx;
            } }
#undef LN1_VALID
#undef LN1_LOAD
            __syncthreads();
            if (tid < 32) { const int hc = hist[tid]; basel[tid] = hc ? (int)__hip_atomic_fetch_add(ctl + CW_CURSOR + layer * 32 + tid, (unsigned)hc, __ATOMIC_RELAXED, __HIP_MEMORY_SCOPE_AGENT) : 0; }
            __syncthreads();
            for (int i = tid; i < rows_per_wg * 4; i += NTHR) { const int rl = i >> 2; const int row = rbase + rl; const bool isctx = (row % TPB) < CTXL; if (lastl && isctx) continue;
                const LAS int* en = ent + i * 3; const int e = en[0]; const int pos = e * CAP + basel[e] + en[1];
                slot_tok[pos] = row; slot_gate[pos] = __builtin_bit_cast(float, en[2]); tok_pos[row * 4 + (i & 3)] = pos; }
        }
        GRID_BARP(14);
        LAS int* tb_bb = (LAS int*)(lds + LDS_MISC + 64);
        LAS int* tb_cnt = (LAS int*)(lds + LDS_MISC + 64 + 256);
        if (wave0 == 0) { PHASE_ARGS(); unsigned* ctl = WSP(unsigned, WS_CTL); const int ln = lane_now();
            const int c = (ln < 32) ? (int)__hip_atomic_load(ctl + CW_CURSOR + layer * 32 + ln, __ATOMIC_RELAXED, __HIP_MEMORY_SCOPE_AGENT) : 0;
            int incl = (c + 255) >> 8;
#pragma unroll
            for (int o = 1; o < 32; o <<= 1) { const int t = __builtin_amdgcn_ds_bpermute(((ln - o) & 63) << 2, incl); if ((ln & 31) >= o) incl += t; }
            if (ln < 32) { tb_cnt[ln] = c; tb_bb[ln] = incl - ((c + 255) >> 8); if (ln == 31) tb_bb[32] = incl; } }
        __syncthreads();
        LAS int* tb_be = (LAS int*)(lds + LDS_MISC + 512);
        { PHASE_IDS(); const int nblk = tb_bb[32];
#pragma clang loop vectorize(disable) unroll(disable)
          for (int i = tid; i < nblk; i += NTHR) { int e = 0;
#pragma unroll
            for (int j = 1; j < 32; ++j) e += (i >= tb_bb[j]) ? 1 : 0;
            tb_be[i] = e; } }
        __syncthreads();
        LAS unsigned char* side_buf = lds + LDS_MISC + 4096;
        {
            PHASE_ARGS(); pg8::SchedMoE S; S.bb = tb_bb; S.cnt = tb_cnt; S.be = tb_be; S.NT = 8; S.G = Gp; S.c = vcup; S.Acompact = nullptr; S.a_tstep = 0;
            S.bias = IN(12) + (size_t)layer * 32 * 2048; S.bias_estride = 2048; S.bias_pnstep = 128; S.bias_seg1 = 1024;
            const int* slot_tok = WSP(int, WS_SLOTTOK); const float* slot_gate = WSP(float, WS_SLOTGATE);
            S.W = (const char*)(WSP(unsigned char, WS_WEXPIN) + (size_t)layer * 32 * 2048 * 1024); S.w_estep = (size_t)2048 * 1024; S.w_tstep = (size_t)256 * 1024; S.slot_tok = slot_tok; S.slot_gate = slot_gate;
            pg8::EpiSwiglu E; E.Z = WSP(unsigned char, WS_Z); E.bias = IN(12) + (size_t)layer * 32 * 2048;
            for (int rep_ = 0; rep_ < DUPN(4); ++rep_)
            pg8::gemm_phase<pg8::EpiSwiglu, pg8::SchedMoE, true, true, true>(wave0, lds + LDS_STAGE, 1024, 1024, (const char*)WSP(unsigned char, WS_H8), S, E, side_buf);
        }
        GRID_BARP(15);
        {
            PHASE_ARGS(); pg8::SchedMoE S; S.bb = tb_bb; S.cnt = tb_cnt; S.be = tb_be; S.NT = 4; S.G = Gp; S.c = vcup;
            S.bias = IN(14) + (size_t)layer * 32 * 1024; S.bias_estride = 1024; S.bias_pnstep = 256; S.bias_seg1 = 128; S.Acompact = (const char*)WSP(unsigned char, WS_Z); S.a_tstep = (size_t)256 * 1024;
            const int* slot_tok = WSP(int, WS_SLOTTOK); const float* slot_gate = WSP(float, WS_SLOTGATE);
            S.W = (const char*)(WSP(unsigned char, WS_WEXPOUT) + (size_t)layer * 32 * 1024 * 1024); S.w_estep = (size_t)1024 * 1024; S.w_tstep = (size_t)256 * 1024; S.slot_tok = slot_tok; S.slot_gate = slot_gate;
            pg8::EpiMoeOut E; E.Y2 = WSP(unsigned char, WS_Y2); E.bias = IN(14) + (size_t)layer * 32 * 1024;
            for (int rep_ = 0; rep_ < DUPN(5); ++rep_)
            pg8::gemm_phase<pg8::EpiMoeOut, pg8::SchedMoE, false, true, true, true>(wave0, lds + LDS_STAGE, 1024, 1024, nullptr, S, E, side_buf);
        }
        GRID_BARP(16);
        {
            PHASE_IDS(); PHASE_ARGS();
            const float* ln_g = IN(6); const float* ln_b = IN(7); const float* MOD = WSP(float, WS_MOD); unsigned short* X16 = WSP(unsigned short, WS_X); const unsigned char* Y = WSP(unsigned char, WS_Y); const float* in_x = IN(0); const float* in_ctx = IN(2); unsigned char* H = WSP(unsigned char, WS_H8);
            const unsigned char* Y2 = WSP(unsigned char, WS_Y2); const int* tok_pos = WSP(int, WS_TOKPOS); float* outp = A_->out;
            const float* g2 = ln_g + (size_t)(layer * 2 + 1) * 1024; const float* b2 = ln_b + (size_t)(layer * 2 + 1) * 1024;
            const float* g1 = ln_g + (size_t)(layer * 2 + 0) * 1024; const float* b1 = ln_b + (size_t)(layer * 2 + 0) * 1024;
            LAS float* L2V = (LAS float*)(lds + LDS_STAGE);
            __syncthreads();
            for (int i = tid; i < 1024; i += NTHR) { const int q = i >> 8, c4 = (i & 255) * 4; const float* sp_ = (q == 0 ? g2 : q == 1 ? b2 : q == 2 ? g1 : b1) + c4; *(LAS f32x4*)(L2V + 4096 + q * 1024 + c4) = *(const f32x4*)sp_; }
            const int rbase2 = vcu * (M / 256);
            int mod_kind = -1;
            for (int rep_ = 0; rep_ < DUPN(13); ++rep_) {
            u32x4 tpn[2];
#pragma unroll
            for (int rr = 0; rr < 2; ++rr) tpn[rr] = *(const u32x4*)(tok_pos + (size_t)(rbase2 + 2 * wave + rr) * 4);
            for (int trip = 0; trip < 9; ++trip) {
                const int row0 = rbase2 + 2 * (wave + 8 * trip); const int b = row0 / TPB, t = row0 % TPB; const bool isctx = t < CTXL;
                const u32x4 tpc[2] = {tpn[0], tpn[1]};
                if (trip + 1 < 9) {
#pragma unroll
                    for (int rr = 0; rr < 2; ++rr) tpn[rr] = *(const u32x4*)(tok_pos + (size_t)(row0 + 16 + rr) * 4); }
                if (lastl && isctx) continue;
                if (mod_kind != (isctx ? 1 : 0)) { mod_kind = isctx ? 1 : 0;
                    const float* mr_ = MOD + (size_t)(layer * 17 + (isctx ? 16 : b)) * 6144; const float* mn_ = MOD + (size_t)((layer + 1 < DEPTH ? layer + 1 : layer) * 17 + (isctx ? 16 : b)) * 6144;
                    __syncthreads();
                    for (int i = tid; i < 1024; i += NTHR) { const int q = i >> 8, c4 = (i & 255) * 4;
                        const f32x4 x_ = (q == 0) ? *(const f32x4*)(mr_ + 5120 + c4) * pg8::Y2SCALE_INV : (q == 1) ? *(const f32x4*)(mn_ + c4) : (q == 2) ? *(const f32x4*)(mn_ + 1024 + c4) : *(const f32x4*)(mr_ + 2048 + c4) * (1.0f / 64.0f);
                        *(LAS f32x4*)(L2V + q * 1024 + c4) = x_; }
                    __syncthreads(); }
                int zr[2][4];
#pragma unroll
                for (int rr = 0; rr < 2; ++rr) { const u32x4 tp = tpc[rr];
#pragma unroll
                    for (int k = 0; k < 4; ++k) { const int pos = (int)tp[k]; const int e = pos / CAP, rk = pos % CAP; zr[rr][k] = tb_bb[e] * 256 + rk; } }
                f32x4 v[2][4]; unsigned yw[2][4][4], y1w[2][4]; u32x2 xh[2][4];
#pragma unroll
                for (int rr = 0; rr < 2; ++rr) { const size_t row_ = (size_t)(row0 + rr);
#pragma unroll
                    for (int j = 0; j < 4; ++j) xh[rr][j] = *(const u32x2*)(X16 + row_ * DM + 4 * lane + 256 * j);
#pragma unroll
                    for (int j = 0; j < 4; ++j) { const int col = 4 * lane + 256 * j; y1w[rr][j] = *(const unsigned*)(Y + row_ * DM + col);
#pragma unroll
                        for (int k = 0; k < 4; ++k) yw[rr][j][k] = *(const unsigned*)(Y2 + (size_t)zr[rr][k] * 1024 + col); } }
#pragma unroll
                for (int rr = 0; rr < 2; ++rr) { float s = 0.f;
#pragma unroll
                    for (int j = 0; j < 4; ++j) { const int yw1 = (int)y1w[rr][j]; const f32x2 ylo = __builtin_amdgcn_cvt_pk_f32_fp8(yw1, false), yhi = __builtin_amdgcn_cvt_pk_f32_fp8(yw1, true); const f32x4 gt = *(const LAS f32x4*)(L2V + 3072 + 4 * lane + 256 * j);
                        v[rr][j] = h4_to_f32(xh[rr][j].x, xh[rr][j].y) * ALPHA; v[rr][j][0] += gt[0] * ylo[0]; v[rr][j][1] += gt[1] * ylo[1]; v[rr][j][2] += gt[2] * yhi[0]; v[rr][j][3] += gt[3] * yhi[1];
                        s += (v[rr][j][0] + v[rr][j][1]) + (v[rr][j][2] + v[rr][j][3]); }
                    const float mean = wave_sum(s, lane) * (1.f / DM); float s2 = 0.f;
#pragma unroll
                    for (int j = 0; j < 4; ++j) { v[rr][j] = v[rr][j] - mean; s2 += (v[rr][j][0] * v[rr][j][0] + v[rr][j][1] * v[rr][j][1]) + (v[rr][j][2] * v[rr][j][2] + v[rr][j][3] * v[rr][j][3]); }
                    const float rstd = __builtin_amdgcn_rsqf(wave_sum(s2, lane) * (1.f / DM) + LN_EPS);
#pragma unroll
                    for (int j = 0; j < 4; ++j) v[rr][j] = v[rr][j] * rstd * *(const LAS f32x4*)(L2V + 6144 + 4 * lane + 256 * j) + *(const LAS f32x4*)(L2V + 7168 + 4 * lane + 256 * j); }
#pragma unroll
                for (int rr = 0; rr < 2; ++rr) { const int row = row0 + rr; float s = 0.f;
#pragma unroll
                    for (int j = 0; j < 4; ++j) { const int col = 4 * lane + 256 * j; f32x4 y = (f32x4){0.f, 0.f, 0.f, 0.f};
#pragma unroll
                        for (int k = 0; k < 4; ++k) { const int w = (int)yw[rr][j][k]; const f32x2 lo = __builtin_amdgcn_cvt_pk_f32_fp8(w, false), hi = __builtin_amdgcn_cvt_pk_f32_fp8(w, true); y[0] += lo[0]; y[1] += lo[1]; y[2] += hi[0]; y[3] += hi[1]; }
                        const f32x4 gt = *(const LAS f32x4*)(L2V + col);
                        v[rr][j] = v[rr][j] * ALPHA + gt * y; s += (v[rr][j][0] + v[rr][j][1]) + (v[rr][j][2] + v[rr][j][3]); }
                    const float mean = wave_sum(s, lane) * (1.f / DM); float s2 = 0.f;
#pragma unroll
                    for (int j = 0; j < 4; ++j) { v[rr][j] = v[rr][j] - mean; s2 += (v[rr][j][0] * v[rr][j][0] + v[rr][j][1] * v[rr][j][1]) + (v[rr][j][2] * v[rr][j][2] + v[rr][j][3] * v[rr][j][3]); }
                    const float rstd = __builtin_amdgcn_rsqf(wave_sum(s2, lane) * (1.f / DM) + LN_EPS);
#pragma unroll
                    for (int j = 0; j < 4; ++j) { const int col = 4 * lane + 256 * j; const f32x4 gg = *(const LAS f32x4*)(L2V + 4096 + col), bb = *(const LAS f32x4*)(L2V + 5120 + col);
                        v[rr][j] = v[rr][j] * rstd * gg + bb; }
                    if (lastl) {
#pragma unroll
                        for (int j = 0; j < 4; ++j) *(f32x4*)(outp + ((size_t)b * SEQ + (t + rr - CTXL)) * DM + 4 * lane + 256 * j) = v[rr][j]; }
                    else { f32x4 shq[4], scq[4];
#pragma unroll
                        for (int j = 0; j < 4; ++j) { const int col = 4 * lane + 256 * j; shq[j] = *(const LAS f32x4*)(L2V + 1024 + col); scq[j] = *(const LAS f32x4*)(L2V + 2048 + col); }
#pragma unroll
                        for (int j = 0; j < 4; ++j) { const int col = 4 * lane + 256 * j; const f32x4 xn = v[rr][j];
                            *(u32x2*)(X16 + (size_t)row * DM + col) = f32_to_h4(xn);
                            const f32x4 h = xn * (scq[j] + 1.0f) + shq[j];
                            *(unsigned*)(H + (size_t)row * DM + col) = pg8::pk4_fp8(h[0], h[1], h[2], h[3]); } } }
            } }
        }
        if (!lastl) GRID_BARP(17);
    }
    if (PROBE_MASK != 0ull) {
        PT_SAMPLE(17);
        __syncthreads();
        const unsigned pt_target_ = MISC[3401] * PROBE_MULT; const unsigned pt_t0_ = (unsigned)__builtin_amdgcn_s_memrealtime();
        while ((unsigned)__builtin_amdgcn_s_memrealtime() - pt_t0_ < pt_target_) __builtin_amdgcn_s_sleep(32);
    }
}

extern "C" void kernel_launch(void* const* d_in, const int* in_sizes, int n_in, void* d_out, int out_size, void* d_ws, size_t ws_size, hipStream_t stream) {
    static int grid = 0;
    if (grid == 0) {
        if (n_in != 34 || ws_size < WS_END) { fprintf(stderr, "kernel_launch: unexpected n_in %d / ws %zu (need %zu)\n", n_in, ws_size, (size_t)WS_END); grid = -1; return; }
        int dev = 0, cus = 0, per_cu = 0;
        if (hipGetDevice(&dev) != hipSuccess || hipDeviceGetAttribute(&cus, hipDeviceAttributeMultiprocessorCount, dev) != hipSuccess) { grid = -1; return; }
        if (hipFuncSetAttribute((const void*)fwd_kernel, hipFuncAttributeMaxDynamicSharedMemorySize, LDS_BYTES) != hipSuccess) { fprintf(stderr, "kernel_launch: hipFuncSetAttribute failed\n"); grid = -1; return; }
        if (hipOccupancyMaxActiveBlocksPerMultiprocessor(&per_cu, (const void*)fwd_kernel, NTHR, LDS_BYTES) != hipSuccess || per_cu < 1) { fprintf(stderr, "kernel_launch: occupancy query says %d\n", per_cu); }
        (void)hipGetLastError();
        if (cus < 256) { fprintf(stderr, "kernel_launch: built for a 256-CU device (one resident workgroup per CU), found %d CUs\n", cus); grid = -1; return; }
        grid = 256;
    }
    if (grid < 0) return;
    (void)hipMemsetAsync((char*)d_ws + WS_CTL, 0, CTL_BYTES, stream);
    Args a{};
    for (int i = 0; i < 34; ++i) a.in[i] = (const float*)d_in[i];
    a.out = (float*)d_out; a.ws = (unsigned char*)d_ws;
    hipLaunchKernelGGL(fwd_kernel, dim3(grid), dim3(NTHR), LDS_BYTES, stream, a);
    const hipError_t le = hipPeekAtLastError();
    if (le != hipSuccess) fprintf(stderr, "kernel_launch: launch failed: %s\n", hipGetErrorName(le));
}
```
